# Optimizing an MI355X kernel written in HIP

```python
import math
import jax, jax.numpy as jnp
from jax import lax
import numpy as np

D_MODEL = 2048
BATCH = 2
SEQ = 4096
DEPTH = 1

HEAD_DIM = 128
MIX_WIDTH = D_MODEL
MOBA_WIDTH = MIX_WIDTH // 2
MOBA_HEADS = MOBA_WIDTH // HEAD_DIM
MOBA_BLOCK = 256
MOBA_TOPK = 3
MOBA_QCHUNK = 32
DIFF_WIDTH = MIX_WIDTH - MOBA_WIDTH
DIFF_V_DIM = 2 * HEAD_DIM
DIFF_HEADS = DIFF_WIDTH // DIFF_V_DIM
DIFF_QK_DIM = HEAD_DIM
DIFF_QK_WIDTH = DIFF_HEADS * 2 * DIFF_QK_DIM
DIFF_QBLOCK = 128
IN_SIZES = (MOBA_WIDTH, MOBA_WIDTH, MOBA_WIDTH, DIFF_QK_WIDTH, DIFF_QK_WIDTH, DIFF_WIDTH)
IN_WIDTH = sum(IN_SIZES)
N_GROUPS = 4
EXPERTS_PER_GROUP = 8
N_EXPERTS = N_GROUPS * EXPERTS_PER_GROUP
EXPERT_TOPK = 2
D_EXPERT = D_MODEL // 4
RMS_EPS = 1e-6
ALIBI_MAX_BIAS = 8.0

kernel_name = "hymba_moba_diffattn_hmoe"


def rms_norm(x, w):
    xf = x.astype(jnp.float32)
    y = xf * lax.rsqrt(jnp.mean(xf * xf, axis=-1, keepdims=True) + RMS_EPS)
    return (y * w.astype(jnp.float32)).astype(x.dtype)


def alibi_slopes(n):
    i = jnp.arange(n, dtype=jnp.float32) + 1.0
    return jnp.exp2(-ALIBI_MAX_BIAS * i / n)


def to_heads(t, n, d):
    b, s, _ = t.shape
    return t.reshape(b, s, n, d).transpose(0, 2, 1, 3)


def moba_attention(q, k, v, slopes):
    B, H, S, Dh = q.shape
    nb = -(-S // MOBA_BLOCK)
    sp = nb * MOBA_BLOCK
    n_top = min(MOBA_TOPK, nb)
    pad = ((0, 0), (0, 0), (0, sp - S), (0, 0))
    kf = jnp.pad(k.astype(jnp.float32), pad)
    vf = jnp.pad(v.astype(jnp.float32), pad)
    kb = kf.reshape(B, H, nb, MOBA_BLOCK, Dh)
    vb = vf.reshape(B, H, nb, MOBA_BLOCK, Dh)
    k_mean = jnp.mean(kb, axis=3)
    qf = q.astype(jnp.float32) * (Dh ** -0.5)
    b_idx = jnp.arange(B)[:, None, None, None]
    h_idx = jnp.arange(H)[None, :, None, None]
    blk = jnp.arange(nb)
    in_blk = jnp.arange(MOBA_BLOCK)
    n_chunks = S // MOBA_QCHUNK

    def chunk(c):
        t0 = c * MOBA_QCHUNK
        qc = lax.dynamic_slice_in_dim(qf, t0, MOBA_QCHUNK, axis=2)
        t = t0 + jnp.arange(MOBA_QCHUNK)
        own = t0 // MOBA_BLOCK
        gate = jnp.einsum('bhqd,bhnd->bhqn', qc, k_mean)
        gate = jnp.where(blk < own, gate, -jnp.inf)
        _, sel = lax.top_k(gate, n_top)
        sel_valid = sel < own
        k_sel = kb[b_idx, h_idx, sel]
        v_sel = vb[b_idx, h_idx, sel]
        pos_sel = sel[..., None] * MOBA_BLOCK + in_blk
        dist_sel = (t[None, None, :, None, None] - pos_sel).astype(jnp.float32)
        s_sel = jnp.einsum('bhqd,bhqjkd->bhqjk', qc, k_sel) - slopes[None, :, None, None, None] * dist_sel
        s_sel = jnp.where(sel_valid[..., None], s_sel, -jnp.inf)
        k_own = lax.dynamic_index_in_dim(kb, own, axis=2, keepdims=False)
        v_own = lax.dynamic_index_in_dim(vb, own, axis=2, keepdims=False)
        pos_own = own * MOBA_BLOCK + in_blk
        dist_own = (t[:, None] - pos_own[None, :]).astype(jnp.float32)
        s_own = jnp.einsum('bhqd,bhkd->bhqk', qc, k_own) - slopes[None, :, None, None] * dist_own
        s_own = jnp.where(pos_own[None, :] <= t[:, None], s_own, -jnp.inf)
        n_sel = n_top * MOBA_BLOCK
        s_all = jnp.concatenate([s_sel.reshape(B, H, MOBA_QCHUNK, n_sel), s_own], axis=-1)
        p = jax.nn.softmax(s_all, axis=-1)
        p_sel = p[..., :n_sel].reshape(B, H, MOBA_QCHUNK, n_top, MOBA_BLOCK)
        p_own = p[..., n_sel:]
        out = (jnp.einsum('bhqjk,bhqjkd->bhqd', p_sel, v_sel)
               + jnp.einsum('bhqk,bhkd->bhqd', p_own, v_own))
        return out.astype(q.dtype)

    outs = lax.map(chunk, jnp.arange(n_chunks))
    return outs.transpose(1, 2, 0, 3, 4).reshape(B, H, S, Dh)


def diff_attention(q1, q2, k1, k2, v, lam, slopes):
    B, H, S, Dq = q1.shape
    scale = Dq ** -0.5
    q1f = q1.astype(jnp.float32) * scale
    q2f = q2.astype(jnp.float32) * scale
    k1f, k2f, vf = k1.astype(jnp.float32), k2.astype(jnp.float32), v.astype(jnp.float32)
    s_pos = jnp.arange(S)
    n_blocks = S // DIFF_QBLOCK

    def block(c):
        t0 = c * DIFF_QBLOCK
        t = t0 + jnp.arange(DIFF_QBLOCK)
        causal = s_pos[None, :] <= t[:, None]
        bias = -slopes[:, None, None] * (t[:, None] - s_pos[None, :]).astype(jnp.float32)

        def probs(qf, kf):
            qc = lax.dynamic_slice_in_dim(qf, t0, DIFF_QBLOCK, axis=2)
            s = jnp.einsum('bhqd,bhkd->bhqk', qc, kf) + bias[None]
            return jax.nn.softmax(jnp.where(causal, s, -jnp.inf), axis=-1)

        a = probs(q1f, k1f) - lam * probs(q2f, k2f)
        return jnp.einsum('bhqk,bhkd->bhqd', a, vf)

    outs = lax.map(block, jnp.arange(n_blocks))
    return outs.transpose(1, 2, 0, 3, 4).reshape(B, H, S, vf.shape[-1])


def hier_moe(h, w_rg, b_rg, w_re, b_re, w_gate, w_up, w_down):
    B, S, D = h.shape
    t = h.reshape(B * S, D)
    tf = t.astype(jnp.float32)
    g_probs = jax.nn.softmax(tf @ w_rg.astype(jnp.float32) + b_rg.astype(jnp.float32), axis=-1)
    g_p, g_top = lax.top_k(g_probs, 1)
    e_logits = (tf @ w_re.astype(jnp.float32) + b_re.astype(jnp.float32)).reshape(-1, N_GROUPS, EXPERTS_PER_GROUP)
    e_in = jnp.take_along_axis(e_logits, g_top[:, :, None], axis=1)[:, 0]
    e_p, e_top = lax.top_k(jax.nn.softmax(e_in, axis=-1), EXPERT_TOPK)
    e_p = e_p / jnp.sum(e_p, axis=-1, keepdims=True)
    weights = g_p * e_p
    expert_ids = g_top * EXPERTS_PER_GROUP + e_top
    combine = jnp.sum(jax.nn.one_hot(expert_ids, N_EXPERTS, dtype=jnp.float32) * weights[..., None], axis=1)
    combine = combine.astype(t.dtype)
    out = jnp.zeros_like(t)
    for g in range(N_GROUPS):
        sl = slice(g * EXPERTS_PER_GROUP, (g + 1) * EXPERTS_PER_GROUP)
        a = jnp.einsum('td,edf->tef', t, w_gate[sl])
        u = jnp.einsum('td,edf->tef', t, w_up[sl])
        act = jax.nn.silu(a) * u * combine[:, sl, None]
        out = out + jnp.einsum('tef,efd->td', act, w_down[sl])
    return out.reshape(B, S, D)


def setup_inputs(seed: int = 0) -> dict:
    key = jax.random.key(seed)
    ks = jax.random.split(key, 20)
    f32 = jnp.float32
    nrm = lambda k, shape, s: jax.random.normal(k, shape, f32) * s
    L = DEPTH
    return {
        "x": jax.random.normal(ks[0], (BATCH, SEQ, D_MODEL), f32),
        "norm_mix_w": 1.0 + nrm(ks[1], (L, D_MODEL), 0.02),
        "w_in": nrm(ks[2], (L, D_MODEL, IN_WIDTH), D_MODEL ** -0.5),
        "lambda_q1": nrm(ks[3], (L, DIFF_QK_DIM), 0.1),
        "lambda_k1": nrm(ks[4], (L, DIFF_QK_DIM), 0.1),
        "lambda_q2": nrm(ks[5], (L, DIFF_QK_DIM), 0.1),
        "lambda_k2": nrm(ks[6], (L, DIFF_QK_DIM), 0.1),
        "diff_subln_w": 1.0 + nrm(ks[7], (L, DIFF_V_DIM), 0.02),
        "w_out": nrm(ks[8], (L, MIX_WIDTH, D_MODEL), MIX_WIDTH ** -0.5),
        "norm_ffn_w": 1.0 + nrm(ks[9], (L, D_MODEL), 0.02),
        "w_router_group": nrm(ks[10], (L, D_MODEL, N_GROUPS), D_MODEL ** -0.5),
        "b_router_group": nrm(ks[11], (L, N_GROUPS), 0.01),
        "w_router_expert": nrm(ks[12], (L, D_MODEL, N_EXPERTS), D_MODEL ** -0.5),
        "b_router_expert": nrm(ks[13], (L, N_EXPERTS), 0.01),
        "w_gate": nrm(ks[14], (L, N_EXPERTS, D_MODEL, D_EXPERT), D_MODEL ** -0.5),
        "w_up": nrm(ks[15], (L, N_EXPERTS, D_MODEL, D_EXPERT), D_MODEL ** -0.5),
        "w_down": nrm(ks[16], (L, N_EXPERTS, D_EXPERT, D_MODEL), D_EXPERT ** -0.5),
        "norm_final_w": 1.0 + nrm(ks[17], (D_MODEL,), 0.02),
    }


def reference(x, norm_mix_w, w_in, lambda_q1, lambda_k1, lambda_q2, lambda_k2, diff_subln_w,
              w_out, norm_ffn_w, w_router_group, b_router_group, w_router_expert, b_router_expert,
              w_gate, w_up, w_down, norm_final_w):
    B, S, _ = x.shape
    slopes_a = alibi_slopes(MOBA_HEADS)
    slopes_b = alibi_slopes(DIFF_HEADS)
    offsets = [int(o) for o in np.cumsum(IN_SIZES)[:-1]]
    for l in range(DEPTH):
        h = rms_norm(x, norm_mix_w[l])
        proj = h @ w_in[l]
        qa, ka, va, qb, kb, vb = jnp.split(proj, offsets, axis=-1)
        out_a = moba_attention(to_heads(qa, MOBA_HEADS, HEAD_DIM), to_heads(ka, MOBA_HEADS, HEAD_DIM),
                               to_heads(va, MOBA_HEADS, HEAD_DIM), slopes_a)
        out_a = out_a.transpose(0, 2, 1, 3).reshape(B, S, MOBA_WIDTH).astype(x.dtype)
        qb = qb.reshape(B, S, DIFF_HEADS, 2, DIFF_QK_DIM).transpose(0, 2, 3, 1, 4)
        kb = kb.reshape(B, S, DIFF_HEADS, 2, DIFF_QK_DIM).transpose(0, 2, 3, 1, 4)
        vbh = to_heads(vb, DIFF_HEADS, DIFF_V_DIM)
        lambda_init = 0.8 - 0.6 * math.exp(-0.3 * l)
        lam = (jnp.exp(jnp.sum(lambda_q1[l].astype(jnp.float32) * lambda_k1[l].astype(jnp.float32)))
               - jnp.exp(jnp.sum(lambda_q2[l].astype(jnp.float32) * lambda_k2[l].astype(jnp.float32)))
               + lambda_init)
        out_b = diff_attention(qb[:, :, 0], qb[:, :, 1], kb[:, :, 0], kb[:, :, 1], vbh, lam, slopes_b)
        out_b = rms_norm(out_b, diff_subln_w[l]) * (1.0 - lambda_init)
        out_b = out_b.transpose(0, 2, 1, 3).reshape(B, S, DIFF_WIDTH).astype(x.dtype)
        mixed = jnp.concatenate([out_a, out_b], axis=-1)
        x = x + mixed @ w_out[l]
        h = rms_norm(x, norm_ffn_w[l])
        x = x + hier_moe(h, w_router_group[l], b_router_group[l], w_router_expert[l], b_router_expert[l],
                         w_gate[l], w_up[l], w_down[l])
    return rms_norm(x, norm_final_w)
```

```cpp
#include <hip/hip_runtime.h>
#include <cstdio>
#include <cstdint>

#ifndef MK_N_LAUNCHES
#define MK_N_LAUNCHES 1
#endif
constexpr int NPH = 10;
constexpr int N_LAUNCHES = MK_N_LAUNCHES;

constexpr int NWAVES = 8;
constexpr int BATCH = 2, SEQ = 4096, T = BATCH * SEQ, D = 2048, NIN = 6144;
constexpr int NE = 32, DE = 512, NPAIR = 2 * T;
constexpr int XP_ROWS = 24576;
constexpr float RMS_EPS = 1e-6f;
constexpr float LOG2E = 1.4426950408889634f;
constexpr float QSCALE = 0.08838834764831845f * 1.4426950408889634f;

constexpr size_t MiB = 1u << 20;
constexpr size_t WS_CTL = 0, CTL_ZERO_BYTES = 1 * MiB;
constexpr size_t WS_WIN = 1 * MiB;
constexpr size_t WS_WOUT = 25 * MiB;
constexpr size_t WS_H = 33 * MiB;
constexpr size_t WS_Y = 1 * MiB;
constexpr size_t WS_WGU = 65 * MiB;
constexpr size_t WS_WD = 193 * MiB;
constexpr size_t WS_PROJ = 257 * MiB;
constexpr size_t WS_XP = 257 * MiB;
constexpr size_t WS_MIX = 353 * MiB;
constexpr size_t WS_ACT = 353 * MiB;
constexpr size_t WS_X1 = 385 * MiB;
constexpr size_t WS_MISC = 449 * MiB;
constexpr size_t WS_KMEAN = WS_MISC;
constexpr size_t WS_TOKINFO = WS_MISC + 256 * 1024;
constexpr size_t WS_TOKRSTD = WS_MISC + 384 * 1024;
constexpr size_t WS_ROWINFO = WS_MISC + 512 * 1024;
constexpr size_t WS_WRHI = WS_MISC + 1024 * 1024;
constexpr size_t WS_WRLO = WS_MISC + 1280 * 1024;
constexpr size_t WS_END = 452 * MiB;
constexpr int CW_BAR = 4096;
constexpr int CW_ECNT = 8192;
constexpr int CW_ECUR = 8192 + 64;
constexpr int CW_QHEAD = 8192 + 128;

constexpr int RING_BYTES = 131072;
constexpr int ATT_SCR_OFF = 131072;
constexpr int MOE_TAB_OFF = 135168;
constexpr int MISC_OFF = 136192;
constexpr int LDS_BYTES = 147456;

#define GAS __attribute__((address_space(1)))
#define LAS __attribute__((address_space(3)))
typedef unsigned short bf16;
typedef float f32x4 __attribute__((ext_vector_type(4)));
typedef float f32x16 __attribute__((ext_vector_type(16)));
typedef short bf16x8 __attribute__((ext_vector_type(8)));
typedef short s16x4 __attribute__((ext_vector_type(4)));
typedef unsigned u32x4 __attribute__((ext_vector_type(4)));
typedef unsigned u32x2 __attribute__((ext_vector_type(2)));

__device__ __forceinline__ unsigned f2bf(float f) { unsigned u = __builtin_bit_cast(unsigned, f); return (u + 0x7fffu + ((u >> 16) & 1u)) >> 16; }
__device__ __forceinline__ unsigned pk2(float lo, float hi) { return f2bf(lo) | (f2bf(hi) << 16); }
__device__ __forceinline__ float bf2f(unsigned b) { return __builtin_bit_cast(float, b << 16); }
__device__ __forceinline__ float wave_sum(float v) {
#pragma unroll
    for (int o = 1; o < 64; o <<= 1) v += __shfl_xor(v, o);
    return v;
}
namespace pg8 {
#define PG8_LAS __attribute__((address_space(3)))
typedef unsigned short bf16_t;
typedef short bf16x8 __attribute__((ext_vector_type(8)));
typedef float f32x4 __attribute__((ext_vector_type(4)));
typedef unsigned u32x4 __attribute__((ext_vector_type(4)));
constexpr int BM = 256, BK = 64, HALF = 128, HTB = HALF * BK * 2  , STAGE_BYTES = 8 * HTB, NXCD = 8, WGM = 8;

__host__ __device__ __forceinline__ int lds_byte(int r, int c) { const int st = (r >> 4) * 2 + (c >> 5), rr = r & 15, cc = c & 31, ob = rr * 64 + cc * 2; return st * 1024 + (ob ^ (((ob >> 9) & 1) << 5)); }
__host__ __device__ __forceinline__ void stage_rc(int b, int& R, int& C) { const int st = b / 1024, sb = b % 1024, swz = sb ^ (((sb >> 9) & 1) << 5); R = (st >> 1) * 16 + swz / 64; C = (st & 1) * 32 + (swz % 64) / 2; }
__host__ __device__ __forceinline__ int perm32(int rho) { const int n = rho >> 4, i = rho & 15; return 8 * (i >> 2) + 4 * n + (i & 3); }

struct Unit { int pm, pn; };
struct Gemm { const bf16_t* A; const bf16_t* Bt; int M, N, K; };

struct StaticOrder {
    int nM, nN, nwg, G, c;
    __host__ __device__ void init(int M, int N, int G_, int c_) { nM = M / BM; nN = N / BM; nwg = nM * nN; G = G_; c = c_; }
    __host__ __device__ bool next(int i, Unit& u) const {
        const long L = (long)i * G + c; if (L >= nwg) return false;
        int wgid = (int)L; { const int q = nwg / NXCD, r = nwg % NXCD, xcd = wgid % NXCD, off = wgid / NXCD; wgid = (xcd < r ? xcd * (q + 1) : r * (q + 1) + (xcd - r) * q) + off; }
        const int nig = WGM * nN, gid = wgid / nig, fm = gid * WGM, gsz = (nM - fm) < WGM ? (nM - fm) : WGM;
        u.pm = fm + ((wgid % nig) % gsz); u.pn = (wgid % nig) / gsz; return true;
    }
    __device__ __forceinline__ void a_ready(const Unit&) const {}
    __device__ __forceinline__ void done(const Unit&) const {}
};

__device__ __forceinline__ unsigned cvt_pk_bf16(float lo, float hi) { unsigned r; asm volatile("v_cvt_pk_bf16_f32 %0, %1, %2" : "=v"(r) : "v"(lo), "v"(hi)); return r; }
typedef float f32x2 __attribute__((ext_vector_type(2)));
struct EpiProj {
    static constexpr bool PERM = true, AFTER_DRAIN = false;
    bf16_t* O; int ldc; float qscale;
    __device__ __forceinline__ void operator()(const f32x4 (&acc)[2][2][4][2], const Unit& u, int wr, int wc, int fr, int fq) const {
        const int row0 = u.pm * BM + wr * 64 + fr, col0 = u.pn * BM + wc * 32 + 8 * fq;
        const float sc = (u.pn < 4 || (u.pn >= 12 && u.pn < 16)) ? qscale : 1.f;
#pragma unroll
        for (int ai = 0; ai < 2; ++ai)
#pragma unroll
            for (int m = 0; m < 4; ++m) { bf16_t* rowp = O + (size_t)(row0 + ai * HALF + m * 16) * ldc + col0;
#pragma unroll
                for (int bj = 0; bj < 2; ++bj) { const f32x4 v0 = acc[ai][bj][m][0] * sc, v1 = acc[ai][bj][m][1] * sc;
                    u32x4 w; w.x = cvt_pk_bf16(v0[0], v0[1]); w.y = cvt_pk_bf16(v0[2], v0[3]); w.z = cvt_pk_bf16(v1[0], v1[1]); w.w = cvt_pk_bf16(v1[2], v1[3]);
                    *(u32x4*)(rowp + bj * HALF) = w; } }
    }
};
struct EpiResid {
    static constexpr bool PERM = true, AFTER_DRAIN = false;
    const float* X; float* X1; int ldc;
    __device__ __forceinline__ void operator()(const f32x4 (&acc)[2][2][4][2], const Unit& u, int wr, int wc, int fr, int fq) const {
        const int row0 = u.pm * BM + wr * 64 + fr, col0 = u.pn * BM + wc * 32 + 8 * fq;
#pragma unroll
        for (int ai = 0; ai < 2; ++ai)
#pragma unroll
            for (int m = 0; m < 4; ++m) { const size_t off = (size_t)(row0 + ai * HALF + m * 16) * ldc + col0;
#pragma unroll
                for (int bj = 0; bj < 2; ++bj)
#pragma unroll
                    for (int n = 0; n < 2; ++n) { const f32x4 xv = *(const f32x4*)(X + off + bj * HALF + 4 * n); *(f32x4*)(X1 + off + bj * HALF + 4 * n) = xv + acc[ai][bj][m][n]; } }
    }
};
__device__ __forceinline__ float silu_mul(float g, float u) { return g * u * __builtin_amdgcn_rcpf(1.f + __builtin_amdgcn_exp2f(-1.4426950408889634f * g)); }
struct EpiSwiGLU {
    static constexpr bool PERM = true, AFTER_DRAIN = false;
    bf16_t* ACT;
    __device__ __forceinline__ void operator()(const f32x4 (&acc)[2][2][4][2], const Unit& u, int wr, int wc, int fr, int fq) const {
        const int row0 = u.pm * BM + wr * 64 + fr, col0 = (u.pn & 3) * 128 + wc * 32 + 8 * fq;
#pragma unroll
        for (int ai = 0; ai < 2; ++ai)
#pragma unroll
            for (int m = 0; m < 4; ++m) { const f32x4 g0 = acc[ai][0][m][0], g1 = acc[ai][0][m][1], u0 = acc[ai][1][m][0], u1 = acc[ai][1][m][1];
                u32x4 w; w.x = cvt_pk_bf16(silu_mul(g0[0], u0[0]), silu_mul(g0[1], u0[1])); w.y = cvt_pk_bf16(silu_mul(g0[2], u0[2]), silu_mul(g0[3], u0[3]));
                w.z = cvt_pk_bf16(silu_mul(g1[0], u1[0]), silu_mul(g1[1], u1[1])); w.w = cvt_pk_bf16(silu_mul(g1[2], u1[2]), silu_mul(g1[3], u1[3]));
                *(u32x4*)(ACT + (size_t)(row0 + ai * HALF + m * 16) * 512 + col0) = w; }
    }
};
struct EpiDown {
    static constexpr bool PERM = true, AFTER_DRAIN = false;
    bf16_t* Y; const int* rowinfo; const PG8_LAS int* rowend;
    __device__ __forceinline__ void operator()(const f32x4 (&acc)[2][2][4][2], const Unit& u, int wr, int wc, int fr, int fq) const {
        const int e = u.pn >> 3, rend = rowend[e];
        const int row0 = u.pm * BM + wr * 64 + fr, col0 = (u.pn & 7) * BM + wc * 32 + 8 * fq;
#pragma unroll
        for (int ai = 0; ai < 2; ++ai)
#pragma unroll
            for (int m = 0; m < 4; ++m) { const int pos = row0 + ai * HALF + m * 16;
                if (pos < rend) { const int pair = rowinfo[2 * pos]; const float wgt = __builtin_bit_cast(float, rowinfo[2 * pos + 1]);
                    bf16_t* rowp = Y + (size_t)pair * 2048 + col0;
#pragma unroll
                    for (int bj = 0; bj < 2; ++bj) { const f32x4 v0 = acc[ai][bj][m][0] * wgt, v1 = acc[ai][bj][m][1] * wgt;
                        u32x4 w; w.x = cvt_pk_bf16(v0[0], v0[1]); w.y = cvt_pk_bf16(v0[2], v0[3]); w.z = cvt_pk_bf16(v1[0], v1[1]); w.w = cvt_pk_bf16(v1[2], v1[3]);
                        *(u32x4*)(rowp + bj * HALF) = w; } } }
    }
};
struct MoeOrder {
    const PG8_LAS int* tab; int npn, total, G, c;
    __device__ __forceinline__ bool next(int i, Unit& u) const {
        const int L = i * G + c; if (L >= total) return false;
        const int tile = L / npn, pn = L - tile * npn; int e = 0;
#pragma unroll 4
        for (int j = 1; j < 32; ++j) e += (tab[j] <= tile) ? 1 : 0;
        u.pm = tab[40 + e] + (tile - tab[e]); u.pn = e * npn + pn; return true;
    }
    __device__ __forceinline__ void a_ready(const Unit&) const {}
    __device__ __forceinline__ void done(const Unit&) const {}
};

template <class Epi, class Sched, bool ALIGN_EPI = false, bool SP2 = false>
__device__ __forceinline__ void gemm_phase(PG8_LAS unsigned char* lds, const Gemm g, const Sched& S, const Epi& E) {
    const int tid = threadIdx.x, wid = __builtin_amdgcn_readfirstlane(tid >> 6), lane = tid & 63, wr = wid >> 2, wc = wid & 3, fr = lane & 15, fq = lane >> 4;
    const int K = g.K, nt = K / BK;
    unsigned voffA[2], voffB[2];
#pragma unroll
    for (int i = 0; i < 2; ++i) { int R, C; stage_rc(tid * 16 + i * 8192, R, C); const int Rb = Epi::PERM ? ((R & ~31) + perm32(R & 31)) : R;
        voffA[i] = (unsigned)(R * K + C) * 2u; voffB[i] = (unsigned)(Rb * K + C) * 2u; }
    const size_t kstep = (size_t)(BK * 2);
    const size_t hstep = (size_t)HALF * K * 2;
    const size_t tstep = 2 * hstep;
    const unsigned ldsw = (unsigned)wid * 1024u;
    const int aoff = lds_byte(wr * 64 + fr, fq * 8), boff = lds_byte(wc * 32 + fr, fq * 8);
#define PG8_SA(b, h) (((b) * 2 + (h)) * HTB)
#define PG8_SB(b, h) ((4 + (b) * 2 + (h)) * HTB)
#define PG8_STAGE(bufoff, gbase, voff) do { _Pragma("unroll") for (int _i = 0; _i < 2; ++_i) \
        __builtin_amdgcn_global_load_lds((const unsigned*)((const char*)(gbase) + (voff)[_i]), (PG8_LAS unsigned*)(lds + (bufoff) + ldsw + _i * 8192), 16, 0, 0); } while (0)
#define PG8_LDA(dst, b, h) do { _Pragma("unroll") for (int m = 0; m < 4; ++m) _Pragma("unroll") for (int k = 0; k < 2; ++k) dst[m][k] = *(const PG8_LAS bf16x8*)(lds + PG8_SA(b, h) + aoff + m * 2048 + k * 1024); } while (0)
#define PG8_LDB(dst, b, h) do { _Pragma("unroll") for (int n = 0; n < 2; ++n) _Pragma("unroll") for (int k = 0; k < 2; ++k) dst[n][k] = *(const PG8_LAS bf16x8*)(lds + PG8_SB(b, h) + boff + n * 2048 + k * 1024); } while (0)
#define PG8_MMA(ai, bj, At, Bt) do { __builtin_amdgcn_s_setprio(1); _Pragma("unroll") for (int m = 0; m < 4; ++m) _Pragma("unroll") for (int n = 0; n < 2; ++n) _Pragma("unroll") for (int k = 0; k < 2; ++k) \
        acc[ai][bj][m][n] = __builtin_amdgcn_mfma_f32_16x16x32_bf16(Bt[n][k], At[m][k], acc[ai][bj][m][n], 0, 0, 0); __builtin_amdgcn_s_setprio(0); } while (0)
#define PG8_WAIT_V(n) asm volatile("s_waitcnt vmcnt(" #n ")" ::: "memory")
#define PG8_WAIT_L(n) asm volatile("s_waitcnt lgkmcnt(" #n ")" ::: "memory")
#define PG8_BAR __builtin_amdgcn_s_barrier()
#define PG8_SCHED __builtin_amdgcn_sched_barrier(0)
    Unit cur, nxt; int ui = 0;
    if (!S.next(0, cur)) return;
    f32x4 acc[2][2][4][2];
#pragma unroll
    for (int a = 0; a < 2; ++a)
#pragma unroll
        for (int b = 0; b < 2; ++b)
#pragma unroll
            for (int m = 0; m < 4; ++m)
#pragma unroll
                for (int n = 0; n < 2; ++n) acc[a][b][m][n] = (f32x4){0.f, 0.f, 0.f, 0.f};
    bf16x8 At[4][2], B0[2][2], B1[2][2];
    const char* cA = (const char*)g.A + (size_t)cur.pm * tstep; const char* cB = (const char*)g.Bt + (size_t)cur.pn * tstep;
    S.a_ready(cur);
    if constexpr (SP2) {
        PG8_STAGE(PG8_SB(0, 0), cB, voffB); PG8_STAGE(PG8_SB(0, 1), cB + hstep, voffB); PG8_STAGE(PG8_SA(0, 0), cA, voffA); PG8_STAGE(PG8_SA(0, 1), cA + hstep, voffA);
        if (wr == 1) PG8_BAR;
        PG8_WAIT_V(2); PG8_BAR;
        PG8_STAGE(PG8_SB(1, 0), cB + kstep, voffB); PG8_STAGE(PG8_SA(1, 0), cA + kstep, voffA); PG8_STAGE(PG8_SB(1, 1), cB + hstep + kstep, voffB);
        PG8_WAIT_V(6); PG8_BAR;
    } else {
        PG8_STAGE(PG8_SB(0, 0), cB, voffB); PG8_STAGE(PG8_SA(0, 0), cA, voffA); PG8_STAGE(PG8_SB(0, 1), cB + hstep, voffB); PG8_STAGE(PG8_SA(0, 1), cA + hstep, voffA);
        if (wr == 1) PG8_BAR;
        PG8_WAIT_V(4); PG8_BAR;
        PG8_STAGE(PG8_SB(1, 0), cB + kstep, voffB); PG8_STAGE(PG8_SA(1, 0), cA + kstep, voffA); PG8_STAGE(PG8_SB(1, 1), cB + hstep + kstep, voffB);
        PG8_WAIT_V(6); PG8_BAR;
    }
    for (;;) {
        const bool has_next = S.next(ui + 1, nxt);
        const char* nA = has_next ? (const char*)g.A + (size_t)nxt.pm * tstep : cA; const char* nB = has_next ? (const char*)g.Bt + (size_t)nxt.pn * tstep : cB;
        for (int t = 0; t < nt; t += 2) {
            const bool last = (t == nt - 2);
            const char* a1 = cA + (size_t)(t + 1) * kstep;
            const char* a2 = last ? nA : cA + (size_t)(t + 2) * kstep; const char* b2 = last ? nB : cB + (size_t)(t + 2) * kstep;
            const char* a3 = a2 + kstep; const char* b3 = b2 + kstep;
            if (last && has_next) S.a_ready(nxt);
            if constexpr (SP2) {
            PG8_LDB(B0, 0, 0); PG8_LDB(B1, 0, 1); PG8_SCHED; PG8_LDA(At, 0, 0); PG8_STAGE(PG8_SA(1, 1), a1 + hstep, voffA);
            PG8_WAIT_V(8); PG8_WAIT_L(0); PG8_BAR; PG8_MMA(0, 0, At, B0); PG8_MMA(0, 1, At, B1); PG8_BAR; PG8_SCHED;
            PG8_LDA(At, 0, 1); PG8_STAGE(PG8_SB(0, 0), b2, voffB); PG8_STAGE(PG8_SB(0, 1), b2 + hstep, voffB); PG8_STAGE(PG8_SA(0, 0), a2, voffA);
            PG8_WAIT_V(8); PG8_WAIT_L(0); PG8_BAR; PG8_MMA(1, 0, At, B0); PG8_MMA(1, 1, At, B1); PG8_BAR; PG8_SCHED;
            PG8_LDB(B0, 1, 0); PG8_LDB(B1, 1, 1); PG8_SCHED; PG8_LDA(At, 1, 0); PG8_STAGE(PG8_SA(0, 1), a2 + hstep, voffA);
            PG8_WAIT_V(8); PG8_WAIT_L(0); PG8_BAR; PG8_MMA(0, 0, At, B0); PG8_MMA(0, 1, At, B1); PG8_BAR; PG8_SCHED;
            PG8_LDA(At, 1, 1); PG8_STAGE(PG8_SB(1, 0), b3, voffB); PG8_STAGE(PG8_SB(1, 1), b3 + hstep, voffB); PG8_STAGE(PG8_SA(1, 0), a3, voffA);
            PG8_WAIT_V(8); PG8_WAIT_L(0); PG8_BAR; PG8_MMA(1, 0, At, B0); PG8_MMA(1, 1, At, B1); PG8_BAR; PG8_SCHED;
            } else {
            PG8_LDB(B0, 0, 0); PG8_SCHED; PG8_LDA(At, 0, 0); PG8_STAGE(PG8_SA(1, 1), a1 + hstep, voffA);
            PG8_WAIT_L(8); PG8_BAR; PG8_WAIT_L(0); PG8_MMA(0, 0, At, B0); PG8_BAR; PG8_SCHED;
            PG8_LDB(B1, 0, 1); PG8_STAGE(PG8_SB(0, 0), b2, voffB);
            PG8_BAR; PG8_WAIT_L(0); PG8_MMA(0, 1, At, B1); PG8_BAR;
            PG8_LDA(At, 0, 1); PG8_STAGE(PG8_SA(0, 0), a2, voffA);
            PG8_BAR; PG8_WAIT_L(0); PG8_MMA(1, 0, At, B0); PG8_BAR; PG8_SCHED;
            PG8_STAGE(PG8_SB(0, 1), b2 + hstep, voffB);
            PG8_WAIT_V(6); PG8_BAR; PG8_MMA(1, 1, At, B1); PG8_BAR;
            PG8_LDB(B0, 1, 0); PG8_SCHED; PG8_LDA(At, 1, 0); PG8_STAGE(PG8_SA(0, 1), a2 + hstep, voffA);
            PG8_WAIT_L(8); PG8_BAR; PG8_WAIT_L(0); PG8_MMA(0, 0, At, B0); PG8_BAR; PG8_SCHED;
            PG8_LDB(B1, 1, 1); PG8_STAGE(PG8_SB(1, 0), b3, voffB);
            PG8_BAR; PG8_WAIT_L(0); PG8_MMA(0, 1, At, B1); PG8_BAR;
            PG8_LDA(At, 1, 1); PG8_STAGE(PG8_SA(1, 0), a3, voffA);
            PG8_BAR; PG8_WAIT_L(0); PG8_MMA(1, 0, At, B0); PG8_BAR; PG8_SCHED;
            PG8_STAGE(PG8_SB(1, 1), b3 + hstep, voffB);
            PG8_WAIT_V(6); PG8_BAR; PG8_MMA(1, 1, At, B1); PG8_BAR;
            }
        }
        if constexpr (ALIGN_EPI) { if (wr == 0) PG8_BAR; }
        if constexpr (!Epi::AFTER_DRAIN) { E(acc, cur, wr, wc, fr, fq); S.done(cur); }
        if (!has_next) break;
#pragma unroll
        for (int a = 0; a < 2; ++a)
#pragma unroll
            for (int b = 0; b < 2; ++b)
#pragma unroll
                for (int m = 0; m < 4; ++m)
#pragma unroll
                    for (int n = 0; n < 2; ++n) acc[a][b][m][n] = (f32x4){0.f, 0.f, 0.f, 0.f};
        cur = nxt; cA = nA; cB = nB; ++ui;
        if constexpr (ALIGN_EPI) { if (wr == 1) PG8_BAR; }
    }
    PG8_WAIT_V(0);
    if constexpr (!ALIGN_EPI) { if (wr == 0) PG8_BAR; }
    PG8_BAR;
    if constexpr (Epi::AFTER_DRAIN) { E.fused(acc, cur, wr, wc, fr, fq, lds, wid, lane); S.done(cur); }
#undef PG8_SA
#undef PG8_SB
#undef PG8_STAGE
#undef PG8_LDA
#undef PG8_LDB
#undef PG8_MMA
#undef PG8_WAIT_V
#undef PG8_WAIT_L
#undef PG8_BAR
#undef PG8_SCHED
}
}
#define XB_TMO      128
#define XB_XCNT(j)  (256  + 64 * (j))
#define XB_XSUB(j)  (1280 + 64 * (j))
#define XB_XGEN(j)  (2304 + 64 * (j))
#define XB_TOP      3328
#define XB_TOPGEN   3392
#define XCD_BAR_WORDS 3456
#define XB_SPIN_CAP (1u << 18)

__device__ __forceinline__ unsigned xb_ld(unsigned* p)              { return __hip_atomic_load(p, __ATOMIC_RELAXED, __HIP_MEMORY_SCOPE_AGENT); }
__device__ __forceinline__ unsigned xb_add(unsigned* p, unsigned v) { return __hip_atomic_fetch_add(p, v, __ATOMIC_RELAXED, __HIP_MEMORY_SCOPE_AGENT); }
__device__ __forceinline__ unsigned xb_xcc_id() { return (unsigned)__builtin_amdgcn_s_getreg((3 << 11) | 20) & 0xFu; }
#define XB_SPIN(cond, bar) do { unsigned _sp = 0; while (cond) { __builtin_amdgcn_s_sleep(1); \
    if ((++_sp & 255u) == 0u) { if (xb_ld(&(bar)[XB_TMO])) break; if (_sp > XB_SPIN_CAP) { atomicAdd(&(bar)[XB_TMO], 1u); break; } } } } while (0)

struct XcdBarrier {
    unsigned* bar; unsigned x;
    volatile LAS unsigned* st;
};

__device__ __forceinline__ XcdBarrier xcd_barrier_post(unsigned* bar, volatile LAS unsigned* st) {
    XcdBarrier b; b.bar = bar; b.x = xb_xcc_id(); b.st = st;
    if (threadIdx.x == 0) (void)xb_add(&bar[XB_XCNT(b.x)], 1u);
    return b;
}
__device__ __forceinline__ void xcd_barrier_complete(unsigned* bar, unsigned x, unsigned& nloc, unsigned& nx) {
    const unsigned G = gridDim.x * gridDim.y * gridDim.z;
    unsigned sum, cnt, mine, sp = 0u;
    for (;;) {
        sum = 0u; cnt = 0u; mine = 0u;
#pragma unroll
        for (unsigned j = 0; j < 16; ++j) { const unsigned c = xb_ld(&bar[XB_XCNT(j)]); sum += c; cnt += (c > 0u) ? 1u : 0u; mine = (j == x) ? c : mine; }
        if (sum == G) break;
        __builtin_amdgcn_s_sleep(1);
        if ((++sp & 255u) == 0u) { if (xb_ld(&bar[XB_TMO])) break; if (sp > XB_SPIN_CAP) { atomicAdd(&bar[XB_TMO], 1u); break; } }
    }
    nloc = mine > 0u ? mine : 1u; nx = cnt > 0u ? cnt : 1u;
}

__device__ __forceinline__ void xcd_barrier(const XcdBarrier& b) {
    asm volatile("s_waitcnt vmcnt(0)" ::: "memory");
    __syncthreads();
    if (threadIdx.x == 0) {
        unsigned* bar = b.bar;
        __builtin_amdgcn_s_waitcnt(0);
        unsigned nloc = b.st[0], nx = b.st[1];
        if (nloc == 0u) { xcd_barrier_complete(bar, b.x, nloc, nx); b.st[0] = nloc; b.st[1] = nx; }
        const unsigned old = xb_add(&bar[XB_XSUB(b.x)], 1u);
        const unsigned gen = old / nloc;
        if (old + 1u == (gen + 1u) * nloc) {
            __builtin_amdgcn_fence(__ATOMIC_RELEASE, "agent");
            asm volatile("s_waitcnt vmcnt(0)" ::: "memory");
            const unsigned og = xb_add(&bar[XB_TOP], 1u);
            const unsigned tg = og / nx;
            if (og + 1u == (tg + 1u) * nx) xb_add(&bar[XB_TOPGEN], 1u);
            else XB_SPIN(xb_ld(&bar[XB_TOPGEN]) == tg, bar);
            __builtin_amdgcn_fence(__ATOMIC_ACQUIRE, "agent");
            xb_add(&bar[XB_XGEN(b.x)], 1u);
            asm volatile("s_waitcnt vmcnt(0)" ::: "memory");
        } else {
            XB_SPIN(xb_ld(&bar[XB_XGEN(b.x)]) == gen, bar);
            __builtin_amdgcn_fence(__ATOMIC_ACQUIRE, "agent");
            asm volatile("s_waitcnt vmcnt(0)" ::: "memory");
        }
    }
    __syncthreads();
}

namespace att {
constexpr int PITCH = NIN;
constexpr int STAGE = 65536, SUB = 16384;
constexpr float THR2 = 11.5f;
#define KSWZ(row, colB) ((row) * 256 + ((colB) ^ (((row) & 7) << 4)))
#define SBAR() __builtin_amdgcn_sched_barrier(0)
__device__ __forceinline__ int v_rd_base(int lane) { return ((lane & 3) << 3) | (((lane >> 2) & 3) << 6) | (((lane >> 4) & 1) << 5) | (((lane >> 5) & 1) << 8); }
constexpr int v_rd_off(int d0, int ks, int half) { return d0 * 512 + ks * 4096 + half * 2048; }
__device__ __forceinline__ int crow(int r, int hi) { return (r & 3) + 8 * (r >> 2) + 4 * hi; }
__device__ __forceinline__ unsigned cvtpk(float lo, float hi) { unsigned r; asm volatile("v_cvt_pk_bf16_f32 %0, %1, %2" : "=v"(r) : "v"(lo), "v"(hi)); return r; }

__device__ __forceinline__ void qkt(f32x16& p0, f32x16& p1, const LAS unsigned char* Ks, int r32, int hi, const bf16x8* qr) {
    const LAS unsigned char* kb[4];
#pragma unroll
    for (int dd = 0; dd < 4; ++dd) kb[dd] = Ks + KSWZ(r32, (dd * 16 + hi * 8) * 2);
#pragma unroll
    for (int d0 = 0; d0 < 8; ++d0) { const LAS unsigned char* a = kb[d0 & 3] + (d0 >> 2) * 128;
        const bf16x8 b0 = *(const LAS bf16x8*)a;
        const bf16x8 b1 = *(const LAS bf16x8*)(a + 32 * 256);
        p0 = __builtin_amdgcn_mfma_f32_32x32x16_bf16(b0, qr[d0], p0, 0, 0, 0);
        p1 = __builtin_amdgcn_mfma_f32_32x32x16_bf16(b1, qr[d0], p1, 0, 0, 0); }
}
__device__ __forceinline__ void pv_tile(f32x16* o, unsigned vb0, bf16x8 pa0, bf16x8 pa1, bf16x8 pa2, bf16x8 pa3) {
#define TRRD(dst, off) asm volatile("ds_read_b64_tr_b16 %0, %1 offset:%2" : "=&v"(dst) : "v"(vb0), "i"(off) : "memory")
#define PV_D0(d0) do { s16x4 l0, l1, l2, l3, h0, h1, h2, h3; constexpr int b_ = v_rd_off(d0, 0, 0); \
        TRRD(l0, b_); TRRD(h0, b_ + 2048); TRRD(l1, b_ + 4096); TRRD(h1, b_ + 6144); TRRD(l2, b_ + 8192); TRRD(h2, b_ + 10240); TRRD(l3, b_ + 12288); TRRD(h3, b_ + 14336); \
        asm volatile("s_waitcnt lgkmcnt(0)" ::: "memory"); SBAR(); \
        o[d0] = __builtin_amdgcn_mfma_f32_32x32x16_bf16(pa0, (bf16x8){l0[0], l0[1], l0[2], l0[3], h0[0], h0[1], h0[2], h0[3]}, o[d0], 0, 0, 0); \
        o[d0] = __builtin_amdgcn_mfma_f32_32x32x16_bf16(pa1, (bf16x8){l1[0], l1[1], l1[2], l1[3], h1[0], h1[1], h1[2], h1[3]}, o[d0], 0, 0, 0); \
        o[d0] = __builtin_amdgcn_mfma_f32_32x32x16_bf16(pa2, (bf16x8){l2[0], l2[1], l2[2], l2[3], h2[0], h2[1], h2[2], h2[3]}, o[d0], 0, 0, 0); \
        o[d0] = __builtin_amdgcn_mfma_f32_32x32x16_bf16(pa3, (bf16x8){l3[0], l3[1], l3[2], l3[3], h3[0], h3[1], h3[2], h3[3]}, o[d0], 0, 0, 0); } while (0)
    PV_D0(0); PV_D0(1); PV_D0(2); PV_D0(3);
#undef PV_D0
#undef TRRD
}
__device__ __forceinline__ void glds16(const bf16* g, LAS unsigned char* l) {
    __builtin_amdgcn_global_load_lds((const unsigned*)g, (LAS unsigned*)l, 16, 0, 0);
}

template <int DIFF, int HF>
__device__ __forceinline__ void half_step(f32x16* o, float& m_reg, float& l_reg, const bf16x8* qr, const LAS unsigned char* Kst, unsigned vb0, LAS float* al_l,
                                          int kbh, int q0, int r32, int hi, float slope2, bool selbit) {
    constexpr int NO = DIFF ? 8 : 4;
    if (kbh > q0 + 31) return;
    float binit = slope2 * (float)(kbh - (q0 + r32) + 4 * hi);
    if (!selbit) binit = -__builtin_inff();
    f32x16 p;
#pragma unroll
    for (int r = 0; r < 16; ++r) p[r] = fmaf(slope2, (float)((r & 3) + 8 * (r >> 2)), binit);
    {
        const LAS unsigned char* kb4[4];
#pragma unroll
        for (int dd = 0; dd < 4; ++dd) kb4[dd] = Kst + KSWZ(r32, (dd * 16 + hi * 8) * 2) + HF * 8192;
#pragma unroll
        for (int d0 = 0; d0 < 8; ++d0) p = __builtin_amdgcn_mfma_f32_32x32x16_bf16(*(const LAS bf16x8*)(kb4[d0 & 3] + (d0 >> 2) * 128), qr[d0], p, 0, 0, 0);
    }
    if (kbh + 31 > q0) {
        const int dq = q0 + r32 - kbh - 4 * hi; const float NEG = -__builtin_inff();
#pragma unroll
        for (int r = 0; r < 16; ++r) { const int c = (r & 3) + 8 * (r >> 2); if (c > dq) p[r] = NEG; }
    }
    float pmax = p[0];
#pragma unroll
    for (int r = 1; r < 16; ++r) pmax = fmaxf(pmax, p[r]);
    pmax = fmaxf(pmax, __shfl_xor(pmax, 32));
    float mn, alpha;
    if (__all(pmax - m_reg <= THR2)) { mn = m_reg; alpha = 1.f; }
    else { mn = fmaxf(m_reg, pmax); alpha = __builtin_amdgcn_exp2f(m_reg - mn); m_reg = mn; }
#pragma unroll
    for (int r = 0; r < 16; ++r) p[r] = __builtin_amdgcn_exp2f(p[r] - mn);
    float ps = 0.f;
#pragma unroll
    for (int r = 0; r < 16; ++r) ps += p[r];
    ps += __shfl_xor(ps, 32);
    l_reg = l_reg * alpha + ps;
    bf16x8 pa0, pa1;
#define PK4(P, B_, OUT) do { unsigned a0 = cvtpk(P[B_ + 0], P[B_ + 1]), a1 = cvtpk(P[B_ + 2], P[B_ + 3]); \
        unsigned b0 = cvtpk(P[B_ + 4], P[B_ + 5]), b1 = cvtpk(P[B_ + 6], P[B_ + 7]); \
        auto r0 = __builtin_amdgcn_permlane32_swap(a0, b0, false, false); auto r1 = __builtin_amdgcn_permlane32_swap(a1, b1, false, false); \
        u32x4 w = {r0[0], r1[0], r0[1], r1[1]}; OUT = __builtin_bit_cast(bf16x8, w); } while (0)
    PK4(p, 0, pa0); PK4(p, 8, pa1);
#undef PK4
    if (__any(alpha < 1.f)) {
        if (hi == 0) al_l[r32] = alpha;
        asm volatile("s_waitcnt lgkmcnt(0)" ::: "memory");
#pragma unroll
        for (int r = 0; r < 16; ++r) { const float a = al_l[crow(r, hi)];
#pragma unroll
            for (int d = 0; d < NO; ++d) o[d][r] *= a; }
    }
    SBAR();
#define TRRD(dst, off) asm volatile("ds_read_b64_tr_b16 %0, %1 offset:%2" : "=&v"(dst) : "v"(vb0), "i"(off) : "memory")
#define PV_D0(d0, vsub) do { s16x4 l0, l1, h0, h1; constexpr int b_ = (vsub) * SUB + v_rd_off(d0, 2 * HF, 0); \
        TRRD(l0, b_); TRRD(h0, b_ + 2048); TRRD(l1, b_ + 4096); TRRD(h1, b_ + 6144); \
        asm volatile("s_waitcnt lgkmcnt(0)" ::: "memory"); SBAR(); \
        o[(vsub) * 4 + d0] = __builtin_amdgcn_mfma_f32_32x32x16_bf16(pa0, (bf16x8){l0[0], l0[1], l0[2], l0[3], h0[0], h0[1], h0[2], h0[3]}, o[(vsub) * 4 + d0], 0, 0, 0); \
        o[(vsub) * 4 + d0] = __builtin_amdgcn_mfma_f32_32x32x16_bf16(pa1, (bf16x8){l1[0], l1[1], l1[2], l1[3], h1[0], h1[1], h1[2], h1[3]}, o[(vsub) * 4 + d0], 0, 0, 0); } while (0)
    PV_D0(0, 0); PV_D0(1, 0); PV_D0(2, 0); PV_D0(3, 0);
    if (DIFF) { PV_D0(0, 1); PV_D0(1, 1); PV_D0(2, 1); PV_D0(3, 1); }
#undef PV_D0
#undef TRRD
}

template <int DIFF>
__device__ __forceinline__ void attn_unit(LAS unsigned char* lds, const bf16* __restrict__ proj, bf16* __restrict__ mixed, const bf16* __restrict__ kmean,
                                          int b, int h, int idx, float lam, const float* __restrict__ subw) {
    constexpr int NO = DIFF ? 8 : 4;
    const int tid = threadIdx.x, lane = tid & 63, wid = __builtin_amdgcn_readfirstlane(tid >> 6), r32 = lane & 31, hi = lane >> 5;
    const int rg = wid & 3, comp = wid >> 2;
    const int q0 = DIFF ? (128 * idx + 32 * rg) : (256 * idx + 32 * wid);
    const size_t rowbase = (size_t)b * SEQ;
    const int qcol = DIFF ? (3072 + 256 * h + 128 * comp) : (128 * h);
    const int kcol = DIFF ? (4096 + 256 * h) : (1024 + 128 * h);
    const int vcol = DIFF ? (5120 + 256 * h) : (2048 + 128 * h);
    const float slope2 = (DIFF ? __builtin_amdgcn_exp2f(-2.f * (float)(h + 1)) : __builtin_amdgcn_exp2f(-(float)(h + 1))) * LOG2E;
    const int NT = DIFF ? 2 * (idx + 1) : 4 * (idx + 1);
    int koff, voff;
    { const int row = 4 * wid + (lane >> 4), ch = (lane & 15) ^ (row & 7); koff = row * PITCH + 8 * ch;
      const int sub = 2 * wid + (lane >> 5), kk = 8 * (sub >> 2) + ((lane & 31) >> 2), k = (kk & ~0xC) | ((kk & 4) << 1) | ((kk & 8) >> 1), c = 32 * (sub & 3) + 8 * (lane & 3);
      voff = k * PITCH + c; }
    LAS unsigned char* const dst0 = lds + wid * 1024;
#define ISSUE_TILE(st, kb_) do { const bf16* g_ = proj + (rowbase + (size_t)(kb_)) * PITCH; LAS unsigned char* d_ = dst0 + (st) * STAGE; \
        _Pragma("unroll") for (int i_ = 0; i_ < 2; ++i_) { \
            glds16(g_ + kcol + koff + i_ * 32 * PITCH, d_ + i_ * 8192); \
            if (DIFF) { glds16(g_ + kcol + 128 + koff + i_ * 32 * PITCH, d_ + SUB + i_ * 8192); \
                        glds16(g_ + vcol + voff + i_ * 32 * PITCH, d_ + 2 * SUB + i_ * 8192); \
                        glds16(g_ + vcol + 128 + voff + i_ * 32 * PITCH, d_ + 3 * SUB + i_ * 8192); } \
            else { glds16(g_ + vcol + voff + i_ * 32 * PITCH, d_ + SUB + i_ * 8192); } } } while (0)
#define TILE_KB(t_) (DIFF ? 64 * (t_) : ((t_) < 4 ? 256 * idx + 64 * (t_) : 256 * (((t_) - 4) >> 2) + 64 * (((t_) - 4) & 3)))
    ISSUE_TILE(0, TILE_KB(0));
    if (!DIFF && idx > 0) {
        const int row = 4 * wid + (lane >> 4), ch = (lane & 15) ^ (row & 7);
        glds16(kmean + ((size_t)(b * 8 + h) * 32 + row) * 128 + 8 * ch, dst0 + STAGE);
    }
    bf16x8 qr[8];
    { const bf16* qp = proj + (rowbase + q0 + r32) * PITCH + qcol + hi * 8;
#pragma unroll
      for (int d0 = 0; d0 < 8; ++d0) qr[d0] = *(const bf16x8*)(qp + d0 * 16); }
    LAS float* const al_l = (LAS float*)(lds + ATT_SCR_OFF + wid * 512);
    LAS float* const li_l = al_l + 32;
    unsigned sel = 0u;
    if (!DIFF && idx > 0) {
        asm volatile("s_waitcnt vmcnt(0)" ::: "memory"); __syncthreads();
        f32x16 g = {};
        { const LAS unsigned char* Ks = lds + STAGE;
#pragma unroll
          for (int d0 = 0; d0 < 8; ++d0) { const LAS unsigned char* a = Ks + KSWZ(r32, ((d0 & 3) * 16 + hi * 8) * 2) + (d0 >> 2) * 128;
              g = __builtin_amdgcn_mfma_f32_32x32x16_bf16(*(const LAS bf16x8*)a, qr[d0], g, 0, 0, 0); } }
        float gv[16]; int gn[16];
#pragma unroll
        for (int r = 0; r < 8; ++r) { const int nb = (r & 3) + 8 * (r >> 2);
            gv[r] = g[r]; gn[r] = nb + 4 * hi; gv[8 + r] = __shfl_xor(g[r], 32); gn[8 + r] = nb + 4 * (1 - hi); }
        const float NEG = -__builtin_inff();
        float m1 = NEG, m2 = NEG, m3 = NEG;
#pragma unroll
        for (int i = 0; i < 16; ++i) { float v = gn[i] < idx ? gv[i] : NEG;
            float t1 = fmaxf(m1, v); v = fminf(m1, v); m1 = t1; float t2 = fmaxf(m2, v); v = fminf(m2, v); m2 = t2; m3 = fmaxf(m3, v); }
#pragma unroll
        for (int i = 0; i < 16; ++i) if (gn[i] < idx && gv[i] >= m3) sel |= 1u << gn[i];
    }
    float m_reg = -1e30f, l_reg = 0.f;
    f32x16 o[NO];
#pragma unroll
    for (int d = 0; d < NO; ++d) o[d] = f32x16{};
    const unsigned ldsu = (unsigned)(uintptr_t)lds;
    const int ksub = DIFF ? comp : 0;
    for (int t = 0; t < NT; ++t) {
        asm volatile("s_waitcnt vmcnt(0)" ::: "memory"); __syncthreads();
        if (t + 1 < NT) ISSUE_TILE((t + 1) & 1, TILE_KB(t + 1));
        const int kb = TILE_KB(t);
        const bool past = !DIFF && t >= 4;
        const bool selbit = past ? (((sel >> ((t - 4) >> 2)) & 1u) != 0u) : true;
        const int stoff = (t & 1) * STAGE;
        const LAS unsigned char* Kst = lds + stoff + ksub * SUB;
        const unsigned vb0 = ldsu + stoff + (DIFF ? 2 : 1) * SUB + v_rd_base(lane);
        half_step<DIFF, 0>(o, m_reg, l_reg, qr, Kst, vb0, al_l, kb, q0, r32, hi, slope2, selbit);
        half_step<DIFF, 1>(o, m_reg, l_reg, qr, Kst, vb0, al_l, kb + 32, q0, r32, hi, slope2, selbit);
    }
    if (hi == 0) li_l[r32] = l_reg;
    asm volatile("s_waitcnt lgkmcnt(0)" ::: "memory");
    float rli[16];
#pragma unroll
    for (int r = 0; r < 16; ++r) rli[r] = __builtin_amdgcn_rcpf(li_l[crow(r, hi)]);
    if (!DIFF) {
        bf16* Ow = mixed + (rowbase + q0) * D + 128 * h;
#pragma unroll
        for (int r = 0; r < 16; ++r) { const int orow = crow(r, hi);
#pragma unroll
            for (int d0 = 0; d0 < 4; ++d0) { const float v = o[d0][r] * rli[r]; const float vn = __shfl_xor(v, 1);
                if ((r32 & 1) == 0) *(unsigned*)(Ow + (size_t)orow * D + d0 * 32 + r32) = cvtpk(v, vn); } }
        __syncthreads();
    } else {
        __syncthreads();
        LAS float* xb = (LAS float*)(lds + rg * 32768) + lane;
        if (comp == 1) {
#pragma unroll
            for (int d0 = 0; d0 < 8; ++d0)
#pragma unroll
                for (int r = 0; r < 16; ++r) xb[(d0 * 16 + r) * 64] = lam * o[d0][r] * rli[r];
        }
        __syncthreads();
        if (comp == 0) {
            float ssq[16];
#pragma unroll
            for (int r = 0; r < 16; ++r) ssq[r] = 0.f;
#pragma unroll
            for (int d0 = 0; d0 < 8; ++d0)
#pragma unroll
                for (int r = 0; r < 16; ++r) { const float dv = o[d0][r] * rli[r] - xb[(d0 * 16 + r) * 64]; o[d0][r] = dv; ssq[r] += dv * dv; }
#pragma unroll
            for (int r = 0; r < 16; ++r) { float s = ssq[r]; s += __shfl_xor(s, 1); s += __shfl_xor(s, 2); s += __shfl_xor(s, 4); s += __shfl_xor(s, 8); s += __shfl_xor(s, 16);
                ssq[r] = __builtin_amdgcn_rsqf(s * (1.f / 256.f) + RMS_EPS) * 0.8f; }
            bf16* Ow = mixed + (rowbase + q0) * D + 1024 + 256 * h;
#pragma unroll
            for (int d0 = 0; d0 < 8; ++d0) { const float wv = subw[d0 * 32 + r32];
#pragma unroll
                for (int r = 0; r < 16; ++r) { const float v = o[d0][r] * ssq[r] * wv; const float vn = __shfl_xor(v, 1);
                    if ((r32 & 1) == 0) *(unsigned*)(Ow + (size_t)crow(r, hi) * D + d0 * 32 + r32) = cvtpk(v, vn); } }
        }
        __syncthreads();
    }
#undef ISSUE_TILE
#undef TILE_KB
}

struct UnitTab { unsigned v[512]; };
constexpr UnitTab make_units() {
    UnitTab t{}; int n = 0, dj = 31, mi = 15;
    while (dj >= 0 || mi >= 0) {
        const int cd = dj >= 0 ? (dj + 1) * 6144 : -1, cm = mi >= 0 ? (mi + 1) * 8192 : -1;
        if (cd >= cm) { for (int b = 0; b < 2; ++b) for (int h = 0; h < 4; ++h) t.v[n++] = (1u << 16) | ((unsigned)b << 12) | ((unsigned)h << 8) | (unsigned)dj; --dj; }
        else { for (int b = 0; b < 2; ++b) for (int h = 0; h < 8; ++h) t.v[n++] = ((unsigned)b << 12) | ((unsigned)h << 8) | (unsigned)mi; --mi; }
    }
    return t;
}
__constant__ UnitTab g_units = make_units();
#undef KSWZ
#undef SBAR
}

__device__ __forceinline__ void tr_item(const float* __restrict__ W, int N, int K, int k0, int n0, bf16* __restrict__ dst, LAS unsigned* scr, int lane) {
    { const int kr = lane >> 4, nc = (lane & 15) * 4;
      f32x4 v[16];
#pragma unroll
      for (int i = 0; i < 16; ++i) v[i] = *(const f32x4*)(W + (size_t)(k0 + 4 * i + kr) * N + n0 + nc);
#pragma unroll
      for (int i = 0; i < 16; ++i) { const int k = 4 * i + kr; scr[k * 33 + (nc >> 1)] = pk2(v[i][0], v[i][1]); scr[k * 33 + (nc >> 1) + 1] = pk2(v[i][2], v[i][3]); } }
    asm volatile("s_waitcnt lgkmcnt(0)" ::: "memory");
    { const int np = lane >> 3, c = lane & 7;
#pragma unroll
      for (int j = 0; j < 4; ++j) { const int n2 = np + 8 * j; unsigned d[8];
#pragma unroll
          for (int i = 0; i < 8; ++i) d[i] = scr[(8 * c + i) * 33 + n2];
          u32x4 lo, hi;
          lo.x = (d[0] & 0xffffu) | (d[1] << 16); lo.y = (d[2] & 0xffffu) | (d[3] << 16); lo.z = (d[4] & 0xffffu) | (d[5] << 16); lo.w = (d[6] & 0xffffu) | (d[7] << 16);
          hi.x = (d[0] >> 16) | (d[1] & 0xffff0000u); hi.y = (d[2] >> 16) | (d[3] & 0xffff0000u); hi.z = (d[4] >> 16) | (d[5] & 0xffff0000u); hi.w = (d[6] >> 16) | (d[7] & 0xffff0000u);
          *(u32x4*)(dst + (size_t)(2 * n2) * K + k0 + 8 * c) = lo;
          *(u32x4*)(dst + (size_t)(2 * n2 + 1) * K + k0 + 8 * c) = hi; } }
    asm volatile("s_waitcnt lgkmcnt(0)" ::: "memory");
}
__device__ __forceinline__ void rms_row_to_bf16(const float* __restrict__ xrow, const float* __restrict__ w, bf16* __restrict__ orow, int lane) {
    const f32x4* xr = (const f32x4*)xrow + lane; const f32x4* wr = (const f32x4*)w + lane;
    f32x4 v[8]; float s = 0.f;
#pragma unroll
    for (int j = 0; j < 8; ++j) { v[j] = xr[64 * j]; s += (v[j][0] * v[j][0] + v[j][1] * v[j][1]) + (v[j][2] * v[j][2] + v[j][3] * v[j][3]); }
    const float rstd = __builtin_amdgcn_rsqf(wave_sum(s) * (1.f / D) + RMS_EPS);
    u32x2* o8 = (u32x2*)orow + lane;
#pragma unroll
    for (int j = 0; j < 8; ++j) { const f32x4 ww = wr[64 * j]; u32x2 p; p.x = pk2(v[j][0] * rstd * ww[0], v[j][1] * rstd * ww[1]); p.y = pk2(v[j][2] * rstd * ww[2], v[j][3] * rstd * ww[3]); o8[64 * j] = p; }
}


struct Args { const float* in[18]; float* out; unsigned char* ws; int ph_lo, ph_hi; };
__global__ void __launch_bounds__(NWAVES * 64, 2) trunk_fwd(Args args) {
    extern __shared__ __attribute__((aligned(16))) unsigned char lds_raw[];
    LAS unsigned char* const lds = (LAS unsigned char*)lds_raw;
    volatile LAS unsigned* const MISC = (volatile LAS unsigned*)(lds + MISC_OFF);
    const int tid = threadIdx.x, lane = tid & 63, wave = __builtin_amdgcn_readfirstlane(tid >> 6);
    const int G = gridDim.x, bx = blockIdx.x;
    const int gw = bx * NWAVES + wave, NGW = G * NWAVES;
    unsigned char* const ws = args.ws;
    unsigned* const ctl = (unsigned*)(ws + WS_CTL);
    const float* const x = args.in[0];
    bf16* const WinT = (bf16*)(ws + WS_WIN); bf16* const WoutT = (bf16*)(ws + WS_WOUT); bf16* const Hb = (bf16*)(ws + WS_H);
    bf16* const WguT = (bf16*)(ws + WS_WGU); bf16* const WdT = (bf16*)(ws + WS_WD);
    bf16* const PROJ = (bf16*)(ws + WS_PROJ); bf16* const XP = (bf16*)(ws + WS_XP); bf16* const MIX = (bf16*)(ws + WS_MIX); bf16* const ACT = (bf16*)(ws + WS_ACT);
    float* const X1 = (float*)(ws + WS_X1); bf16* const Y = (bf16*)(ws + WS_Y);
    bf16* const KMEAN = (bf16*)(ws + WS_KMEAN); u32x4* const TOKINFO = (u32x4*)(ws + WS_TOKINFO); float* const TOKRSTD = (float*)(ws + WS_TOKRSTD);
    int* const ROWINFO = (int*)(ws + WS_ROWINFO); bf16* const WRHI = (bf16*)(ws + WS_WRHI); bf16* const WRLO = (bf16*)(ws + WS_WRLO);

    for (int u = tid; u < (LDS_BYTES - ATT_SCR_OFF) / 4; u += NWAVES * 64) ((LAS unsigned*)(lds + ATT_SCR_OFF))[u] = 0u;
    __syncthreads();
    XcdBarrier bar; bar.bar = ctl + CW_BAR; bar.x = 0; bar.st = nullptr;
    if (N_LAUNCHES == 1) bar = xcd_barrier_post(ctl + CW_BAR, MISC + 8);
#define GRID_BAR() do { if (N_LAUNCHES == 1) xcd_barrier(bar); } while (0)
    const int lo = args.ph_lo, hi_ph = args.ph_hi;
#ifndef PH_MASK
#define PH_MASK 0x3ff
#endif
#define IN(k) (((PH_MASK >> (k)) & 1) && lo <= (k) && (k) < hi_ph)
#define BOTH(k) (IN(k) && IN((k) + 1))

    if (IN(0)) {
        LAS unsigned* scr = (LAS unsigned*)(lds + wave * 16384);
        constexpr int I_IN = 32 * 96, I_OUT = 32 * 32, I_G = 32 * 8 * 32, I_D = 8 * 32 * 32;
        constexpr int NITEMS = I_IN + I_OUT + 2 * I_G + I_D;
        for (int it = gw; it < NITEMS; it += NGW) {
            int r = it;
            if (r < I_IN) { const int kb = r / 96, nb = r % 96; tr_item(args.in[2], NIN, D, 64 * kb, 64 * nb, WinT + (size_t)(64 * nb) * D, scr, lane); continue; } r -= I_IN;
            if (r < I_OUT) { const int kb = r / 32, nb = r % 32; tr_item(args.in[8], D, D, 64 * kb, 64 * nb, WoutT + (size_t)(64 * nb) * D, scr, lane); continue; } r -= I_OUT;
            if (r < 2 * I_G) { const int up = r >= I_G ? 1 : 0; if (up) r -= I_G; const int e = r >> 8, q = r & 255, kb = q >> 3, nb = q & 7, n0 = 64 * nb;
                const float* W = (up ? args.in[15] : args.in[14]) + (size_t)e * D * DE;
                tr_item(W, DE, D, 64 * kb, n0, WguT + ((size_t)e * 1024 + (n0 >> 7) * 256 + (n0 & 127) + up * 128) * D, scr, lane); continue; } r -= 2 * I_G;
            { const int e = r >> 8, q = r & 255, kb = q >> 5, nb = q & 31;
              tr_item(args.in[16] + (size_t)e * DE * D, D, DE, 64 * kb, 64 * nb, WdT + ((size_t)e * 2048 + 64 * nb) * DE, scr, lane); }
        }
        for (int i = bx * 512 + tid; i < 48 * D; i += G * 512) { const int c = i / D, k = i % D;
            const float v = c < 4 ? args.in[10][k * 4 + c] : (c < 36 ? args.in[12][k * 32 + (c - 4)] : 0.f);
            const unsigned h = f2bf(v); WRHI[i] = (bf16)h; WRLO[i] = (bf16)f2bf(v - bf2f(h)); }
        for (int m = gw; m < T; m += NGW) rms_row_to_bf16(x + (size_t)m * D, args.in[1], Hb + (size_t)m * D, lane);
        if (BOTH(0)) GRID_BAR();
    }

    if (IN(1)) {
        pg8::Gemm g{Hb, WinT, T, NIN, D}; pg8::StaticOrder S; S.init(T, NIN, G, bx);
        pg8::EpiProj E{PROJ, NIN, QSCALE};
        pg8::gemm_phase<pg8::EpiProj, pg8::StaticOrder, true, true>(lds, g, S, E);
        if (BOTH(1)) GRID_BAR();
    }

    if (IN(2)) {
        LAS float* red = (LAS float*)lds;
        for (int u = bx; u < 256; u += G) { const int bh = u >> 4, blk = u & 15, b = bh >> 3, h = bh & 7;
            const bf16* kp = PROJ + ((size_t)b * SEQ + 256 * blk + 32 * wave) * NIN + 1024 + 128 * h + 2 * lane;
            float s0 = 0.f, s1 = 0.f;
#pragma unroll 8
            for (int r = 0; r < 32; ++r) { const unsigned v = *(const unsigned*)(kp + (size_t)r * NIN); s0 += bf2f(v & 0xffffu); s1 += bf2f(v >> 16); }
            red[wave * 128 + 2 * lane] = s0; red[wave * 128 + 2 * lane + 1] = s1;
            __syncthreads();
            if (tid < 128) { float s = 0.f;
#pragma unroll
                for (int w = 0; w < 8; ++w) s += red[w * 128 + tid];
                KMEAN[((size_t)bh * 32 + blk) * 128 + tid] = (bf16)f2bf(s * (1.f / 256.f)); }
            if (blk == 0) { for (int i = tid; i < 16 * 128; i += 512) KMEAN[((size_t)bh * 32 + 16) * 128 + i] = 0; }
            __syncthreads();
        }
        if (BOTH(2)) GRID_BAR();
    }

    if (IN(3)) {
        float lam;
        { const float a = args.in[3][lane] * args.in[4][lane] + args.in[3][lane + 64] * args.in[4][lane + 64];
          const float c = args.in[5][lane] * args.in[6][lane] + args.in[5][lane + 64] * args.in[6][lane + 64];
          lam = __expf(wave_sum(a)) - __expf(wave_sum(c)) + 0.2f; }
        for (;;) {
            if (tid == 0) MISC[16] = __hip_atomic_fetch_add(ctl + CW_QHEAD, 1u, __ATOMIC_RELAXED, __HIP_MEMORY_SCOPE_AGENT);
            __syncthreads();
            const unsigned qi = __builtin_amdgcn_readfirstlane(MISC[16]);
            if (qi >= 512u) break;
            const unsigned e = att::g_units.v[qi]; const int ty = (int)(e >> 16), b = (int)((e >> 12) & 15u), h = (int)((e >> 8) & 15u), idx = (int)(e & 255u);
            if (ty) att::attn_unit<1>(lds, PROJ, MIX, KMEAN, b, h, idx, lam, args.in[7]);
            else att::attn_unit<0>(lds, PROJ, MIX, KMEAN, b, h, idx, lam, args.in[7]);
        }
        if (BOTH(3)) GRID_BAR();
    }

    if (IN(4)) {
        pg8::Gemm g{MIX, WoutT, T, D, D}; pg8::StaticOrder S; S.init(T, D, G, bx);
        pg8::EpiResid E{x, X1, D};
        pg8::gemm_phase<pg8::EpiResid, pg8::StaticOrder, false, true>(lds, g, S, E);
        if (BOTH(4)) GRID_BAR();
    }

    if (IN(5)) {
        LAS float* lg = (LAS float*)(lds + wave * 4096);
        const float* nw = args.in[9];
        for (int tile = wave * G + bx; tile < T / 16; tile += NGW) {
            const int t0 = tile * 16, row = lane & 15, kq = lane >> 4;
            const float* xr = X1 + (size_t)(t0 + row) * D + 8 * kq;
            pg8::f32x4 acc[3] = {{0.f, 0.f, 0.f, 0.f}, {0.f, 0.f, 0.f, 0.f}, {0.f, 0.f, 0.f, 0.f}};
            float ss = 0.f;
#pragma unroll 2
            for (int s = 0; s < 64; ++s) {
                const f32x4 a0 = *(const f32x4*)(xr + 32 * s), a1 = *(const f32x4*)(xr + 32 * s + 4);
                const f32x4 w0 = *(const f32x4*)(nw + 32 * s + 8 * kq), w1 = *(const f32x4*)(nw + 32 * s + 8 * kq + 4);
                ss += (a0[0] * a0[0] + a0[1] * a0[1]) + (a0[2] * a0[2] + a0[3] * a0[3]) + (a1[0] * a1[0] + a1[1] * a1[1]) + (a1[2] * a1[2] + a1[3] * a1[3]);
                const f32x4 u0 = a0 * w0, u1 = a1 * w1;
                unsigned hb[8]; float uf[8] = {u0[0], u0[1], u0[2], u0[3], u1[0], u1[1], u1[2], u1[3]};
                u32x4 ah, al;
#pragma unroll
                for (int j = 0; j < 8; ++j) hb[j] = f2bf(uf[j]);
                ah.x = hb[0] | (hb[1] << 16); ah.y = hb[2] | (hb[3] << 16); ah.z = hb[4] | (hb[5] << 16); ah.w = hb[6] | (hb[7] << 16);
                al.x = pk2(uf[0] - bf2f(hb[0]), uf[1] - bf2f(hb[1])); al.y = pk2(uf[2] - bf2f(hb[2]), uf[3] - bf2f(hb[3]));
                al.z = pk2(uf[4] - bf2f(hb[4]), uf[5] - bf2f(hb[5])); al.w = pk2(uf[6] - bf2f(hb[6]), uf[7] - bf2f(hb[7]));
                const bf16x8 afh = __builtin_bit_cast(bf16x8, ah), afl = __builtin_bit_cast(bf16x8, al);
#pragma unroll
                for (int ct = 0; ct < 3; ++ct) { const size_t wo = (size_t)(16 * ct + row) * D + 32 * s + 8 * kq;
                    const bf16x8 bh = *(const bf16x8*)(WRHI + wo), bl = *(const bf16x8*)(WRLO + wo);
                    acc[ct] = __builtin_amdgcn_mfma_f32_16x16x32_bf16(afh, bh, acc[ct], 0, 0, 0);
                    acc[ct] = __builtin_amdgcn_mfma_f32_16x16x32_bf16(afh, bl, acc[ct], 0, 0, 0);
                    acc[ct] = __builtin_amdgcn_mfma_f32_16x16x32_bf16(afl, bh, acc[ct], 0, 0, 0); }
            }
            ss += __shfl_xor(ss, 16); ss += __shfl_xor(ss, 32);
            const float rstd = __builtin_amdgcn_rsqf(ss * (1.f / D) + RMS_EPS);
#pragma unroll
            for (int ct = 0; ct < 3; ++ct)
#pragma unroll
                for (int r = 0; r < 4; ++r) lg[(4 * kq + r) * 48 + 16 * ct + row] = acc[ct][r];
            if (kq == 0) lg[768 + row] = rstd;
            asm volatile("s_waitcnt lgkmcnt(0)" ::: "memory");
            if (lane < 16) {
                const LAS float* L = lg + lane * 48; const float rs = lg[768 + lane];
                float gmax = -__builtin_inff(); int gi = 0; float gl[4];
#pragma unroll
                for (int c = 0; c < 4; ++c) { gl[c] = L[c] * rs + args.in[11][c]; if (gl[c] > gmax) { gmax = gl[c]; gi = c; } }
                float gsum = 0.f;
#pragma unroll
                for (int c = 0; c < 4; ++c) gsum += __expf(gl[c] - gmax);
                const float gp = 1.f / gsum;
                float el[8], emax = -__builtin_inff();
#pragma unroll
                for (int j = 0; j < 8; ++j) { el[j] = L[4 + 8 * gi + j] * rs + args.in[13][8 * gi + j]; emax = fmaxf(emax, el[j]); }
                float p0v = -1.f, p1v = -1.f; int i0 = 0, i1 = 0;
#pragma unroll
                for (int j = 0; j < 8; ++j) { const float p = __expf(el[j] - emax);
                    if (p > p0v) { p1v = p0v; i1 = i0; p0v = p; i0 = j; } else if (p > p1v) { p1v = p; i1 = j; } }
                const float inv = gp / (p0v + p1v);
                const int e0 = 8 * gi + i0, e1 = 8 * gi + i1;
                u32x4 info; info.x = (unsigned)e0; info.y = (unsigned)e1; info.z = __builtin_bit_cast(unsigned, p0v * inv); info.w = __builtin_bit_cast(unsigned, p1v * inv);
                TOKINFO[t0 + lane] = info; TOKRSTD[t0 + lane] = rs;
                atomicAdd(ctl + CW_ECNT + e0, 1u); atomicAdd(ctl + CW_ECNT + e1, 1u);
            }
            asm volatile("s_waitcnt lgkmcnt(0)" ::: "memory");
        }
        if (BOTH(5)) GRID_BAR();
    }

    LAS int* const tab = (LAS int*)(lds + MOE_TAB_OFF);
    if (IN(6) || IN(7) || IN(8)) {
        if (tid < 32) tab[120 + tid] = (int)__hip_atomic_load(ctl + CW_ECNT + tid, __ATOMIC_RELAXED, __HIP_MEMORY_SCOPE_AGENT);
        __syncthreads();
        if (tid == 0) { int ts = 0;
            for (int e = 0; e < 32; ++e) { const int c = tab[120 + e], nt = (c + 255) >> 8; tab[e] = ts; tab[40 + e] = ts; tab[80 + e] = ts * 256 + c; ts += nt; }
            tab[32] = ts; }
        __syncthreads();
    }

    if (IN(6)) {
        const float* nw = args.in[9];
        for (int t = gw; t < T; t += NGW) {
            const u32x4 info = TOKINFO[t]; const float rs = TOKRSTD[t];
            const int e0 = (int)info.x, e1 = (int)info.y;
            int p0 = 0, p1 = 0;
            if (lane == 0) { p0 = (int)atomicAdd(ctl + CW_ECUR + e0, 1u); p1 = (int)atomicAdd(ctl + CW_ECUR + e1, 1u); }
            p0 = __builtin_amdgcn_readfirstlane(p0) + tab[40 + e0] * 256; p1 = __builtin_amdgcn_readfirstlane(p1) + tab[40 + e1] * 256;
            const f32x4* xr = (const f32x4*)(X1 + (size_t)t * D) + lane; const f32x4* wr = (const f32x4*)nw + lane;
            u32x2* o0 = (u32x2*)(XP + (size_t)p0 * D) + lane; u32x2* o1 = (u32x2*)(XP + (size_t)p1 * D) + lane;
#pragma unroll
            for (int j = 0; j < 8; ++j) { const f32x4 v = xr[64 * j], ww = wr[64 * j]; u32x2 p; p.x = pk2(v[0] * rs * ww[0], v[1] * rs * ww[1]); p.y = pk2(v[2] * rs * ww[2], v[3] * rs * ww[3]);
                o0[64 * j] = p; o1[64 * j] = p; }
            if (lane == 0) { ROWINFO[2 * p0] = 2 * t; ROWINFO[2 * p0 + 1] = (int)info.z; ROWINFO[2 * p1] = 2 * t + 1; ROWINFO[2 * p1 + 1] = (int)info.w; }
        }
        if (BOTH(6)) GRID_BAR();
    }

    if (IN(7)) {
        pg8::Gemm g{XP, WguT, XP_ROWS, NE * 1024, D}; pg8::MoeOrder S{tab, 4, tab[32] * 4, G, bx};
        pg8::EpiSwiGLU E{ACT};
        pg8::gemm_phase<pg8::EpiSwiGLU, pg8::MoeOrder, true, true>(lds, g, S, E);
        if (BOTH(7)) GRID_BAR();
    }

    if (IN(8)) {
        pg8::Gemm g{ACT, WdT, XP_ROWS, NE * 2048, DE}; pg8::MoeOrder S{tab, 8, tab[32] * 8, G, bx};
        pg8::EpiDown E{Y, ROWINFO, tab + 80};
        pg8::gemm_phase<pg8::EpiDown, pg8::MoeOrder, true, true>(lds, g, S, E);
        if (BOTH(8)) GRID_BAR();
    }

    if (IN(9)) {
        const float* nf = args.in[17];
        for (int t = gw; t < T; t += NGW) {
            const f32x4* xr = (const f32x4*)(X1 + (size_t)t * D) + lane;
            const u32x2* y0 = (const u32x2*)(Y + (size_t)(2 * t) * D) + lane; const u32x2* y1 = (const u32x2*)(Y + (size_t)(2 * t + 1) * D) + lane;
            f32x4 v[8]; float s = 0.f;
#pragma unroll
            for (int j = 0; j < 8; ++j) { f32x4 a = xr[64 * j]; const u32x2 p = y0[64 * j], q = y1[64 * j];
                a[0] += bf2f(p.x & 0xffffu) + bf2f(q.x & 0xffffu); a[1] += bf2f(p.x >> 16) + bf2f(q.x >> 16);
                a[2] += bf2f(p.y & 0xffffu) + bf2f(q.y & 0xffffu); a[3] += bf2f(p.y >> 16) + bf2f(q.y >> 16);
                v[j] = a; s += (a[0] * a[0] + a[1] * a[1]) + (a[2] * a[2] + a[3] * a[3]); }
            const float rstd = __builtin_amdgcn_rsqf(wave_sum(s) * (1.f / D) + RMS_EPS);
            f32x4* orow = (f32x4*)(args.out + (size_t)t * D) + lane; const f32x4* wr = (const f32x4*)nf + lane;
#pragma unroll
            for (int j = 0; j < 8; ++j) orow[64 * j] = v[j] * rstd * wr[64 * j];
        }
    }
#undef IN
#undef BOTH
#undef GRID_BAR
}

extern "C" void kernel_launch(void* const* d_in, const int* in_sizes, int n_in, void* d_out, int out_size, void* d_ws, size_t ws_size, hipStream_t stream) {
    static int grid = 0;
    if (grid == 0) {
        if (n_in != 18 || in_sizes[0] != T * D || out_size != T * D || ws_size < WS_END) { fprintf(stderr, "kernel_launch: unexpected shapes (n_in %d, in0 %d, out %d, ws %zu)\n", n_in, n_in > 0 ? in_sizes[0] : -1, out_size, ws_size); grid = -1; return; }
        int dev = 0, cus = 0, per_cu = 0;
        if (hipGetDevice(&dev) != hipSuccess || hipDeviceGetAttribute(&cus, hipDeviceAttributeMultiprocessorCount, dev) != hipSuccess) { grid = -1; return; }
        if (hipFuncSetAttribute((const void*)trunk_fwd, hipFuncAttributeMaxDynamicSharedMemorySize, LDS_BYTES) != hipSuccess) { fprintf(stderr, "kernel_launch: hipFuncSetAttribute failed\n"); grid = -1; return; }
        if (hipOccupancyMaxActiveBlocksPerMultiprocessor(&per_cu, (const void*)trunk_fwd, NWAVES * 64, LDS_BYTES) != hipSuccess || per_cu < 1)
            fprintf(stderr, "kernel_launch: note: occupancy query reports %d workgroups per CU\n", per_cu);
        (void)hipGetLastError();
        grid = cus;
    }
    if (grid < 0) return;
    if (hipMemsetAsync((char*)d_ws + WS_CTL, 0, CTL_ZERO_BYTES, stream) != hipSuccess) return;
    Args a{};
    for (int i = 0; i < 18; ++i) a.in[i] = (const float*)d_in[i];
    a.out = (float*)d_out; a.ws = (unsigned char*)d_ws;
    for (int li = 0; li < N_LAUNCHES; ++li) {
        a.ph_lo = (N_LAUNCHES == 1) ? 0 : li; a.ph_hi = (N_LAUNCHES == 1) ? NPH : li + 1;
        hipLaunchKernelGGL(trunk_fwd, dim3(grid), dim3(NWAVES * 64), LDS_BYTES, stream, a);
    }
}
```

```cpp
#include <hip/hip_runtime.h>
#include <cstdio>
#include <cstdint>

#ifndef MK_N_LAUNCHES
#define MK_N_LAUNCHES 1
#endif
constexpr int NPH = 10;
constexpr int N_LAUNCHES = MK_N_LAUNCHES;

constexpr int NWAVES = 8;
constexpr int BATCH = 2, SEQ = 4096, T = BATCH * SEQ, D = 2048, NIN = 6144;
constexpr int NE = 32, DE = 512, NPAIR = 2 * T;
constexpr int XP_ROWS = 24576;
constexpr float RMS_EPS = 1e-6f;
constexpr float LOG2E = 1.4426950408889634f;
constexpr float QSCALE = 0.08838834764831845f * 1.4426950408889634f;

constexpr size_t MiB = 1u << 20;
constexpr size_t WS_CTL = 0, CTL_ZERO_BYTES = 1 * MiB;
constexpr size_t WS_WIN = 1 * MiB;
constexpr size_t WS_WOUT = 25 * MiB;
constexpr size_t WS_H = 33 * MiB;
constexpr size_t WS_Y = 1 * MiB;
constexpr size_t WS_WGU = 65 * MiB;
constexpr size_t WS_WD = 193 * MiB;
constexpr size_t WS_PROJ = 257 * MiB;
constexpr size_t WS_XP = 257 * MiB;
constexpr size_t WS_MIX = 353 * MiB;
constexpr size_t WS_ACT = 353 * MiB;
constexpr size_t WS_X1 = 385 * MiB;
constexpr size_t WS_MISC = 449 * MiB;
constexpr size_t WS_KMEAN = WS_MISC;
constexpr size_t WS_TOKINFO = WS_MISC + 256 * 1024;
constexpr size_t WS_TOKRSTD = WS_MISC + 384 * 1024;
constexpr size_t WS_ROWINFO = WS_MISC + 512 * 1024;
constexpr size_t WS_WRHI = WS_MISC + 1024 * 1024;
constexpr size_t WS_WRLO = WS_MISC + 1280 * 1024;
constexpr size_t WS_END = 452 * MiB;
constexpr int CW_BAR = 4096;
constexpr int CW_ECNT = 16384;
constexpr int CW_ECUR = 16384 + 2048;
constexpr int CW_QHEAD = 16384 + 4096;

constexpr int RING_BYTES = 131072;
constexpr int ATT_SCR_OFF = 131072;
constexpr int MOE_TAB_OFF = 135168;
constexpr int MISC_OFF = 136192;
constexpr int LDS_BYTES = 147456;

#define GAS __attribute__((address_space(1)))
#define LAS __attribute__((address_space(3)))
typedef unsigned short bf16;
typedef float f32x4 __attribute__((ext_vector_type(4)));
typedef float f32x16 __attribute__((ext_vector_type(16)));
typedef short bf16x8 __attribute__((ext_vector_type(8)));
typedef short s16x4 __attribute__((ext_vector_type(4)));
typedef unsigned u32x4 __attribute__((ext_vector_type(4)));
typedef unsigned u32x2 __attribute__((ext_vector_type(2)));

__device__ __forceinline__ unsigned f2bf(float f) { unsigned u = __builtin_bit_cast(unsigned, f); return (u + 0x7fffu + ((u >> 16) & 1u)) >> 16; }
__device__ __forceinline__ unsigned pk2(float lo, float hi) { return f2bf(lo) | (f2bf(hi) << 16); }
__device__ __forceinline__ float bf2f(unsigned b) { return __builtin_bit_cast(float, b << 16); }
__device__ __forceinline__ float wave_sum(float v) {
#pragma unroll
    for (int o = 1; o < 64; o <<= 1) v += __shfl_xor(v, o);
    return v;
}
namespace pg8 {
#define PG8_LAS __attribute__((address_space(3)))
typedef unsigned short bf16_t;
typedef short bf16x8 __attribute__((ext_vector_type(8)));
typedef float f32x4 __attribute__((ext_vector_type(4)));
typedef unsigned u32x4 __attribute__((ext_vector_type(4)));
constexpr int BM = 256, BK = 64, HALF = 128, HTB = HALF * BK * 2  , STAGE_BYTES = 8 * HTB, NXCD = 8, WGM = 8;

__host__ __device__ __forceinline__ int lds_byte(int r, int c) { const int st = (r >> 4) * 2 + (c >> 5), rr = r & 15, cc = c & 31, ob = rr * 64 + cc * 2; return st * 1024 + (ob ^ (((ob >> 9) & 1) << 5)); }
__host__ __device__ __forceinline__ void stage_rc(int b, int& R, int& C) { const int st = b / 1024, sb = b % 1024, swz = sb ^ (((sb >> 9) & 1) << 5); R = (st >> 1) * 16 + swz / 64; C = (st & 1) * 32 + (swz % 64) / 2; }
__host__ __device__ __forceinline__ int perm32(int rho) { const int n = rho >> 4, i = rho & 15; return 8 * (i >> 2) + 4 * n + (i & 3); }

struct Unit { int pm, pn; };
struct Gemm { const bf16_t* A; const bf16_t* Bt; int M, N, K; };

struct StaticOrder {
    int nM, nN, nwg, G, c;
    __host__ __device__ void init(int M, int N, int G_, int c_) { nM = M / BM; nN = N / BM; nwg = nM * nN; G = G_; c = c_; }
    __host__ __device__ bool next(int i, Unit& u) const {
        const long L = (long)i * G + c; if (L >= nwg) return false;
        int wgid = (int)L; { const int q = nwg / NXCD, r = nwg % NXCD, xcd = wgid % NXCD, off = wgid / NXCD; wgid = (xcd < r ? xcd * (q + 1) : r * (q + 1) + (xcd - r) * q) + off; }
        const int nig = WGM * nN, gid = wgid / nig, fm = gid * WGM, gsz = (nM - fm) < WGM ? (nM - fm) : WGM;
        u.pm = fm + ((wgid % nig) % gsz); u.pn = (wgid % nig) / gsz; return true;
    }
    __device__ __forceinline__ void a_ready(const Unit&) const {}
    __device__ __forceinline__ void done(const Unit&) const {}
};

__device__ __forceinline__ unsigned cvt_pk_bf16(float lo, float hi) { unsigned r; asm volatile("v_cvt_pk_bf16_f32 %0, %1, %2" : "=v"(r) : "v"(lo), "v"(hi)); return r; }
typedef float f32x2 __attribute__((ext_vector_type(2)));
struct EpiProj {
    static constexpr bool PERM = true, AFTER_DRAIN = false;
    bf16_t* O; int ldc; float qscale;
    __device__ __forceinline__ void operator()(const f32x4 (&acc)[2][2][4][2], const Unit& u, int wr, int wc, int fr, int fq) const {
        const int row0 = u.pm * BM + wr * 64 + fr, col0 = u.pn * BM + wc * 32 + 8 * fq;
        const float sc = (u.pn < 4 || (u.pn >= 12 && u.pn < 16)) ? qscale : 1.f;
#pragma unroll
        for (int ai = 0; ai < 2; ++ai)
#pragma unroll
            for (int m = 0; m < 4; ++m) { bf16_t* rowp = O + (size_t)(row0 + ai * HALF + m * 16) * ldc + col0;
#pragma unroll
                for (int bj = 0; bj < 2; ++bj) { const f32x4 v0 = acc[ai][bj][m][0] * sc, v1 = acc[ai][bj][m][1] * sc;
                    u32x4 w; w.x = cvt_pk_bf16(v0[0], v0[1]); w.y = cvt_pk_bf16(v0[2], v0[3]); w.z = cvt_pk_bf16(v1[0], v1[1]); w.w = cvt_pk_bf16(v1[2], v1[3]);
                    *(u32x4*)(rowp + bj * HALF) = w; } }
    }
};
struct EpiResid {
    static constexpr bool PERM = true, AFTER_DRAIN = false;
    const float* X; float* X1; int ldc;
    __device__ __forceinline__ void operator()(const f32x4 (&acc)[2][2][4][2], const Unit& u, int wr, int wc, int fr, int fq) const {
        const int row0 = u.pm * BM + wr * 64 + fr, col0 = u.pn * BM + wc * 32 + 8 * fq;
#pragma unroll
        for (int ai = 0; ai < 2; ++ai)
#pragma unroll
            for (int m = 0; m < 4; ++m) { const size_t off = (size_t)(row0 + ai * HALF + m * 16) * ldc + col0;
#pragma unroll
                for (int bj = 0; bj < 2; ++bj)
#pragma unroll
                    for (int n = 0; n < 2; ++n) { const f32x4 xv = *(const f32x4*)(X + off + bj * HALF + 4 * n); *(f32x4*)(X1 + off + bj * HALF + 4 * n) = xv + acc[ai][bj][m][n]; } }
    }
};
__device__ __forceinline__ float silu_mul(float g, float u) { return g * u * __builtin_amdgcn_rcpf(1.f + __builtin_amdgcn_exp2f(-1.4426950408889634f * g)); }
struct EpiSwiGLU {
    static constexpr bool PERM = true, AFTER_DRAIN = false;
    bf16_t* ACT;
    __device__ __forceinline__ void operator()(const f32x4 (&acc)[2][2][4][2], const Unit& u, int wr, int wc, int fr, int fq) const {
        const int row0 = u.pm * BM + wr * 64 + fr, col0 = (u.pn & 3) * 128 + wc * 32 + 8 * fq;
#pragma unroll
        for (int ai = 0; ai < 2; ++ai)
#pragma unroll
            for (int m = 0; m < 4; ++m) { const f32x4 g0 = acc[ai][0][m][0], g1 = acc[ai][0][m][1], u0 = acc[ai][1][m][0], u1 = acc[ai][1][m][1];
                u32x4 w; w.x = cvt_pk_bf16(silu_mul(g0[0], u0[0]), silu_mul(g0[1], u0[1])); w.y = cvt_pk_bf16(silu_mul(g0[2], u0[2]), silu_mul(g0[3], u0[3]));
                w.z = cvt_pk_bf16(silu_mul(g1[0], u1[0]), silu_mul(g1[1], u1[1])); w.w = cvt_pk_bf16(silu_mul(g1[2], u1[2]), silu_mul(g1[3], u1[3]));
                *(u32x4*)(ACT + (size_t)(row0 + ai * HALF + m * 16) * 512 + col0) = w; }
    }
};
struct EpiDown {
    static constexpr bool PERM = true, AFTER_DRAIN = false;
    bf16_t* Y; const int* rowinfo; const PG8_LAS int* rowend;
    __device__ __forceinline__ void operator()(const f32x4 (&acc)[2][2][4][2], const Unit& u, int wr, int wc, int fr, int fq) const {
        const int e = u.pn >> 3, rend = rowend[e];
        const int row0 = u.pm * BM + wr * 64 + fr, col0 = (u.pn & 7) * BM + wc * 32 + 8 * fq;
#pragma unroll
        for (int ai = 0; ai < 2; ++ai)
#pragma unroll
            for (int m = 0; m < 4; ++m) { const int pos = row0 + ai * HALF + m * 16;
                if (pos < rend) { const int pair = rowinfo[2 * pos]; const float wgt = __builtin_bit_cast(float, rowinfo[2 * pos + 1]);
                    bf16_t* rowp = Y + (size_t)pair * 2048 + col0;
#pragma unroll
                    for (int bj = 0; bj < 2; ++bj) { const f32x4 v0 = acc[ai][bj][m][0] * wgt, v1 = acc[ai][bj][m][1] * wgt;
                        u32x4 w; w.x = cvt_pk_bf16(v0[0], v0[1]); w.y = cvt_pk_bf16(v0[2], v0[3]); w.z = cvt_pk_bf16(v1[0], v1[1]); w.w = cvt_pk_bf16(v1[2], v1[3]);
                        *(u32x4*)(rowp + bj * HALF) = w; } } }
    }
};
struct MoeOrder {
    const PG8_LAS int* tab; int npn, total, G, c;
    __device__ __forceinline__ bool next(int i, Unit& u) const {
        const int L = i * G + c; if (L >= total) return false;
        const int tile = L / npn, pn = L - tile * npn; int e = 0;
#pragma unroll 4
        for (int j = 1; j < 32; ++j) e += (tab[j] <= tile) ? 1 : 0;
        u.pm = tab[40 + e] + (tile - tab[e]); u.pn = e * npn + pn; return true;
    }
    __device__ __forceinline__ void a_ready(const Unit&) const {}
    __device__ __forceinline__ void done(const Unit&) const {}
};

template <class Epi, class Sched, bool ALIGN_EPI = false, bool SP2 = false>
__device__ __forceinline__ void gemm_phase(PG8_LAS unsigned char* lds, const Gemm g, const Sched& S, const Epi& E) {
    const int tid = threadIdx.x, wid = __builtin_amdgcn_readfirstlane(tid >> 6), lane = tid & 63, wr = wid >> 2, wc = wid & 3, fr = lane & 15, fq = lane >> 4;
    const int K = g.K, nt = K / BK;
    unsigned voffA[2], voffB[2];
#pragma unroll
    for (int i = 0; i < 2; ++i) { int R, C; stage_rc(tid * 16 + i * 8192, R, C); const int Rb = Epi::PERM ? ((R & ~31) + perm32(R & 31)) : R;
        voffA[i] = (unsigned)(R * K + C) * 2u; voffB[i] = (unsigned)(Rb * K + C) * 2u; }
    const size_t kstep = (size_t)(BK * 2);
    const size_t hstep = (size_t)HALF * K * 2;
    const size_t tstep = 2 * hstep;
    const unsigned ldsw = (unsigned)wid * 1024u;
    const int aoff = lds_byte(wr * 64 + fr, fq * 8), boff = lds_byte(wc * 32 + fr, fq * 8);
#define PG8_SA(b, h) (((b) * 2 + (h)) * HTB)
#define PG8_SB(b, h) ((4 + (b) * 2 + (h)) * HTB)
#define PG8_STAGE(bufoff, gbase, voff) do { _Pragma("unroll") for (int _i = 0; _i < 2; ++_i) \
        __builtin_amdgcn_global_load_lds((const unsigned*)((const char*)(gbase) + (voff)[_i]), (PG8_LAS unsigned*)(lds + (bufoff) + ldsw + _i * 8192), 16, 0, 0); } while (0)
#define PG8_LDA(dst, b, h) do { _Pragma("unroll") for (int m = 0; m < 4; ++m) _Pragma("unroll") for (int k = 0; k < 2; ++k) dst[m][k] = *(const PG8_LAS bf16x8*)(lds + PG8_SA(b, h) + aoff + m * 2048 + k * 1024); } while (0)
#define PG8_LDB(dst, b, h) do { _Pragma("unroll") for (int n = 0; n < 2; ++n) _Pragma("unroll") for (int k = 0; k < 2; ++k) dst[n][k] = *(const PG8_LAS bf16x8*)(lds + PG8_SB(b, h) + boff + n * 2048 + k * 1024); } while (0)
#define PG8_MMA(ai, bj, At, Bt) do { __builtin_amdgcn_s_setprio(1); _Pragma("unroll") for (int m = 0; m < 4; ++m) _Pragma("unroll") for (int n = 0; n < 2; ++n) _Pragma("unroll") for (int k = 0; k < 2; ++k) \
        acc[ai][bj][m][n] = __builtin_amdgcn_mfma_f32_16x16x32_bf16(Bt[n][k], At[m][k], acc[ai][bj][m][n], 0, 0, 0); __builtin_amdgcn_s_setprio(0); } while (0)
#define PG8_WAIT_V(n) asm volatile("s_waitcnt vmcnt(" #n ")" ::: "memory")
#define PG8_WAIT_L(n) asm volatile("s_waitcnt lgkmcnt(" #n ")" ::: "memory")
#define PG8_BAR __builtin_amdgcn_s_barrier()
#define PG8_SCHED __builtin_amdgcn_sched_barrier(0)
    Unit cur, nxt; int ui = 0;
    if (!S.next(0, cur)) return;
    f32x4 acc[2][2][4][2];
#pragma unroll
    for (int a = 0; a < 2; ++a)
#pragma unroll
        for (int b = 0; b < 2; ++b)
#pragma unroll
            for (int m = 0; m < 4; ++m)
#pragma unroll
                for (int n = 0; n < 2; ++n) acc[a][b][m][n] = (f32x4){0.f, 0.f, 0.f, 0.f};
    bf16x8 At[4][2], B0[2][2], B1[2][2];
    const char* cA = (const char*)g.A + (size_t)cur.pm * tstep; const char* cB = (const char*)g.Bt + (size_t)cur.pn * tstep;
    S.a_ready(cur);
    if constexpr (SP2) {
        PG8_STAGE(PG8_SB(0, 0), cB, voffB); PG8_STAGE(PG8_SB(0, 1), cB + hstep, voffB); PG8_STAGE(PG8_SA(0, 0), cA, voffA); PG8_STAGE(PG8_SA(0, 1), cA + hstep, voffA);
        if (wr == 1) PG8_BAR;
        PG8_WAIT_V(2); PG8_BAR;
        PG8_STAGE(PG8_SB(1, 0), cB + kstep, voffB); PG8_STAGE(PG8_SA(1, 0), cA + kstep, voffA); PG8_STAGE(PG8_SB(1, 1), cB + hstep + kstep, voffB);
        PG8_WAIT_V(6); PG8_BAR;
    } else {
        PG8_STAGE(PG8_SB(0, 0), cB, voffB); PG8_STAGE(PG8_SA(0, 0), cA, voffA); PG8_STAGE(PG8_SB(0, 1), cB + hstep, voffB); PG8_STAGE(PG8_SA(0, 1), cA + hstep, voffA);
        if (wr == 1) PG8_BAR;
        PG8_WAIT_V(4); PG8_BAR;
        PG8_STAGE(PG8_SB(1, 0), cB + kstep, voffB); PG8_STAGE(PG8_SA(1, 0), cA + kstep, voffA); PG8_STAGE(PG8_SB(1, 1), cB + hstep + kstep, voffB);
        PG8_WAIT_V(6); PG8_BAR;
    }
    for (;;) {
        const bool has_next = S.next(ui + 1, nxt);
        const char* nA = has_next ? (const char*)g.A + (size_t)nxt.pm * tstep : cA; const char* nB = has_next ? (const char*)g.Bt + (size_t)nxt.pn * tstep : cB;
        for (int t = 0; t < nt; t += 2) {
            const bool last = (t == nt - 2);
            const char* a1 = cA + (size_t)(t + 1) * kstep;
            const char* a2 = last ? nA : cA + (size_t)(t + 2) * kstep; const char* b2 = last ? nB : cB + (size_t)(t + 2) * kstep;
            const char* a3 = a2 + kstep; const char* b3 = b2 + kstep;
            if (last && has_next) S.a_ready(nxt);
            if constexpr (SP2) {
            PG8_LDB(B0, 0, 0); PG8_LDB(B1, 0, 1); PG8_SCHED; PG8_LDA(At, 0, 0); PG8_STAGE(PG8_SA(1, 1), a1 + hstep, voffA);
            PG8_WAIT_V(8); PG8_WAIT_L(0); PG8_BAR; PG8_MMA(0, 0, At, B0); PG8_MMA(0, 1, At, B1); PG8_BAR; PG8_SCHED;
            PG8_LDA(At, 0, 1); PG8_STAGE(PG8_SB(0, 0), b2, voffB); PG8_STAGE(PG8_SB(0, 1), b2 + hstep, voffB); PG8_STAGE(PG8_SA(0, 0), a2, voffA);
            PG8_WAIT_V(8); PG8_WAIT_L(0); PG8_BAR; PG8_MMA(1, 0, At, B0); PG8_MMA(1, 1, At, B1); PG8_BAR; PG8_SCHED;
            PG8_LDB(B0, 1, 0); PG8_LDB(B1, 1, 1); PG8_SCHED; PG8_LDA(At, 1, 0); PG8_STAGE(PG8_SA(0, 1), a2 + hstep, voffA);
            PG8_WAIT_V(8); PG8_WAIT_L(0); PG8_BAR; PG8_MMA(0, 0, At, B0); PG8_MMA(0, 1, At, B1); PG8_BAR; PG8_SCHED;
            PG8_LDA(At, 1, 1); PG8_STAGE(PG8_SB(1, 0), b3, voffB); PG8_STAGE(PG8_SB(1, 1), b3 + hstep, voffB); PG8_STAGE(PG8_SA(1, 0), a3, voffA);
            PG8_WAIT_V(8); PG8_WAIT_L(0); PG8_BAR; PG8_MMA(1, 0, At, B0); PG8_MMA(1, 1, At, B1); PG8_BAR; PG8_SCHED;
            } else {
            PG8_LDB(B0, 0, 0); PG8_SCHED; PG8_LDA(At, 0, 0); PG8_STAGE(PG8_SA(1, 1), a1 + hstep, voffA);
            PG8_WAIT_L(8); PG8_BAR; PG8_WAIT_L(0); PG8_MMA(0, 0, At, B0); PG8_BAR; PG8_SCHED;
            PG8_LDB(B1, 0, 1); PG8_STAGE(PG8_SB(0, 0), b2, voffB);
            PG8_BAR; PG8_WAIT_L(0); PG8_MMA(0, 1, At, B1); PG8_BAR;
            PG8_LDA(At, 0, 1); PG8_STAGE(PG8_SA(0, 0), a2, voffA);
            PG8_BAR; PG8_WAIT_L(0); PG8_MMA(1, 0, At, B0); PG8_BAR; PG8_SCHED;
            PG8_STAGE(PG8_SB(0, 1), b2 + hstep, voffB);
            PG8_WAIT_V(6); PG8_BAR; PG8_MMA(1, 1, At, B1); PG8_BAR;
            PG8_LDB(B0, 1, 0); PG8_SCHED; PG8_LDA(At, 1, 0); PG8_STAGE(PG8_SA(0, 1), a2 + hstep, voffA);
            PG8_WAIT_L(8); PG8_BAR; PG8_WAIT_L(0); PG8_MMA(0, 0, At, B0); PG8_BAR; PG8_SCHED;
            PG8_LDB(B1, 1, 1); PG8_STAGE(PG8_SB(1, 0), b3, voffB);
            PG8_BAR; PG8_WAIT_L(0); PG8_MMA(0, 1, At, B1); PG8_BAR;
            PG8_LDA(At, 1, 1); PG8_STAGE(PG8_SA(1, 0), a3, voffA);
            PG8_BAR; PG8_WAIT_L(0); PG8_MMA(1, 0, At, B0); PG8_BAR; PG8_SCHED;
            PG8_STAGE(PG8_SB(1, 1), b3 + hstep, voffB);
            PG8_WAIT_V(6); PG8_BAR; PG8_MMA(1, 1, At, B1); PG8_BAR;
            }
        }
        if constexpr (ALIGN_EPI) { if (wr == 0) PG8_BAR; }
        if constexpr (!Epi::AFTER_DRAIN) { E(acc, cur, wr, wc, fr, fq); S.done(cur); }
        if (!has_next) break;
#pragma unroll
        for (int a = 0; a < 2; ++a)
#pragma unroll
            for (int b = 0; b < 2; ++b)
#pragma unroll
                for (int m = 0; m < 4; ++m)
#pragma unroll
                    for (int n = 0; n < 2; ++n) acc[a][b][m][n] = (f32x4){0.f, 0.f, 0.f, 0.f};
        cur = nxt; cA = nA; cB = nB; ++ui;
        if constexpr (ALIGN_EPI) { if (wr == 1) PG8_BAR; }
    }
    PG8_WAIT_V(0);
    if constexpr (!ALIGN_EPI) { if (wr == 0) PG8_BAR; }
    PG8_BAR;
    if constexpr (Epi::AFTER_DRAIN) { E.fused(acc, cur, wr, wc, fr, fq, lds, wid, lane); S.done(cur); }
#undef PG8_SA
#undef PG8_SB
#undef PG8_STAGE
#undef PG8_LDA
#undef PG8_LDB
#undef PG8_MMA
#undef PG8_WAIT_V
#undef PG8_WAIT_L
#undef PG8_BAR
#undef PG8_SCHED
}
}
#define XB_TMO      128
#define XB_XCNT(j)  (256  + 64 * (j))
#define XB_XSUB(j)  (1280 + 64 * (j))
#define XB_XGEN(j)  (2304 + 64 * (j))
#define XB_TOP      3328
#define XB_TOPGEN   3392
#define XCD_BAR_WORDS 3456
#define XB_SPIN_CAP (1u << 18)

__device__ __forceinline__ unsigned xb_ld(unsigned* p)              { return __hip_atomic_load(p, __ATOMIC_RELAXED, __HIP_MEMORY_SCOPE_AGENT); }
__device__ __forceinline__ unsigned xb_add(unsigned* p, unsigned v) { return __hip_atomic_fetch_add(p, v, __ATOMIC_RELAXED, __HIP_MEMORY_SCOPE_AGENT); }
__device__ __forceinline__ unsigned xb_xcc_id() { return (unsigned)__builtin_amdgcn_s_getreg((3 << 11) | 20) & 0xFu; }
#define XB_SPIN(cond, bar) do { unsigned _sp = 0; while (cond) { __builtin_amdgcn_s_sleep(1); \
    if ((++_sp & 255u) == 0u) { if (xb_ld(&(bar)[XB_TMO])) break; if (_sp > XB_SPIN_CAP) { atomicAdd(&(bar)[XB_TMO], 1u); break; } } } } while (0)

struct XcdBarrier {
    unsigned* bar; unsigned x;
    volatile LAS unsigned* st;
};

__device__ __forceinline__ XcdBarrier xcd_barrier_post(unsigned* bar, volatile LAS unsigned* st) {
    XcdBarrier b; b.bar = bar; b.x = xb_xcc_id(); b.st = st;
    if (threadIdx.x == 0) (void)xb_add(&bar[XB_XCNT(b.x)], 1u);
    return b;
}
__device__ __forceinline__ void xcd_barrier_complete(unsigned* bar, unsigned x, unsigned& nloc, unsigned& nx) {
    const unsigned G = gridDim.x * gridDim.y * gridDim.z;
    unsigned sum, cnt, mine, sp = 0u;
    for (;;) {
        sum = 0u; cnt = 0u; mine = 0u;
#pragma unroll
        for (unsigned j = 0; j < 16; ++j) { const unsigned c = xb_ld(&bar[XB_XCNT(j)]); sum += c; cnt += (c > 0u) ? 1u : 0u; mine = (j == x) ? c : mine; }
        if (sum == G) break;
        __builtin_amdgcn_s_sleep(1);
        if ((++sp & 255u) == 0u) { if (xb_ld(&bar[XB_TMO])) break; if (sp > XB_SPIN_CAP) { atomicAdd(&bar[XB_TMO], 1u); break; } }
    }
    nloc = mine > 0u ? mine : 1u; nx = cnt > 0u ? cnt : 1u;
}

__device__ __forceinline__ void xcd_barrier(const XcdBarrier& b) {
    asm volatile("s_waitcnt vmcnt(0)" ::: "memory");
    __syncthreads();
    if (threadIdx.x == 0) {
        unsigned* bar = b.bar;
        __builtin_amdgcn_s_waitcnt(0);
        unsigned nloc = b.st[0], nx = b.st[1];
        if (nloc == 0u) { xcd_barrier_complete(bar, b.x, nloc, nx); b.st[0] = nloc; b.st[1] = nx; }
        const unsigned old = xb_add(&bar[XB_XSUB(b.x)], 1u);
        const unsigned gen = old / nloc;
        if (old + 1u == (gen + 1u) * nloc) {
            __builtin_amdgcn_fence(__ATOMIC_RELEASE, "agent");
            asm volatile("s_waitcnt vmcnt(0)" ::: "memory");
            const unsigned og = xb_add(&bar[XB_TOP], 1u);
            const unsigned tg = og / nx;
            if (og + 1u == (tg + 1u) * nx) xb_add(&bar[XB_TOPGEN], 1u);
            else XB_SPIN(xb_ld(&bar[XB_TOPGEN]) == tg, bar);
            __builtin_amdgcn_fence(__ATOMIC_ACQUIRE, "agent");
            xb_add(&bar[XB_XGEN(b.x)], 1u);
            asm volatile("s_waitcnt vmcnt(0)" ::: "memory");
        } else {
            XB_SPIN(xb_ld(&bar[XB_XGEN(b.x)]) == gen, bar);
            __builtin_amdgcn_fence(__ATOMIC_ACQUIRE, "agent");
            asm volatile("s_waitcnt vmcnt(0)" ::: "memory");
        }
    }
    __syncthreads();
}

namespace att {
constexpr int PITCH = NIN;
constexpr int STAGE = 65536, SUB = 16384;
constexpr float THR2 = 11.5f;
#define KSWZ(row, colB) ((row) * 256 + ((colB) ^ (((row) & 7) << 4)))
#define SBAR() __builtin_amdgcn_sched_barrier(0)
__device__ __forceinline__ int v_rd_base(int lane) { return ((lane & 3) << 3) | (((lane >> 2) & 3) << 6) | (((lane >> 4) & 1) << 5) | (((lane >> 5) & 1) << 8); }
constexpr int v_rd_off(int d0, int ks, int half) { return d0 * 512 + ks * 4096 + half * 2048; }
__device__ __forceinline__ int crow(int r, int hi) { return (r & 3) + 8 * (r >> 2) + 4 * hi; }
__device__ __forceinline__ unsigned cvtpk(float lo, float hi) { unsigned r; asm volatile("v_cvt_pk_bf16_f32 %0, %1, %2" : "=v"(r) : "v"(lo), "v"(hi)); return r; }

__device__ __forceinline__ void qkt(f32x16& p0, f32x16& p1, const LAS unsigned char* Ks, int r32, int hi, const bf16x8* qr) {
    const LAS unsigned char* kb[4];
#pragma unroll
    for (int dd = 0; dd < 4; ++dd) kb[dd] = Ks + KSWZ(r32, (dd * 16 + hi * 8) * 2);
#pragma unroll
    for (int d0 = 0; d0 < 8; ++d0) { const LAS unsigned char* a = kb[d0 & 3] + (d0 >> 2) * 128;
        const bf16x8 b0 = *(const LAS bf16x8*)a;
        const bf16x8 b1 = *(const LAS bf16x8*)(a + 32 * 256);
        p0 = __builtin_amdgcn_mfma_f32_32x32x16_bf16(b0, qr[d0], p0, 0, 0, 0);
        p1 = __builtin_amdgcn_mfma_f32_32x32x16_bf16(b1, qr[d0], p1, 0, 0, 0); }
}
__device__ __forceinline__ void pv_tile(f32x16* o, unsigned vb0, bf16x8 pa0, bf16x8 pa1, bf16x8 pa2, bf16x8 pa3) {
#define TRRD(dst, off) asm volatile("ds_read_b64_tr_b16 %0, %1 offset:%2" : "=&v"(dst) : "v"(vb0), "i"(off) : "memory")
#define PV_D0(d0) do { s16x4 l0, l1, l2, l3, h0, h1, h2, h3; constexpr int b_ = v_rd_off(d0, 0, 0); \
        TRRD(l0, b_); TRRD(h0, b_ + 2048); TRRD(l1, b_ + 4096); TRRD(h1, b_ + 6144); TRRD(l2, b_ + 8192); TRRD(h2, b_ + 10240); TRRD(l3, b_ + 12288); TRRD(h3, b_ + 14336); \
        asm volatile("s_waitcnt lgkmcnt(0)" ::: "memory"); SBAR(); \
        o[d0] = __builtin_amdgcn_mfma_f32_32x32x16_bf16(pa0, (bf16x8){l0[0], l0[1], l0[2], l0[3], h0[0], h0[1], h0[2], h0[3]}, o[d0], 0, 0, 0); \
        o[d0] = __builtin_amdgcn_mfma_f32_32x32x16_bf16(pa1, (bf16x8){l1[0], l1[1], l1[2], l1[3], h1[0], h1[1], h1[2], h1[3]}, o[d0], 0, 0, 0); \
        o[d0] = __builtin_amdgcn_mfma_f32_32x32x16_bf16(pa2, (bf16x8){l2[0], l2[1], l2[2], l2[3], h2[0], h2[1], h2[2], h2[3]}, o[d0], 0, 0, 0); \
        o[d0] = __builtin_amdgcn_mfma_f32_32x32x16_bf16(pa3, (bf16x8){l3[0], l3[1], l3[2], l3[3], h3[0], h3[1], h3[2], h3[3]}, o[d0], 0, 0, 0); } while (0)
    PV_D0(0); PV_D0(1); PV_D0(2); PV_D0(3);
#undef PV_D0
#undef TRRD
}
__device__ __forceinline__ void glds16(const bf16* g, LAS unsigned char* l) {
    __builtin_amdgcn_global_load_lds((const unsigned*)g, (LAS unsigned*)l, 16, 0, 0);
}

template <int DIFF, int HF>
__device__ __forceinline__ void half_step(f32x16* o, float& m_reg, float& l_reg, const bf16x8* qr, const LAS unsigned char* Kst, unsigned vb0, LAS float* al_l,
                                          int kbh, int q0, int r32, int hi, float slope2, bool selbit) {
    constexpr int NO = DIFF ? 8 : 4;
    if (kbh > q0 + 31) return;
    float binit = slope2 * (float)(kbh - (q0 + r32) + 4 * hi);
    if (!selbit) binit = -__builtin_inff();
    f32x16 p;
#pragma unroll
    for (int r = 0; r < 16; ++r) p[r] = fmaf(slope2, (float)((r & 3) + 8 * (r >> 2)), binit);
    {
        const LAS unsigned char* kb4[4];
#pragma unroll
        for (int dd = 0; dd < 4; ++dd) kb4[dd] = Kst + KSWZ(r32, (dd * 16 + hi * 8) * 2) + HF * 8192;
#pragma unroll
        for (int d0 = 0; d0 < 8; ++d0) p = __builtin_amdgcn_mfma_f32_32x32x16_bf16(*(const LAS bf16x8*)(kb4[d0 & 3] + (d0 >> 2) * 128), qr[d0], p, 0, 0, 0);
    }
    if (kbh + 31 > q0) {
        const int dq = q0 + r32 - kbh - 4 * hi; const float NEG = -__builtin_inff();
#pragma unroll
        for (int r = 0; r < 16; ++r) { const int c = (r & 3) + 8 * (r >> 2); if (c > dq) p[r] = NEG; }
    }
    float pmax = p[0];
#pragma unroll
    for (int r = 1; r < 16; ++r) pmax = fmaxf(pmax, p[r]);
    pmax = fmaxf(pmax, __shfl_xor(pmax, 32));
    float mn, alpha;
    if (__all(pmax - m_reg <= THR2)) { mn = m_reg; alpha = 1.f; }
    else { mn = fmaxf(m_reg, pmax); alpha = __builtin_amdgcn_exp2f(m_reg - mn); m_reg = mn; }
#pragma unroll
    for (int r = 0; r < 16; ++r) p[r] = __builtin_amdgcn_exp2f(p[r] - mn);
    float ps = 0.f;
#pragma unroll
    for (int r = 0; r < 16; ++r) ps += p[r];
    ps += __shfl_xor(ps, 32);
    l_reg = l_reg * alpha + ps;
    bf16x8 pa0, pa1;
#define PK4(P, B_, OUT) do { unsigned a0 = cvtpk(P[B_ + 0], P[B_ + 1]), a1 = cvtpk(P[B_ + 2], P[B_ + 3]); \
        unsigned b0 = cvtpk(P[B_ + 4], P[B_ + 5]), b1 = cvtpk(P[B_ + 6], P[B_ + 7]); \
        auto r0 = __builtin_amdgcn_permlane32_swap(a0, b0, false, false); auto r1 = __builtin_amdgcn_permlane32_swap(a1, b1, false, false); \
        u32x4 w = {r0[0], r1[0], r0[1], r1[1]}; OUT = __builtin_bit_cast(bf16x8, w); } while (0)
    PK4(p, 0, pa0); PK4(p, 8, pa1);
#undef PK4
    if (__any(alpha < 1.f)) {
        if (hi == 0) al_l[r32] = alpha;
        asm volatile("s_waitcnt lgkmcnt(0)" ::: "memory");
#pragma unroll
        for (int r = 0; r < 16; ++r) { const float a = al_l[crow(r, hi)];
#pragma unroll
            for (int d = 0; d < NO; ++d) o[d][r] *= a; }
    }
    SBAR();
#define TRRD(dst, off) asm volatile("ds_read_b64_tr_b16 %0, %1 offset:%2" : "=&v"(dst) : "v"(vb0), "i"(off) : "memory")
#define PV_D0(d0, vsub) do { s16x4 l0, l1, h0, h1; constexpr int b_ = (vsub) * SUB + v_rd_off(d0, 2 * HF, 0); \
        TRRD(l0, b_); TRRD(h0, b_ + 2048); TRRD(l1, b_ + 4096); TRRD(h1, b_ + 6144); \
        asm volatile("s_waitcnt lgkmcnt(0)" ::: "memory"); SBAR(); \
        o[(vsub) * 4 + d0] = __builtin_amdgcn_mfma_f32_32x32x16_bf16(pa0, (bf16x8){l0[0], l0[1], l0[2], l0[3], h0[0], h0[1], h0[2], h0[3]}, o[(vsub) * 4 + d0], 0, 0, 0); \
        o[(vsub) * 4 + d0] = __builtin_amdgcn_mfma_f32_32x32x16_bf16(pa1, (bf16x8){l1[0], l1[1], l1[2], l1[3], h1[0], h1[1], h1[2], h1[3]}, o[(vsub) * 4 + d0], 0, 0, 0); } while (0)
    PV_D0(0, 0); PV_D0(1, 0); PV_D0(2, 0); PV_D0(3, 0);
    if (DIFF) { PV_D0(0, 1); PV_D0(1, 1); PV_D0(2, 1); PV_D0(3, 1); }
#undef PV_D0
#undef TRRD
}

template <int DIFF>
__device__ __forceinline__ void attn_unit(LAS unsigned char* lds, const bf16* __restrict__ proj, bf16* __restrict__ mixed, const bf16* __restrict__ kmean,
                                          int b, int h, int idx, float lam, const float* __restrict__ subw) {
    constexpr int NO = DIFF ? 8 : 4;
    const int tid = threadIdx.x, lane = tid & 63, wid = __builtin_amdgcn_readfirstlane(tid >> 6), r32 = lane & 31, hi = lane >> 5;
    const int rg = wid & 3, comp = wid >> 2;
    const int q0 = DIFF ? (128 * idx + 32 * rg) : (256 * idx + 32 * wid);
    const size_t rowbase = (size_t)b * SEQ;
    const int qcol = DIFF ? (3072 + 256 * h + 128 * comp) : (128 * h);
    const int kcol = DIFF ? (4096 + 256 * h) : (1024 + 128 * h);
    const int vcol = DIFF ? (5120 + 256 * h) : (2048 + 128 * h);
    const float slope2 = (DIFF ? __builtin_amdgcn_exp2f(-2.f * (float)(h + 1)) : __builtin_amdgcn_exp2f(-(float)(h + 1))) * LOG2E;
    const int NT = DIFF ? 2 * (idx + 1) : 4 * (idx + 1);
    int koff, voff;
    { const int row = 4 * wid + (lane >> 4), ch = (lane & 15) ^ (row & 7); koff = row * PITCH + 8 * ch;
      const int sub = 2 * wid + (lane >> 5), kk = 8 * (sub >> 2) + ((lane & 31) >> 2), k = (kk & ~0xC) | ((kk & 4) << 1) | ((kk & 8) >> 1), c = 32 * (sub & 3) + 8 * (lane & 3);
      voff = k * PITCH + c; }
    LAS unsigned char* const dst0 = lds + wid * 1024;
#define ISSUE_TILE(st, kb_) do { const bf16* g_ = proj + (rowbase + (size_t)(kb_)) * PITCH; LAS unsigned char* d_ = dst0 + (st) * STAGE; \
        _Pragma("unroll") for (int i_ = 0; i_ < 2; ++i_) { \
            glds16(g_ + kcol + koff + i_ * 32 * PITCH, d_ + i_ * 8192); \
            if (DIFF) { glds16(g_ + kcol + 128 + koff + i_ * 32 * PITCH, d_ + SUB + i_ * 8192); \
                        glds16(g_ + vcol + voff + i_ * 32 * PITCH, d_ + 2 * SUB + i_ * 8192); \
                        glds16(g_ + vcol + 128 + voff + i_ * 32 * PITCH, d_ + 3 * SUB + i_ * 8192); } \
            else { glds16(g_ + vcol + voff + i_ * 32 * PITCH, d_ + SUB + i_ * 8192); } } } while (0)
#define TILE_KB(t_) (DIFF ? 64 * (t_) : ((t_) < 4 ? 256 * idx + 64 * (t_) : 256 * (((t_) - 4) >> 2) + 64 * (((t_) - 4) & 3)))
    ISSUE_TILE(0, TILE_KB(0));
    if (!DIFF && idx > 0) {
        const int row = 4 * wid + (lane >> 4), ch = (lane & 15) ^ (row & 7);
        glds16(kmean + ((size_t)(b * 8 + h) * 32 + row) * 128 + 8 * ch, dst0 + STAGE);
    }
    bf16x8 qr[8];
    { const bf16* qp = proj + (rowbase + q0 + r32) * PITCH + qcol + hi * 8;
#pragma unroll
      for (int d0 = 0; d0 < 8; ++d0) qr[d0] = *(const bf16x8*)(qp + d0 * 16); }
    LAS float* const al_l = (LAS float*)(lds + ATT_SCR_OFF + wid * 512);
    LAS float* const li_l = al_l + 32;
    unsigned sel = 0u;
    if (!DIFF && idx > 0) {
        asm volatile("s_waitcnt vmcnt(0)" ::: "memory"); __syncthreads();
        f32x16 g = {};
        { const LAS unsigned char* Ks = lds + STAGE;
#pragma unroll
          for (int d0 = 0; d0 < 8; ++d0) { const LAS unsigned char* a = Ks + KSWZ(r32, ((d0 & 3) * 16 + hi * 8) * 2) + (d0 >> 2) * 128;
              g = __builtin_amdgcn_mfma_f32_32x32x16_bf16(*(const LAS bf16x8*)a, qr[d0], g, 0, 0, 0); } }
        float gv[16]; int gn[16];
#pragma unroll
        for (int r = 0; r < 8; ++r) { const int nb = (r & 3) + 8 * (r >> 2);
            gv[r] = g[r]; gn[r] = nb + 4 * hi; gv[8 + r] = __shfl_xor(g[r], 32); gn[8 + r] = nb + 4 * (1 - hi); }
        const float NEG = -__builtin_inff();
        float m1 = NEG, m2 = NEG, m3 = NEG;
#pragma unroll
        for (int i = 0; i < 16; ++i) { float v = gn[i] < idx ? gv[i] : NEG;
            float t1 = fmaxf(m1, v); v = fminf(m1, v); m1 = t1; float t2 = fmaxf(m2, v); v = fminf(m2, v); m2 = t2; m3 = fmaxf(m3, v); }
#pragma unroll
        for (int i = 0; i < 16; ++i) if (gn[i] < idx && gv[i] >= m3) sel |= 1u << gn[i];
    }
    float m_reg = -1e30f, l_reg = 0.f;
    f32x16 o[NO];
#pragma unroll
    for (int d = 0; d < NO; ++d) o[d] = f32x16{};
    const unsigned ldsu = (unsigned)(uintptr_t)lds;
    const int ksub = DIFF ? comp : 0;
    for (int t = 0; t < NT; ++t) {
        asm volatile("s_waitcnt vmcnt(0)" ::: "memory"); __syncthreads();
        if (t + 1 < NT) ISSUE_TILE((t + 1) & 1, TILE_KB(t + 1));
        const int kb = TILE_KB(t);
        const bool past = !DIFF && t >= 4;
        const bool selbit = past ? (((sel >> ((t - 4) >> 2)) & 1u) != 0u) : true;
        const int stoff = (t & 1) * STAGE;
        const LAS unsigned char* Kst = lds + stoff + ksub * SUB;
        const unsigned vb0 = ldsu + stoff + (DIFF ? 2 : 1) * SUB + v_rd_base(lane);
        half_step<DIFF, 0>(o, m_reg, l_reg, qr, Kst, vb0, al_l, kb, q0, r32, hi, slope2, selbit);
        half_step<DIFF, 1>(o, m_reg, l_reg, qr, Kst, vb0, al_l, kb + 32, q0, r32, hi, slope2, selbit);
    }
    if (hi == 0) li_l[r32] = l_reg;
    asm volatile("s_waitcnt lgkmcnt(0)" ::: "memory");
    float rli[16];
#pragma unroll
    for (int r = 0; r < 16; ++r) rli[r] = __builtin_amdgcn_rcpf(li_l[crow(r, hi)]);
    if (!DIFF) {
        bf16* Ow = mixed + (rowbase + q0) * D + 128 * h;
#pragma unroll
        for (int r = 0; r < 16; ++r) { const int orow = crow(r, hi);
#pragma unroll
            for (int d0 = 0; d0 < 4; ++d0) { const float v = o[d0][r] * rli[r]; const float vn = __shfl_xor(v, 1);
                if ((r32 & 1) == 0) *(unsigned*)(Ow + (size_t)orow * D + d0 * 32 + r32) = cvtpk(v, vn); } }
        __syncthreads();
    } else {
        __syncthreads();
        LAS float* xb = (LAS float*)(lds + rg * 32768) + lane;
        if (comp == 1) {
#pragma unroll
            for (int d0 = 0; d0 < 8; ++d0)
#pragma unroll
                for (int r = 0; r < 16; ++r) xb[(d0 * 16 + r) * 64] = lam * o[d0][r] * rli[r];
        }
        __syncthreads();
        if (comp == 0) {
            float ssq[16];
#pragma unroll
            for (int r = 0; r < 16; ++r) ssq[r] = 0.f;
#pragma unroll
            for (int d0 = 0; d0 < 8; ++d0)
#pragma unroll
                for (int r = 0; r < 16; ++r) { const float dv = o[d0][r] * rli[r] - xb[(d0 * 16 + r) * 64]; o[d0][r] = dv; ssq[r] += dv * dv; }
#pragma unroll
            for (int r = 0; r < 16; ++r) { float s = ssq[r]; s += __shfl_xor(s, 1); s += __shfl_xor(s, 2); s += __shfl_xor(s, 4); s += __shfl_xor(s, 8); s += __shfl_xor(s, 16);
                ssq[r] = __builtin_amdgcn_rsqf(s * (1.f / 256.f) + RMS_EPS) * 0.8f; }
            bf16* Ow = mixed + (rowbase + q0) * D + 1024 + 256 * h;
#pragma unroll
            for (int d0 = 0; d0 < 8; ++d0) { const float wv = subw[d0 * 32 + r32];
#pragma unroll
                for (int r = 0; r < 16; ++r) { const float v = o[d0][r] * ssq[r] * wv; const float vn = __shfl_xor(v, 1);
                    if ((r32 & 1) == 0) *(unsigned*)(Ow + (size_t)crow(r, hi) * D + d0 * 32 + r32) = cvtpk(v, vn); } }
        }
        __syncthreads();
    }
#undef ISSUE_TILE
#undef TILE_KB
}

struct UnitTab { unsigned v[512]; };
constexpr UnitTab make_units() {
    UnitTab t{}; int n = 0, dj = 31, mi = 15;
    while (dj >= 0 || mi >= 0) {
        const int cd = dj >= 0 ? (dj + 1) * 6144 : -1, cm = mi >= 0 ? (mi + 1) * 8192 : -1;
        if (cd >= cm) { for (int b = 0; b < 2; ++b) for (int h = 0; h < 4; ++h) t.v[n++] = (1u << 16) | ((unsigned)b << 12) | ((unsigned)h << 8) | (unsigned)dj; --dj; }
        else { for (int b = 0; b < 2; ++b) for (int h = 0; h < 8; ++h) t.v[n++] = ((unsigned)b << 12) | ((unsigned)h << 8) | (unsigned)mi; --mi; }
    }
    return t;
}
__constant__ UnitTab g_units = make_units();
#undef KSWZ
#undef SBAR
}

__device__ __forceinline__ void tr_item(const float* __restrict__ W, int N, int K, int k0, int n0, bf16* __restrict__ dst, LAS unsigned* scr, int lane) {
    { const int kr = lane >> 4, nc = (lane & 15) * 4;
      f32x4 v[16];
#pragma unroll
      for (int i = 0; i < 16; ++i) v[i] = *(const f32x4*)(W + (size_t)(k0 + 4 * i + kr) * N + n0 + nc);
#pragma unroll
      for (int i = 0; i < 16; ++i) { const int k = 4 * i + kr; scr[k * 33 + (nc >> 1)] = pk2(v[i][0], v[i][1]); scr[k * 33 + (nc >> 1) + 1] = pk2(v[i][2], v[i][3]); } }
    asm volatile("s_waitcnt lgkmcnt(0)" ::: "memory");
    { const int np = lane >> 3, c = lane & 7;
#pragma unroll
      for (int j = 0; j < 4; ++j) { const int n2 = np + 8 * j; unsigned d[8];
#pragma unroll
          for (int i = 0; i < 8; ++i) d[i] = scr[(8 * c + i) * 33 + n2];
          u32x4 lo, hi;
          lo.x = (d[0] & 0xffffu) | (d[1] << 16); lo.y = (d[2] & 0xffffu) | (d[3] << 16); lo.z = (d[4] & 0xffffu) | (d[5] << 16); lo.w = (d[6] & 0xffffu) | (d[7] << 16);
          hi.x = (d[0] >> 16) | (d[1] & 0xffff0000u); hi.y = (d[2] >> 16) | (d[3] & 0xffff0000u); hi.z = (d[4] >> 16) | (d[5] & 0xffff0000u); hi.w = (d[6] >> 16) | (d[7] & 0xffff0000u);
          *(u32x4*)(dst + (size_t)(2 * n2) * K + k0 + 8 * c) = lo;
          *(u32x4*)(dst + (size_t)(2 * n2 + 1) * K + k0 + 8 * c) = hi; } }
    asm volatile("s_waitcnt lgkmcnt(0)" ::: "memory");
}
__device__ __forceinline__ void rms_row_to_bf16(const float* __restrict__ xrow, const float* __restrict__ w, bf16* __restrict__ orow, int lane) {
    const f32x4* xr = (const f32x4*)xrow + lane; const f32x4* wr = (const f32x4*)w + lane;
    f32x4 v[8]; float s = 0.f;
#pragma unroll
    for (int j = 0; j < 8; ++j) { v[j] = xr[64 * j]; s += (v[j][0] * v[j][0] + v[j][1] * v[j][1]) + (v[j][2] * v[j][2] + v[j][3] * v[j][3]); }
    const float rstd = __builtin_amdgcn_rsqf(wave_sum(s) * (1.f / D) + RMS_EPS);
    u32x2* o8 = (u32x2*)orow + lane;
#pragma unroll
    for (int j = 0; j < 8; ++j) { const f32x4 ww = wr[64 * j]; u32x2 p; p.x = pk2(v[j][0] * rstd * ww[0], v[j][1] * rstd * ww[1]); p.y = pk2(v[j][2] * rstd * ww[2], v[j][3] * rstd * ww[3]); o8[64 * j] = p; }
}


struct Args { const float* in[18]; float* out; unsigned char* ws; int ph_lo, ph_hi, li, pad; };
__global__ void __launch_bounds__(NWAVES * 64, 2) trunk_fwd(Args args) {
    extern __shared__ __attribute__((aligned(16))) unsigned char lds_raw[];
    LAS unsigned char* const lds = (LAS unsigned char*)lds_raw;
    volatile LAS unsigned* const MISC = (volatile LAS unsigned*)(lds + MISC_OFF);
    const int tid = threadIdx.x, lane = tid & 63, wave = __builtin_amdgcn_readfirstlane(tid >> 6);
    const int G = gridDim.x, bx = blockIdx.x;
    const int gw = bx * NWAVES + wave, NGW = G * NWAVES;
    unsigned char* const ws = args.ws;
    unsigned* const ctl = (unsigned*)(ws + WS_CTL);
    const float* const x = args.in[0];
    bf16* const WinT = (bf16*)(ws + WS_WIN); bf16* const WoutT = (bf16*)(ws + WS_WOUT); bf16* const Hb = (bf16*)(ws + WS_H);
    bf16* const WguT = (bf16*)(ws + WS_WGU); bf16* const WdT = (bf16*)(ws + WS_WD);
    bf16* const PROJ = (bf16*)(ws + WS_PROJ); bf16* const XP = (bf16*)(ws + WS_XP); bf16* const MIX = (bf16*)(ws + WS_MIX); bf16* const ACT = (bf16*)(ws + WS_ACT);
    float* const X1 = (float*)(ws + WS_X1); bf16* const Y = (bf16*)(ws + WS_Y);
    bf16* const KMEAN = (bf16*)(ws + WS_KMEAN); u32x4* const TOKINFO = (u32x4*)(ws + WS_TOKINFO); float* const TOKRSTD = (float*)(ws + WS_TOKRSTD);
    int* const ROWINFO = (int*)(ws + WS_ROWINFO); bf16* const WRHI = (bf16*)(ws + WS_WRHI); bf16* const WRLO = (bf16*)(ws + WS_WRLO);

    for (int u = tid; u < (LDS_BYTES - ATT_SCR_OFF) / 4; u += NWAVES * 64) ((LAS unsigned*)(lds + ATT_SCR_OFF))[u] = 0u;
    __syncthreads();
    const int lo = args.ph_lo, hi_ph = args.ph_hi;
    XcdBarrier bar; bar.bar = ctl + CW_BAR + args.li * XCD_BAR_WORDS; bar.x = 0; bar.st = nullptr;
    if (hi_ph - lo > 1) bar = xcd_barrier_post(ctl + CW_BAR + args.li * XCD_BAR_WORDS, MISC + 8);
#define GRID_BAR() xcd_barrier(bar)
#if defined(PROBE_DUP)
    const int POFF = args.li == 1 ? 8192 : 0;
#else
    constexpr int POFF = 0;
#endif
#ifndef PH_MASK
#define PH_MASK 0x3ff
#endif
#define IN(k) (((PH_MASK >> (k)) & 1) && lo <= (k) && (k) < hi_ph)
#define BOTH(k) (IN(k) && IN((k) + 1))

    if (IN(0)) {
        LAS unsigned* scr = (LAS unsigned*)(lds + wave * 16384);
        constexpr int I_IN = 32 * 96, I_OUT = 32 * 32, I_G = 32 * 8 * 32, I_D = 8 * 32 * 32;
        constexpr int NITEMS = I_IN + I_OUT + 2 * I_G + I_D;
        for (int it = gw; it < NITEMS; it += NGW) {
            int r = it;
            if (r < I_IN) { const int kb = r / 96, nb = r % 96; tr_item(args.in[2], NIN, D, 64 * kb, 64 * nb, WinT + (size_t)(64 * nb) * D, scr, lane); continue; } r -= I_IN;
            if (r < I_OUT) { const int kb = r / 32, nb = r % 32; tr_item(args.in[8], D, D, 64 * kb, 64 * nb, WoutT + (size_t)(64 * nb) * D, scr, lane); continue; } r -= I_OUT;
            if (r < 2 * I_G) { const int up = r >= I_G ? 1 : 0; if (up) r -= I_G; const int e = r >> 8, q = r & 255, kb = q >> 3, nb = q & 7, n0 = 64 * nb;
                const float* W = (up ? args.in[15] : args.in[14]) + (size_t)e * D * DE;
                tr_item(W, DE, D, 64 * kb, n0, WguT + ((size_t)e * 1024 + (n0 >> 7) * 256 + (n0 & 127) + up * 128) * D, scr, lane); continue; } r -= 2 * I_G;
            { const int e = r >> 8, q = r & 255, kb = q >> 5, nb = q & 31;
              tr_item(args.in[16] + (size_t)e * DE * D, D, DE, 64 * kb, 64 * nb, WdT + ((size_t)e * 2048 + 64 * nb) * DE, scr, lane); }
        }
        for (int i = bx * 512 + tid; i < 48 * D; i += G * 512) { const int c = i / D, k = i % D;
            const float v = c < 4 ? args.in[10][k * 4 + c] : (c < 36 ? args.in[12][k * 32 + (c - 4)] : 0.f);
            const unsigned h = f2bf(v); WRHI[i] = (bf16)h; WRLO[i] = (bf16)f2bf(v - bf2f(h)); }
        for (int m = gw; m < T; m += NGW) rms_row_to_bf16(x + (size_t)m * D, args.in[1], Hb + (size_t)m * D, lane);
        if (BOTH(0)) GRID_BAR();
    }

    if (IN(1)) {
        pg8::Gemm g{Hb, WinT, T, NIN, D}; pg8::StaticOrder S; S.init(T, NIN, G, bx);
        pg8::EpiProj E{PROJ, NIN, QSCALE};
        pg8::gemm_phase<pg8::EpiProj, pg8::StaticOrder, true, true>(lds, g, S, E);
        if (BOTH(1)) GRID_BAR();
    }

    if (IN(2)) {
        LAS float* red = (LAS float*)lds;
        for (int u = bx; u < 256; u += G) { const int bh = u >> 4, blk = u & 15, b = bh >> 3, h = bh & 7;
            const bf16* kp = PROJ + ((size_t)b * SEQ + 256 * blk + 32 * wave) * NIN + 1024 + 128 * h + 2 * lane;
            float s0 = 0.f, s1 = 0.f;
#pragma unroll 8
            for (int r = 0; r < 32; ++r) { const unsigned v = *(const unsigned*)(kp + (size_t)r * NIN); s0 += bf2f(v & 0xffffu); s1 += bf2f(v >> 16); }
            red[wave * 128 + 2 * lane] = s0; red[wave * 128 + 2 * lane + 1] = s1;
            __syncthreads();
            if (tid < 128) { float s = 0.f;
#pragma unroll
                for (int w = 0; w < 8; ++w) s += red[w * 128 + tid];
                KMEAN[((size_t)bh * 32 + blk) * 128 + tid] = (bf16)f2bf(s * (1.f / 256.f)); }
            if (blk == 0) { for (int i = tid; i < 16 * 128; i += 512) KMEAN[((size_t)bh * 32 + 16) * 128 + i] = 0; }
            __syncthreads();
        }
        if (BOTH(2)) GRID_BAR();
    }

    if (IN(3)) {
        float lam;
        { const float a = args.in[3][lane] * args.in[4][lane] + args.in[3][lane + 64] * args.in[4][lane + 64];
          const float c = args.in[5][lane] * args.in[6][lane] + args.in[5][lane + 64] * args.in[6][lane + 64];
          lam = __expf(wave_sum(a)) - __expf(wave_sum(c)) + 0.2f; }
        for (;;) {
            if (tid == 0) MISC[16] = __hip_atomic_fetch_add(ctl + CW_QHEAD + 64 * args.li, 1u, __ATOMIC_RELAXED, __HIP_MEMORY_SCOPE_AGENT);
            __syncthreads();
            const unsigned qi = __builtin_amdgcn_readfirstlane(MISC[16]);
            if (qi >= 512u) break;
            const unsigned e = att::g_units.v[qi]; const int ty = (int)(e >> 16), b = (int)((e >> 12) & 15u), h = (int)((e >> 8) & 15u), idx = (int)(e & 255u);
            if (ty) att::attn_unit<1>(lds, PROJ, MIX, KMEAN, b, h, idx, lam, args.in[7]);
            else att::attn_unit<0>(lds, PROJ, MIX, KMEAN, b, h, idx, lam, args.in[7]);
        }
        if (BOTH(3)) GRID_BAR();
    }

    if (IN(4)) {
        pg8::Gemm g{MIX, WoutT, T, D, D}; pg8::StaticOrder S; S.init(T, D, G, bx);
        pg8::EpiResid E{x, X1, D};
        pg8::gemm_phase<pg8::EpiResid, pg8::StaticOrder, false, true>(lds, g, S, E);
        if (BOTH(4)) GRID_BAR();
    }

    if (IN(5)) {
        LAS float* lg = (LAS float*)(lds + wave * 4096);
        const float* nw = args.in[9];
        for (int tile = wave * G + bx; tile < T / 16; tile += NGW) {
            const int t0 = tile * 16, row = lane & 15, kq = lane >> 4;
            const float* xr = X1 + (size_t)(t0 + row) * D + 8 * kq;
            pg8::f32x4 acc[3] = {{0.f, 0.f, 0.f, 0.f}, {0.f, 0.f, 0.f, 0.f}, {0.f, 0.f, 0.f, 0.f}};
            float ss = 0.f;
#pragma unroll 2
            for (int s = 0; s < 64; ++s) {
                const f32x4 a0 = *(const f32x4*)(xr + 32 * s), a1 = *(const f32x4*)(xr + 32 * s + 4);
                const f32x4 w0 = *(const f32x4*)(nw + 32 * s + 8 * kq), w1 = *(const f32x4*)(nw + 32 * s + 8 * kq + 4);
                ss += (a0[0] * a0[0] + a0[1] * a0[1]) + (a0[2] * a0[2] + a0[3] * a0[3]) + (a1[0] * a1[0] + a1[1] * a1[1]) + (a1[2] * a1[2] + a1[3] * a1[3]);
                const f32x4 u0 = a0 * w0, u1 = a1 * w1;
                unsigned hb[8]; float uf[8] = {u0[0], u0[1], u0[2], u0[3], u1[0], u1[1], u1[2], u1[3]};
                u32x4 ah, al;
#pragma unroll
                for (int j = 0; j < 8; ++j) hb[j] = f2bf(uf[j]);
                ah.x = hb[0] | (hb[1] << 16); ah.y = hb[2] | (hb[3] << 16); ah.z = hb[4] | (hb[5] << 16); ah.w = hb[6] | (hb[7] << 16);
                al.x = pk2(uf[0] - bf2f(hb[0]), uf[1] - bf2f(hb[1])); al.y = pk2(uf[2] - bf2f(hb[2]), uf[3] - bf2f(hb[3]));
                al.z = pk2(uf[4] - bf2f(hb[4]), uf[5] - bf2f(hb[5])); al.w = pk2(uf[6] - bf2f(hb[6]), uf[7] - bf2f(hb[7]));
                const bf16x8 afh = __builtin_bit_cast(bf16x8, ah), afl = __builtin_bit_cast(bf16x8, al);
#pragma unroll
                for (int ct = 0; ct < 3; ++ct) { const size_t wo = (size_t)(16 * ct + row) * D + 32 * s + 8 * kq;
                    const bf16x8 bh = *(const bf16x8*)(WRHI + wo), bl = *(const bf16x8*)(WRLO + wo);
                    acc[ct] = __builtin_amdgcn_mfma_f32_16x16x32_bf16(afh, bh, acc[ct], 0, 0, 0);
                    acc[ct] = __builtin_amdgcn_mfma_f32_16x16x32_bf16(afh, bl, acc[ct], 0, 0, 0);
                    acc[ct] = __builtin_amdgcn_mfma_f32_16x16x32_bf16(afl, bh, acc[ct], 0, 0, 0); }
            }
            ss += __shfl_xor(ss, 16); ss += __shfl_xor(ss, 32);
            const float rstd = __builtin_amdgcn_rsqf(ss * (1.f / D) + RMS_EPS);
#pragma unroll
            for (int ct = 0; ct < 3; ++ct)
#pragma unroll
                for (int r = 0; r < 4; ++r) lg[(4 * kq + r) * 48 + 16 * ct + row] = acc[ct][r];
            if (kq == 0) lg[768 + row] = rstd;
            asm volatile("s_waitcnt lgkmcnt(0)" ::: "memory");
            if (lane < 16) {
                const LAS float* L = lg + lane * 48; const float rs = lg[768 + lane];
                float gmax = -__builtin_inff(); int gi = 0; float gl[4];
#pragma unroll
                for (int c = 0; c < 4; ++c) { gl[c] = L[c] * rs + args.in[11][c]; if (gl[c] > gmax) { gmax = gl[c]; gi = c; } }
                float gsum = 0.f;
#pragma unroll
                for (int c = 0; c < 4; ++c) gsum += __expf(gl[c] - gmax);
                const float gp = 1.f / gsum;
                float el[8], emax = -__builtin_inff();
#pragma unroll
                for (int j = 0; j < 8; ++j) { el[j] = L[4 + 8 * gi + j] * rs + args.in[13][8 * gi + j]; emax = fmaxf(emax, el[j]); }
                float p0v = -1.f, p1v = -1.f; int i0 = 0, i1 = 0;
#pragma unroll
                for (int j = 0; j < 8; ++j) { const float p = __expf(el[j] - emax);
                    if (p > p0v) { p1v = p0v; i1 = i0; p0v = p; i0 = j; } else if (p > p1v) { p1v = p; i1 = j; } }
                const float inv = gp / (p0v + p1v);
                const int e0 = 8 * gi + i0, e1 = 8 * gi + i1;
                u32x4 info; info.x = (unsigned)e0; info.y = (unsigned)e1; info.z = __builtin_bit_cast(unsigned, p0v * inv); info.w = __builtin_bit_cast(unsigned, p1v * inv);
                TOKINFO[t0 + lane] = info; TOKRSTD[t0 + lane] = rs;
                atomicAdd(ctl + CW_ECNT + POFF + 64 * e0, 1u); atomicAdd(ctl + CW_ECNT + POFF + 64 * e1, 1u);
            }
            asm volatile("s_waitcnt lgkmcnt(0)" ::: "memory");
        }
        if (BOTH(5)) GRID_BAR();
    }

    LAS int* const tab = (LAS int*)(lds + MOE_TAB_OFF);
    if (IN(6) || IN(7) || IN(8)) {
        if (tid < 32) tab[120 + tid] = (int)__hip_atomic_load(ctl + CW_ECNT + 64 * tid, __ATOMIC_RELAXED, __HIP_MEMORY_SCOPE_AGENT);
        __syncthreads();
        if (tid == 0) { int ts = 0;
            for (int e = 0; e < 32; ++e) { const int c = tab[120 + e], nt = (c + 255) >> 8; tab[e] = ts; tab[40 + e] = ts; tab[80 + e] = ts * 256 + c; ts += nt; }
            tab[32] = ts; }
        __syncthreads();
    }

    if (IN(6)) {
        const float* nw = args.in[9];
        static_assert(T == 4 * 8 * 256, "P6 deal assumes 4 tokens per wave on 256 workgroups");
        for (int tb = gw; tb < T; tb += 4 * NGW) {
            int mp0 = 0, mp1 = 0; unsigned mw0 = 0u, mw1 = 0u; float mrs = 0.f;
            if (lane < 4 && tb + lane * NGW < T) { const int t = tb + lane * NGW; const u32x4 info = TOKINFO[t]; mrs = TOKRSTD[t];
                const int e0 = (int)info.x, e1 = (int)info.y; mw0 = info.z; mw1 = info.w;
                mp0 = (int)atomicAdd(ctl + CW_ECUR + POFF + 64 * e0, 1u) + tab[40 + e0] * 256; mp1 = (int)atomicAdd(ctl + CW_ECUR + POFF + 64 * e1, 1u) + tab[40 + e1] * 256; }
#pragma unroll
            for (int i = 0; i < 4; ++i) { const int t = tb + i * NGW; if (t >= T) break;
                const int p0 = __builtin_amdgcn_readlane(mp0, i), p1 = __builtin_amdgcn_readlane(mp1, i);
                const float rs = __builtin_bit_cast(float, __builtin_amdgcn_readlane(__builtin_bit_cast(int, mrs), i));
                const f32x4* xr = (const f32x4*)(X1 + (size_t)t * D) + lane; const f32x4* wr = (const f32x4*)nw + lane;
                u32x2* o0 = (u32x2*)(XP + (size_t)p0 * D) + lane; u32x2* o1 = (u32x2*)(XP + (size_t)p1 * D) + lane;
#pragma unroll
                for (int j = 0; j < 8; ++j) { const f32x4 v = xr[64 * j], ww = wr[64 * j]; u32x2 p; p.x = pk2(v[0] * rs * ww[0], v[1] * rs * ww[1]); p.y = pk2(v[2] * rs * ww[2], v[3] * rs * ww[3]);
                    o0[64 * j] = p; o1[64 * j] = p; }
                if (lane == i) { ROWINFO[2 * mp0] = 2 * t; ROWINFO[2 * mp0 + 1] = (int)mw0; ROWINFO[2 * mp1] = 2 * t + 1; ROWINFO[2 * mp1 + 1] = (int)mw1; }
            }
        }
        if (BOTH(6)) GRID_BAR();
    }

    if (IN(7)) {
        pg8::Gemm g{XP, WguT, XP_ROWS, NE * 1024, D}; pg8::MoeOrder S{tab, 4, tab[32] * 4, G, bx};
        pg8::EpiSwiGLU E{ACT};
        pg8::gemm_phase<pg8::EpiSwiGLU, pg8::MoeOrder, true, true>(lds, g, S, E);
        if (BOTH(7)) GRID_BAR();
    }

    if (IN(8)) {
        pg8::Gemm g{ACT, WdT, XP_ROWS, NE * 2048, DE}; pg8::MoeOrder S{tab, 8, tab[32] * 8, G, bx};
        pg8::EpiDown E{Y, ROWINFO, tab + 80};
        pg8::gemm_phase<pg8::EpiDown, pg8::MoeOrder, true, true>(lds, g, S, E);
        if (BOTH(8)) GRID_BAR();
    }

    if (IN(9)) {
        const float* nf = args.in[17];
        for (int t = gw; t < T; t += NGW) {
            const f32x4* xr = (const f32x4*)(X1 + (size_t)t * D) + lane;
            const u32x2* y0 = (const u32x2*)(Y + (size_t)(2 * t) * D) + lane; const u32x2* y1 = (const u32x2*)(Y + (size_t)(2 * t + 1) * D) + lane;
            f32x4 v[8]; float s = 0.f;
#pragma unroll
            for (int j = 0; j < 8; ++j) { f32x4 a = xr[64 * j]; const u32x2 p = y0[64 * j], q = y1[64 * j];
                a[0] += bf2f(p.x & 0xffffu) + bf2f(q.x & 0xffffu); a[1] += bf2f(p.x >> 16) + bf2f(q.x >> 16);
                a[2] += bf2f(p.y & 0xffffu) + bf2f(q.y & 0xffffu); a[3] += bf2f(p.y >> 16) + bf2f(q.y >> 16);
                v[j] = a; s += (a[0] * a[0] + a[1] * a[1]) + (a[2] * a[2] + a[3] * a[3]); }
            const float rstd = __builtin_amdgcn_rsqf(wave_sum(s) * (1.f / D) + RMS_EPS);
            f32x4* orow = (f32x4*)(args.out + (size_t)t * D) + lane; const f32x4* wr = (const f32x4*)nf + lane;
#pragma unroll
            for (int j = 0; j < 8; ++j) orow[64 * j] = v[j] * rstd * wr[64 * j];
        }
    }
#undef IN
#undef BOTH
#undef GRID_BAR
}

extern "C" void kernel_launch(void* const* d_in, const int* in_sizes, int n_in, void* d_out, int out_size, void* d_ws, size_t ws_size, hipStream_t stream) {
    static int grid = 0;
    if (grid == 0) {
        if (n_in != 18 || in_sizes[0] != T * D || out_size != T * D || ws_size < WS_END) { fprintf(stderr, "kernel_launch: unexpected shapes (n_in %d, in0 %d, out %d, ws %zu)\n", n_in, n_in > 0 ? in_sizes[0] : -1, out_size, ws_size); grid = -1; return; }
        int dev = 0, cus = 0, per_cu = 0;
        if (hipGetDevice(&dev) != hipSuccess || hipDeviceGetAttribute(&cus, hipDeviceAttributeMultiprocessorCount, dev) != hipSuccess) { grid = -1; return; }
        if (hipFuncSetAttribute((const void*)trunk_fwd, hipFuncAttributeMaxDynamicSharedMemorySize, LDS_BYTES) != hipSuccess) { fprintf(stderr, "kernel_launch: hipFuncSetAttribute failed\n"); grid = -1; return; }
        if (hipOccupancyMaxActiveBlocksPerMultiprocessor(&per_cu, (const void*)trunk_fwd, NWAVES * 64, LDS_BYTES) != hipSuccess || per_cu < 1)
            fprintf(stderr, "kernel_launch: note: occupancy query reports %d workgroups per CU\n", per_cu);
        (void)hipGetLastError();
        grid = cus;
    }
    if (grid < 0) return;
    if (hipMemsetAsync((char*)d_ws + WS_CTL, 0, CTL_ZERO_BYTES, stream) != hipSuccess) return;
    Args a{};
    for (int i = 0; i < 18; ++i) a.in[i] = (const float*)d_in[i];
    a.out = (float*)d_out; a.ws = (unsigned char*)d_ws;
    int plan[NPH + 2][2]; int nl = 0;
#if defined(PROBE_DUP)
    plan[nl][0] = 0; plan[nl][1] = PROBE_DUP + 1; ++nl; plan[nl][0] = PROBE_DUP; plan[nl][1] = PROBE_DUP + 1; ++nl;
    if (PROBE_DUP + 1 < NPH) { plan[nl][0] = PROBE_DUP + 1; plan[nl][1] = NPH; ++nl; }
#else
    if (N_LAUNCHES == 1) { plan[0][0] = 0; plan[0][1] = NPH; nl = 1; } else { for (int k = 0; k < NPH; ++k) { plan[k][0] = k; plan[k][1] = k + 1; } nl = NPH; }
#endif
    for (int li = 0; li < nl; ++li) {
        a.ph_lo = plan[li][0]; a.ph_hi = plan[li][1]; a.li = li;
        hipLaunchKernelGGL(trunk_fwd, dim3(grid), dim3(NWAVES * 64), LDS_BYTES, stream, a);
    }
}
```

```cpp
#include <hip/hip_runtime.h>
#include <cstdio>
#include <cstdint>

#ifndef MK_N_LAUNCHES
#define MK_N_LAUNCHES 1
#endif
constexpr int NPH = 10;
constexpr int N_LAUNCHES = MK_N_LAUNCHES;

constexpr int NWAVES = 8;
constexpr int BATCH = 2, SEQ = 4096, T = BATCH * SEQ, D = 2048, NIN = 6144;
constexpr int NE = 32, DE = 512, NPAIR = 2 * T;
constexpr int XP_ROWS = 24576;
constexpr float RMS_EPS = 1e-6f;
constexpr float LOG2E = 1.4426950408889634f;
constexpr float QSCALE = 0.08838834764831845f * 1.4426950408889634f;

constexpr size_t MiB = 1u << 20;
constexpr size_t WS_CTL = 0, CTL_ZERO_BYTES = 1 * MiB;
constexpr size_t WS_WIN = 1 * MiB;
constexpr size_t WS_WOUT = 25 * MiB;
constexpr size_t WS_H = 33 * MiB;
constexpr size_t WS_Y = 1 * MiB;
constexpr size_t WS_WGU = 65 * MiB;
constexpr size_t WS_WD = 193 * MiB;
constexpr size_t WS_PROJ = 257 * MiB;
constexpr size_t WS_XP = 257 * MiB;
constexpr size_t WS_MIX = 353 * MiB;
constexpr size_t WS_ACT = 353 * MiB;
constexpr size_t WS_X1 = 385 * MiB;
constexpr size_t WS_MISC = 449 * MiB;
constexpr size_t WS_KMEAN = WS_MISC;
constexpr size_t WS_TOKINFO = WS_MISC + 256 * 1024;
constexpr size_t WS_TOKRSTD = WS_MISC + 384 * 1024;
constexpr size_t WS_ROWINFO = WS_MISC + 512 * 1024;
constexpr size_t WS_WRHI = WS_MISC + 1024 * 1024;
constexpr size_t WS_WRLO = WS_MISC + 1280 * 1024;
constexpr size_t WS_END = 452 * MiB;
constexpr int CW_BAR = 4096;
constexpr int CW_ECNT = 16384;
constexpr int CW_ECUR = 16384 + 2048;
constexpr int CW_QHEAD = 16384 + 4096;

constexpr int RING_BYTES = 131072;
constexpr int ATT_SCR_OFF = 131072;
constexpr int MOE_TAB_OFF = 135168;
constexpr int MISC_OFF = 136192;
constexpr int QTAB_OFF = 136448;
constexpr int LDS_BYTES = 147456;

#define GAS __attribute__((address_space(1)))
#define LAS __attribute__((address_space(3)))
typedef unsigned short bf16;
typedef float f32x4 __attribute__((ext_vector_type(4)));
typedef float f32x16 __attribute__((ext_vector_type(16)));
typedef short bf16x8 __attribute__((ext_vector_type(8)));
typedef short s16x4 __attribute__((ext_vector_type(4)));
typedef unsigned u32x4 __attribute__((ext_vector_type(4)));
typedef unsigned u32x2 __attribute__((ext_vector_type(2)));

__device__ __forceinline__ unsigned f2bf(float f) { unsigned u = __builtin_bit_cast(unsigned, f); return (u + 0x7fffu + ((u >> 16) & 1u)) >> 16; }
__device__ __forceinline__ unsigned pk2(float lo, float hi) { return f2bf(lo) | (f2bf(hi) << 16); }
__device__ __forceinline__ float bf2f(unsigned b) { return __builtin_bit_cast(float, b << 16); }
__device__ __forceinline__ float wave_sum(float v) {
#pragma unroll
    for (int o = 1; o < 64; o <<= 1) v += __shfl_xor(v, o);
    return v;
}
namespace pg8 {
#define PG8_LAS __attribute__((address_space(3)))
typedef unsigned short bf16_t;
typedef short bf16x8 __attribute__((ext_vector_type(8)));
typedef float f32x4 __attribute__((ext_vector_type(4)));
typedef unsigned u32x4 __attribute__((ext_vector_type(4)));
constexpr int BM = 256, BK = 64, HALF = 128, HTB = HALF * BK * 2  , STAGE_BYTES = 8 * HTB, NXCD = 8, WGM = 8;

__host__ __device__ __forceinline__ int lds_byte(int r, int c) { const int st = (r >> 4) * 2 + (c >> 5), rr = r & 15, cc = c & 31, ob = rr * 64 + cc * 2; return st * 1024 + (ob ^ (((ob >> 9) & 1) << 5)); }
__host__ __device__ __forceinline__ void stage_rc(int b, int& R, int& C) { const int st = b / 1024, sb = b % 1024, swz = sb ^ (((sb >> 9) & 1) << 5); R = (st >> 1) * 16 + swz / 64; C = (st & 1) * 32 + (swz % 64) / 2; }
__host__ __device__ __forceinline__ int perm32(int rho) { const int n = rho >> 4, i = rho & 15; return 8 * (i >> 2) + 4 * n + (i & 3); }

struct Unit { int pm, pn; };
struct Gemm { const bf16_t* A; const bf16_t* Bt; int M, N, K; };

struct StaticOrder {
    int nM, nN, nwg, G, c;
    __host__ __device__ void init(int M, int N, int G_, int c_) { nM = M / BM; nN = N / BM; nwg = nM * nN; G = G_; c = c_; }
    __host__ __device__ bool next(int i, Unit& u) const {
        const long L = (long)i * G + c; if (L >= nwg) return false;
        int wgid = (int)L; { const int q = nwg / NXCD, r = nwg % NXCD, xcd = wgid % NXCD, off = wgid / NXCD; wgid = (xcd < r ? xcd * (q + 1) : r * (q + 1) + (xcd - r) * q) + off; }
        const int nig = WGM * nN, gid = wgid / nig, fm = gid * WGM, gsz = (nM - fm) < WGM ? (nM - fm) : WGM;
        u.pm = fm + ((wgid % nig) % gsz); u.pn = (wgid % nig) / gsz; return true;
    }
    __device__ __forceinline__ void a_ready(const Unit&) const {}
    __device__ __forceinline__ void done(const Unit&) const {}
};

__device__ __forceinline__ unsigned cvt_pk_bf16(float lo, float hi) { unsigned r; asm volatile("v_cvt_pk_bf16_f32 %0, %1, %2" : "=v"(r) : "v"(lo), "v"(hi)); return r; }
typedef float f32x2 __attribute__((ext_vector_type(2)));
struct EpiProj {
    static constexpr bool PERM = true, AFTER_DRAIN = false;
    bf16_t* O; int ldc; float qscale;
    __device__ __forceinline__ void operator()(const f32x4 (&acc)[2][2][4][2], const Unit& u, int wr, int wc, int fr, int fq) const {
        const int row0 = u.pm * BM + wr * 64 + fr, col0 = u.pn * BM + wc * 32 + 8 * fq;
        const float sc = (u.pn < 4 || (u.pn >= 12 && u.pn < 16)) ? qscale : 1.f;
#pragma unroll
        for (int ai = 0; ai < 2; ++ai)
#pragma unroll
            for (int m = 0; m < 4; ++m) { bf16_t* rowp = O + (size_t)(row0 + ai * HALF + m * 16) * ldc + col0;
#pragma unroll
                for (int bj = 0; bj < 2; ++bj) { const f32x4 v0 = acc[ai][bj][m][0] * sc, v1 = acc[ai][bj][m][1] * sc;
                    u32x4 w; w.x = cvt_pk_bf16(v0[0], v0[1]); w.y = cvt_pk_bf16(v0[2], v0[3]); w.z = cvt_pk_bf16(v1[0], v1[1]); w.w = cvt_pk_bf16(v1[2], v1[3]);
                    *(u32x4*)(rowp + bj * HALF) = w; } }
    }
};
struct EpiResid {
    static constexpr bool PERM = true, AFTER_DRAIN = false;
    const float* X; float* X1; int ldc;
    __device__ __forceinline__ void operator()(const f32x4 (&acc)[2][2][4][2], const Unit& u, int wr, int wc, int fr, int fq) const {
        const int row0 = u.pm * BM + wr * 64 + fr, col0 = u.pn * BM + wc * 32 + 8 * fq;
#pragma unroll
        for (int ai = 0; ai < 2; ++ai)
#pragma unroll
            for (int m = 0; m < 4; ++m) { const size_t off = (size_t)(row0 + ai * HALF + m * 16) * ldc + col0;
#pragma unroll
                for (int bj = 0; bj < 2; ++bj)
#pragma unroll
                    for (int n = 0; n < 2; ++n) { const f32x4 xv = *(const f32x4*)(X + off + bj * HALF + 4 * n); *(f32x4*)(X1 + off + bj * HALF + 4 * n) = xv + acc[ai][bj][m][n]; } }
    }
};
__device__ __forceinline__ float silu_mul(float g, float u) { return g * u * __builtin_amdgcn_rcpf(1.f + __builtin_amdgcn_exp2f(-1.4426950408889634f * g)); }
struct EpiSwiGLU {
    static constexpr bool PERM = true, AFTER_DRAIN = false;
    bf16_t* ACT;
    __device__ __forceinline__ void operator()(const f32x4 (&acc)[2][2][4][2], const Unit& u, int wr, int wc, int fr, int fq) const {
        const int row0 = u.pm * BM + wr * 64 + fr, col0 = (u.pn & 3) * 128 + wc * 32 + 8 * fq;
#pragma unroll
        for (int ai = 0; ai < 2; ++ai)
#pragma unroll
            for (int m = 0; m < 4; ++m) { const f32x4 g0 = acc[ai][0][m][0], g1 = acc[ai][0][m][1], u0 = acc[ai][1][m][0], u1 = acc[ai][1][m][1];
                u32x4 w; w.x = cvt_pk_bf16(silu_mul(g0[0], u0[0]), silu_mul(g0[1], u0[1])); w.y = cvt_pk_bf16(silu_mul(g0[2], u0[2]), silu_mul(g0[3], u0[3]));
                w.z = cvt_pk_bf16(silu_mul(g1[0], u1[0]), silu_mul(g1[1], u1[1])); w.w = cvt_pk_bf16(silu_mul(g1[2], u1[2]), silu_mul(g1[3], u1[3]));
                *(u32x4*)(ACT + (size_t)(row0 + ai * HALF + m * 16) * 512 + col0) = w; }
    }
};
struct EpiDown {
    static constexpr bool PERM = true, AFTER_DRAIN = false;
    bf16_t* Y; const int* rowinfo; const PG8_LAS int* rowend;
    __device__ __forceinline__ void operator()(const f32x4 (&acc)[2][2][4][2], const Unit& u, int wr, int wc, int fr, int fq) const {
        const int e = u.pn >> 3, rend = rowend[e];
        const int row0 = u.pm * BM + wr * 64 + fr, col0 = (u.pn & 7) * BM + wc * 32 + 8 * fq;
#pragma unroll
        for (int ai = 0; ai < 2; ++ai)
#pragma unroll
            for (int m = 0; m < 4; ++m) { const int pos = row0 + ai * HALF + m * 16;
                if (pos < rend) { const int pair = rowinfo[2 * pos]; const float wgt = __builtin_bit_cast(float, rowinfo[2 * pos + 1]);
                    bf16_t* rowp = Y + (size_t)pair * 2048 + col0;
#pragma unroll
                    for (int bj = 0; bj < 2; ++bj) { const f32x4 v0 = acc[ai][bj][m][0] * wgt, v1 = acc[ai][bj][m][1] * wgt;
                        u32x4 w; w.x = cvt_pk_bf16(v0[0], v0[1]); w.y = cvt_pk_bf16(v0[2], v0[3]); w.z = cvt_pk_bf16(v1[0], v1[1]); w.w = cvt_pk_bf16(v1[2], v1[3]);
                        *(u32x4*)(rowp + bj * HALF) = w; } } }
    }
};
struct MoeOrder {
    const PG8_LAS int* tab; int npn, total, G, c;
    __device__ __forceinline__ bool next(int i, Unit& u) const {
        const int L = i * G + c; if (L >= total) return false;
        const int tile = L / npn, pn = L - tile * npn; int e = 0;
#pragma unroll 4
        for (int j = 1; j < 32; ++j) e += (tab[j] <= tile) ? 1 : 0;
        u.pm = tab[40 + e] + (tile - tab[e]); u.pn = e * npn + pn; return true;
    }
    __device__ __forceinline__ void a_ready(const Unit&) const {}
    __device__ __forceinline__ void done(const Unit&) const {}
};

template <class Epi, class Sched, bool ALIGN_EPI = false, bool SP2 = false>
__device__ __forceinline__ void gemm_phase(PG8_LAS unsigned char* lds, const Gemm g, const Sched& S, const Epi& E) {
    const int tid = threadIdx.x, wid = __builtin_amdgcn_readfirstlane(tid >> 6), lane = tid & 63, wr = wid >> 2, wc = wid & 3, fr = lane & 15, fq = lane >> 4;
    const int K = g.K, nt = K / BK;
    unsigned voffA[2], voffB[2];
#pragma unroll
    for (int i = 0; i < 2; ++i) { int R, C; stage_rc(tid * 16 + i * 8192, R, C); const int Rb = Epi::PERM ? ((R & ~31) + perm32(R & 31)) : R;
        voffA[i] = (unsigned)(R * K + C) * 2u; voffB[i] = (unsigned)(Rb * K + C) * 2u; }
    const size_t kstep = (size_t)(BK * 2);
    const size_t hstep = (size_t)HALF * K * 2;
    const size_t tstep = 2 * hstep;
    const unsigned ldsw = (unsigned)wid * 1024u;
    const int aoff = lds_byte(wr * 64 + fr, fq * 8), boff = lds_byte(wc * 32 + fr, fq * 8);
#define PG8_SA(b, h) (((b) * 2 + (h)) * HTB)
#define PG8_SB(b, h) ((4 + (b) * 2 + (h)) * HTB)
#define PG8_STAGE(bufoff, gbase, voff) do { _Pragma("unroll") for (int _i = 0; _i < 2; ++_i) \
        __builtin_amdgcn_global_load_lds((const unsigned*)((const char*)(gbase) + (voff)[_i]), (PG8_LAS unsigned*)(lds + (bufoff) + ldsw + _i * 8192), 16, 0, 0); } while (0)
#define PG8_LDA(dst, b, h) do { _Pragma("unroll") for (int m = 0; m < 4; ++m) _Pragma("unroll") for (int k = 0; k < 2; ++k) dst[m][k] = *(const PG8_LAS bf16x8*)(lds + PG8_SA(b, h) + aoff + m * 2048 + k * 1024); } while (0)
#define PG8_LDB(dst, b, h) do { _Pragma("unroll") for (int n = 0; n < 2; ++n) _Pragma("unroll") for (int k = 0; k < 2; ++k) dst[n][k] = *(const PG8_LAS bf16x8*)(lds + PG8_SB(b, h) + boff + n * 2048 + k * 1024); } while (0)
#define PG8_MMA(ai, bj, At, Bt) do { __builtin_amdgcn_s_setprio(1); _Pragma("unroll") for (int m = 0; m < 4; ++m) _Pragma("unroll") for (int n = 0; n < 2; ++n) _Pragma("unroll") for (int k = 0; k < 2; ++k) \
        acc[ai][bj][m][n] = __builtin_amdgcn_mfma_f32_16x16x32_bf16(Bt[n][k], At[m][k], acc[ai][bj][m][n], 0, 0, 0); __builtin_amdgcn_s_setprio(0); } while (0)
#define PG8_WAIT_V(n) asm volatile("s_waitcnt vmcnt(" #n ")" ::: "memory")
#define PG8_WAIT_L(n) asm volatile("s_waitcnt lgkmcnt(" #n ")" ::: "memory")
#define PG8_BAR __builtin_amdgcn_s_barrier()
#define PG8_SCHED __builtin_amdgcn_sched_barrier(0)
    Unit cur, nxt; int ui = 0;
    if (!S.next(0, cur)) return;
    f32x4 acc[2][2][4][2];
#pragma unroll
    for (int a = 0; a < 2; ++a)
#pragma unroll
        for (int b = 0; b < 2; ++b)
#pragma unroll
            for (int m = 0; m < 4; ++m)
#pragma unroll
                for (int n = 0; n < 2; ++n) acc[a][b][m][n] = (f32x4){0.f, 0.f, 0.f, 0.f};
    bf16x8 At[4][2], B0[2][2], B1[2][2];
    const char* cA = (const char*)g.A + (size_t)cur.pm * tstep; const char* cB = (const char*)g.Bt + (size_t)cur.pn * tstep;
    S.a_ready(cur);
    if constexpr (SP2) {
        PG8_STAGE(PG8_SB(0, 0), cB, voffB); PG8_STAGE(PG8_SB(0, 1), cB + hstep, voffB); PG8_STAGE(PG8_SA(0, 0), cA, voffA); PG8_STAGE(PG8_SA(0, 1), cA + hstep, voffA);
        if (wr == 1) PG8_BAR;
        PG8_WAIT_V(2); PG8_BAR;
        PG8_STAGE(PG8_SB(1, 0), cB + kstep, voffB); PG8_STAGE(PG8_SA(1, 0), cA + kstep, voffA); PG8_STAGE(PG8_SB(1, 1), cB + hstep + kstep, voffB);
        PG8_WAIT_V(6); PG8_BAR;
    } else {
        PG8_STAGE(PG8_SB(0, 0), cB, voffB); PG8_STAGE(PG8_SA(0, 0), cA, voffA); PG8_STAGE(PG8_SB(0, 1), cB + hstep, voffB); PG8_STAGE(PG8_SA(0, 1), cA + hstep, voffA);
        if (wr == 1) PG8_BAR;
        PG8_WAIT_V(4); PG8_BAR;
        PG8_STAGE(PG8_SB(1, 0), cB + kstep, voffB); PG8_STAGE(PG8_SA(1, 0), cA + kstep, voffA); PG8_STAGE(PG8_SB(1, 1), cB + hstep + kstep, voffB);
        PG8_WAIT_V(6); PG8_BAR;
    }
    for (;;) {
        const bool has_next = S.next(ui + 1, nxt);
        const char* nA = has_next ? (const char*)g.A + (size_t)nxt.pm * tstep : cA; const char* nB = has_next ? (const char*)g.Bt + (size_t)nxt.pn * tstep : cB;
        for (int t = 0; t < nt; t += 2) {
            const bool last = (t == nt - 2);
            const char* a1 = cA + (size_t)(t + 1) * kstep;
            const char* a2 = last ? nA : cA + (size_t)(t + 2) * kstep; const char* b2 = last ? nB : cB + (size_t)(t + 2) * kstep;
            const char* a3 = a2 + kstep; const char* b3 = b2 + kstep;
            if (last && has_next) S.a_ready(nxt);
            if constexpr (SP2) {
            PG8_LDB(B0, 0, 0); PG8_LDB(B1, 0, 1); PG8_SCHED; PG8_LDA(At, 0, 0); PG8_STAGE(PG8_SA(1, 1), a1 + hstep, voffA);
            PG8_WAIT_V(8); PG8_WAIT_L(0); PG8_BAR; PG8_MMA(0, 0, At, B0); PG8_MMA(0, 1, At, B1); PG8_BAR; PG8_SCHED;
            PG8_LDA(At, 0, 1); PG8_STAGE(PG8_SB(0, 0), b2, voffB); PG8_STAGE(PG8_SB(0, 1), b2 + hstep, voffB); PG8_STAGE(PG8_SA(0, 0), a2, voffA);
            PG8_WAIT_V(8); PG8_WAIT_L(0); PG8_BAR; PG8_MMA(1, 0, At, B0); PG8_MMA(1, 1, At, B1); PG8_BAR; PG8_SCHED;
            PG8_LDB(B0, 1, 0); PG8_LDB(B1, 1, 1); PG8_SCHED; PG8_LDA(At, 1, 0); PG8_STAGE(PG8_SA(0, 1), a2 + hstep, voffA);
            PG8_WAIT_V(8); PG8_WAIT_L(0); PG8_BAR; PG8_MMA(0, 0, At, B0); PG8_MMA(0, 1, At, B1); PG8_BAR; PG8_SCHED;
            PG8_LDA(At, 1, 1); PG8_STAGE(PG8_SB(1, 0), b3, voffB); PG8_STAGE(PG8_SB(1, 1), b3 + hstep, voffB); PG8_STAGE(PG8_SA(1, 0), a3, voffA);
            PG8_WAIT_V(8); PG8_WAIT_L(0); PG8_BAR; PG8_MMA(1, 0, At, B0); PG8_MMA(1, 1, At, B1); PG8_BAR; PG8_SCHED;
            } else {
            PG8_LDB(B0, 0, 0); PG8_SCHED; PG8_LDA(At, 0, 0); PG8_STAGE(PG8_SA(1, 1), a1 + hstep, voffA);
            PG8_WAIT_L(8); PG8_BAR; PG8_WAIT_L(0); PG8_MMA(0, 0, At, B0); PG8_BAR; PG8_SCHED;
            PG8_LDB(B1, 0, 1); PG8_STAGE(PG8_SB(0, 0), b2, voffB);
            PG8_BAR; PG8_WAIT_L(0); PG8_MMA(0, 1, At, B1); PG8_BAR;
            PG8_LDA(At, 0, 1); PG8_STAGE(PG8_SA(0, 0), a2, voffA);
            PG8_BAR; PG8_WAIT_L(0); PG8_MMA(1, 0, At, B0); PG8_BAR; PG8_SCHED;
            PG8_STAGE(PG8_SB(0, 1), b2 + hstep, voffB);
            PG8_WAIT_V(6); PG8_BAR; PG8_MMA(1, 1, At, B1); PG8_BAR;
            PG8_LDB(B0, 1, 0); PG8_SCHED; PG8_LDA(At, 1, 0); PG8_STAGE(PG8_SA(0, 1), a2 + hstep, voffA);
            PG8_WAIT_L(8); PG8_BAR; PG8_WAIT_L(0); PG8_MMA(0, 0, At, B0); PG8_BAR; PG8_SCHED;
            PG8_LDB(B1, 1, 1); PG8_STAGE(PG8_SB(1, 0), b3, voffB);
            PG8_BAR; PG8_WAIT_L(0); PG8_MMA(0, 1, At, B1); PG8_BAR;
            PG8_LDA(At, 1, 1); PG8_STAGE(PG8_SA(1, 0), a3, voffA);
            PG8_BAR; PG8_WAIT_L(0); PG8_MMA(1, 0, At, B0); PG8_BAR; PG8_SCHED;
            PG8_STAGE(PG8_SB(1, 1), b3 + hstep, voffB);
            PG8_WAIT_V(6); PG8_BAR; PG8_MMA(1, 1, At, B1); PG8_BAR;
            }
        }
        if constexpr (ALIGN_EPI) { if (wr == 0) PG8_BAR; }
        if constexpr (!Epi::AFTER_DRAIN) { E(acc, cur, wr, wc, fr, fq); S.done(cur); }
        if (!has_next) break;
#pragma unroll
        for (int a = 0; a < 2; ++a)
#pragma unroll
            for (int b = 0; b < 2; ++b)
#pragma unroll
                for (int m = 0; m < 4; ++m)
#pragma unroll
                    for (int n = 0; n < 2; ++n) acc[a][b][m][n] = (f32x4){0.f, 0.f, 0.f, 0.f};
        cur = nxt; cA = nA; cB = nB; ++ui;
        if constexpr (ALIGN_EPI) { if (wr == 1) PG8_BAR; }
    }
    PG8_WAIT_V(0);
    if constexpr (!ALIGN_EPI) { if (wr == 0) PG8_BAR; }
    PG8_BAR;
    if constexpr (Epi::AFTER_DRAIN) { E.fused(acc, cur, wr, wc, fr, fq, lds, wid, lane); S.done(cur); }
#undef PG8_SA
#undef PG8_SB
#undef PG8_STAGE
#undef PG8_LDA
#undef PG8_LDB
#undef PG8_MMA
#undef PG8_WAIT_V
#undef PG8_WAIT_L
#undef PG8_BAR
#undef PG8_SCHED
}
}
#define XB_TMO      128
#define XB_XCNT(j)  (256  + 64 * (j))
#define XB_XSUB(j)  (1280 + 64 * (j))
#define XB_XGEN(j)  (2304 + 64 * (j))
#define XB_TOP      3328
#define XB_TOPGEN   3392
#define XCD_BAR_WORDS 3456
#define XB_SPIN_CAP (1u << 18)

__device__ __forceinline__ unsigned xb_ld(unsigned* p)              { return __hip_atomic_load(p, __ATOMIC_RELAXED, __HIP_MEMORY_SCOPE_AGENT); }
__device__ __forceinline__ unsigned xb_add(unsigned* p, unsigned v) { return __hip_atomic_fetch_add(p, v, __ATOMIC_RELAXED, __HIP_MEMORY_SCOPE_AGENT); }
__device__ __forceinline__ unsigned xb_xcc_id() { return (unsigned)__builtin_amdgcn_s_getreg((3 << 11) | 20) & 0xFu; }
#define XB_SPIN(cond, bar) do { unsigned _sp = 0; while (cond) { __builtin_amdgcn_s_sleep(1); \
    if ((++_sp & 255u) == 0u) { if (xb_ld(&(bar)[XB_TMO])) break; if (_sp > XB_SPIN_CAP) { atomicAdd(&(bar)[XB_TMO], 1u); break; } } } } while (0)

struct XcdBarrier {
    unsigned* bar; unsigned x;
    volatile LAS unsigned* st;
};

__device__ __forceinline__ XcdBarrier xcd_barrier_post(unsigned* bar, volatile LAS unsigned* st) {
    XcdBarrier b; b.bar = bar; b.x = xb_xcc_id(); b.st = st;
    if (threadIdx.x == 0) (void)xb_add(&bar[XB_XCNT(b.x)], 1u);
    return b;
}
__device__ __forceinline__ void xcd_barrier_complete(unsigned* bar, unsigned x, unsigned& nloc, unsigned& nx) {
    const unsigned G = gridDim.x * gridDim.y * gridDim.z;
    unsigned sum, cnt, mine, sp = 0u;
    for (;;) {
        sum = 0u; cnt = 0u; mine = 0u;
#pragma unroll
        for (unsigned j = 0; j < 16; ++j) { const unsigned c = xb_ld(&bar[XB_XCNT(j)]); sum += c; cnt += (c > 0u) ? 1u : 0u; mine = (j == x) ? c : mine; }
        if (sum == G) break;
        __builtin_amdgcn_s_sleep(1);
        if ((++sp & 255u) == 0u) { if (xb_ld(&bar[XB_TMO])) break; if (sp > XB_SPIN_CAP) { atomicAdd(&bar[XB_TMO], 1u); break; } }
    }
    nloc = mine > 0u ? mine : 1u; nx = cnt > 0u ? cnt : 1u;
}

__device__ __forceinline__ void xcd_barrier(const XcdBarrier& b) {
    asm volatile("s_waitcnt vmcnt(0)" ::: "memory");
    __syncthreads();
    if (threadIdx.x == 0) {
        unsigned* bar = b.bar;
        __builtin_amdgcn_s_waitcnt(0);
        unsigned nloc = b.st[0], nx = b.st[1];
        if (nloc == 0u) { xcd_barrier_complete(bar, b.x, nloc, nx); b.st[0] = nloc; b.st[1] = nx; }
        const unsigned old = xb_add(&bar[XB_XSUB(b.x)], 1u);
        const unsigned gen = old / nloc;
        if (old + 1u == (gen + 1u) * nloc) {
            __builtin_amdgcn_fence(__ATOMIC_RELEASE, "agent");
            asm volatile("s_waitcnt vmcnt(0)" ::: "memory");
            const unsigned og = xb_add(&bar[XB_TOP], 1u);
            const unsigned tg = og / nx;
            if (og + 1u == (tg + 1u) * nx) xb_add(&bar[XB_TOPGEN], 1u);
            else XB_SPIN(xb_ld(&bar[XB_TOPGEN]) == tg, bar);
            __builtin_amdgcn_fence(__ATOMIC_ACQUIRE, "agent");
            xb_add(&bar[XB_XGEN(b.x)], 1u);
            asm volatile("s_waitcnt vmcnt(0)" ::: "memory");
        } else {
            XB_SPIN(xb_ld(&bar[XB_XGEN(b.x)]) == gen, bar);
            __builtin_amdgcn_fence(__ATOMIC_ACQUIRE, "agent");
            asm volatile("s_waitcnt vmcnt(0)" ::: "memory");
        }
    }
    __syncthreads();
}

namespace att {
constexpr int PITCH = NIN;
constexpr int STAGE = 65536, SUB = 16384;
typedef short v4i16_t __attribute__((ext_vector_type(4)));
constexpr float THR2 = 11.5f;
constexpr float PSKIP = -140.f;
#define KSWZ(row, colB) ((row) * 256 + ((colB) ^ (((row) & 7) << 4)))
#define SBAR() __builtin_amdgcn_sched_barrier(0)
__device__ __forceinline__ int v_rd_base(int lane) { return ((lane & 3) << 3) | (((lane >> 2) & 3) << 6) | (((lane >> 4) & 1) << 5) | (((lane >> 5) & 1) << 8); }
constexpr int v_rd_off(int d0, int ks, int half) { return d0 * 512 + ks * 4096 + half * 2048; }
__device__ __forceinline__ int crow(int r, int hi) { return (r & 3) + 8 * (r >> 2) + 4 * hi; }
__device__ __forceinline__ unsigned cvtpk(float lo, float hi) { unsigned r; asm volatile("v_cvt_pk_bf16_f32 %0, %1, %2" : "=v"(r) : "v"(lo), "v"(hi)); return r; }

__device__ __forceinline__ void qkt(f32x16& p0, f32x16& p1, const LAS unsigned char* Ks, int r32, int hi, const bf16x8* qr) {
    const LAS unsigned char* kb[4];
#pragma unroll
    for (int dd = 0; dd < 4; ++dd) kb[dd] = Ks + KSWZ(r32, (dd * 16 + hi * 8) * 2);
#pragma unroll
    for (int d0 = 0; d0 < 8; ++d0) { const LAS unsigned char* a = kb[d0 & 3] + (d0 >> 2) * 128;
        const bf16x8 b0 = *(const LAS bf16x8*)a;
        const bf16x8 b1 = *(const LAS bf16x8*)(a + 32 * 256);
        p0 = __builtin_amdgcn_mfma_f32_32x32x16_bf16(b0, qr[d0], p0, 0, 0, 0);
        p1 = __builtin_amdgcn_mfma_f32_32x32x16_bf16(b1, qr[d0], p1, 0, 0, 0); }
}
__device__ __forceinline__ void pv_tile(f32x16* o, unsigned vb0, bf16x8 pa0, bf16x8 pa1, bf16x8 pa2, bf16x8 pa3) {
#define TRRD(dst, off) asm volatile("ds_read_b64_tr_b16 %0, %1 offset:%2" : "=&v"(dst) : "v"(vb0), "i"(off) : "memory")
#define PV_D0(d0) do { s16x4 l0, l1, l2, l3, h0, h1, h2, h3; constexpr int b_ = v_rd_off(d0, 0, 0); \
        TRRD(l0, b_); TRRD(h0, b_ + 2048); TRRD(l1, b_ + 4096); TRRD(h1, b_ + 6144); TRRD(l2, b_ + 8192); TRRD(h2, b_ + 10240); TRRD(l3, b_ + 12288); TRRD(h3, b_ + 14336); \
        asm volatile("s_waitcnt lgkmcnt(0)" ::: "memory"); SBAR(); \
        o[d0] = __builtin_amdgcn_mfma_f32_32x32x16_bf16(pa0, (bf16x8){l0[0], l0[1], l0[2], l0[3], h0[0], h0[1], h0[2], h0[3]}, o[d0], 0, 0, 0); \
        o[d0] = __builtin_amdgcn_mfma_f32_32x32x16_bf16(pa1, (bf16x8){l1[0], l1[1], l1[2], l1[3], h1[0], h1[1], h1[2], h1[3]}, o[d0], 0, 0, 0); \
        o[d0] = __builtin_amdgcn_mfma_f32_32x32x16_bf16(pa2, (bf16x8){l2[0], l2[1], l2[2], l2[3], h2[0], h2[1], h2[2], h2[3]}, o[d0], 0, 0, 0); \
        o[d0] = __builtin_amdgcn_mfma_f32_32x32x16_bf16(pa3, (bf16x8){l3[0], l3[1], l3[2], l3[3], h3[0], h3[1], h3[2], h3[3]}, o[d0], 0, 0, 0); } while (0)
    PV_D0(0); PV_D0(1); PV_D0(2); PV_D0(3);
#undef PV_D0
#undef TRRD
}
__device__ __forceinline__ void glds16(const bf16* g, LAS unsigned char* l) {
    __builtin_amdgcn_global_load_lds((const unsigned*)g, (LAS unsigned*)l, 16, 0, 0);
}

template <int DIFF, int HF>
__device__ __forceinline__ void half_step(f32x16* o, float& m_reg, float& l_reg, const bf16x8* qr, const LAS unsigned char* Kst, unsigned vb0, LAS float* al_l,
                                          int kbh, int q0, int r32, int hi, float slope2, bool selbit) {
    constexpr int NO = DIFF ? 8 : 4;
    if (kbh > q0 + 31) return;
    float binit = slope2 * (float)(kbh - (q0 + r32) + 4 * hi);
    if (!selbit) binit = -__builtin_inff();
    f32x16 p;
#pragma unroll
    for (int r = 0; r < 16; ++r) p[r] = fmaf(slope2, (float)((r & 3) + 8 * (r >> 2)), binit);
    {
        const LAS unsigned char* kb4[4];
#pragma unroll
        for (int dd = 0; dd < 4; ++dd) kb4[dd] = Kst + KSWZ(r32, (dd * 16 + hi * 8) * 2) + HF * 8192;
        if (DIFF) {
            bf16x8 kf[4];
#pragma unroll
            for (int d0 = 0; d0 < 4; ++d0) kf[d0] = *(const LAS bf16x8*)(kb4[d0]);
            SBAR();
#pragma unroll
            for (int d0 = 0; d0 < 4; ++d0) { p = __builtin_amdgcn_mfma_f32_32x32x16_bf16(kf[d0], qr[d0], p, 0, 0, 0); kf[d0] = *(const LAS bf16x8*)(kb4[d0] + 128); }
            SBAR();
#pragma unroll
            for (int d0 = 0; d0 < 4; ++d0) p = __builtin_amdgcn_mfma_f32_32x32x16_bf16(kf[d0], qr[4 + d0], p, 0, 0, 0);
        } else {
            bf16x8 kf[8];
#pragma unroll
            for (int d0 = 0; d0 < 8; ++d0) kf[d0] = *(const LAS bf16x8*)(kb4[d0 & 3] + (d0 >> 2) * 128);
            SBAR();
#pragma unroll
            for (int d0 = 0; d0 < 8; ++d0) p = __builtin_amdgcn_mfma_f32_32x32x16_bf16(kf[d0], qr[d0], p, 0, 0, 0);
        }
    }
    if (kbh + 31 > q0) {
        const int dq = q0 + r32 - kbh - 4 * hi; const float NEG = -__builtin_inff();
#pragma unroll
        for (int r = 0; r < 16; ++r) { const int c = (r & 3) + 8 * (r >> 2); if (c > dq) p[r] = NEG; }
    }
    float pmax = p[0];
#pragma unroll
    for (int r = 1; r < 16; ++r) pmax = fmaxf(pmax, p[r]);
    { auto rr = __builtin_amdgcn_permlane32_swap(__float_as_uint(pmax), __float_as_uint(pmax), false, false); pmax = fmaxf(__uint_as_float(rr[0]), __uint_as_float(rr[1])); }
    if (__all(pmax - m_reg < PSKIP)) return;
    float mn, alpha;
    if (__all(pmax - m_reg <= THR2)) { mn = m_reg; alpha = 1.f; }
    else { mn = fmaxf(m_reg, pmax); alpha = __builtin_amdgcn_exp2f(m_reg - mn); m_reg = mn; }
#pragma unroll
    for (int r = 0; r < 16; ++r) p[r] = __builtin_amdgcn_exp2f(p[r] - mn);
    float ps = 0.f;
#pragma unroll
    for (int r = 0; r < 16; ++r) ps += p[r];
    { auto rr = __builtin_amdgcn_permlane32_swap(__float_as_uint(ps), __float_as_uint(ps), false, false); ps = __uint_as_float(rr[0]) + __uint_as_float(rr[1]); }
    l_reg = l_reg * alpha + ps;
    bf16x8 pa0, pa1;
#define PK4(P, B_, OUT) do { unsigned a0 = cvtpk(P[B_ + 0], P[B_ + 1]), a1 = cvtpk(P[B_ + 2], P[B_ + 3]); \
        unsigned b0 = cvtpk(P[B_ + 4], P[B_ + 5]), b1 = cvtpk(P[B_ + 6], P[B_ + 7]); \
        auto r0 = __builtin_amdgcn_permlane32_swap(a0, b0, false, false); auto r1 = __builtin_amdgcn_permlane32_swap(a1, b1, false, false); \
        u32x4 w = {r0[0], r1[0], r0[1], r1[1]}; OUT = __builtin_bit_cast(bf16x8, w); } while (0)
    PK4(p, 0, pa0); PK4(p, 8, pa1);
#undef PK4
    if (__any(alpha < 1.f)) {
        if (hi == 0) al_l[r32] = alpha;
        asm volatile("s_waitcnt lgkmcnt(0)" ::: "memory");
#pragma unroll
        for (int r = 0; r < 16; ++r) { const float a = al_l[crow(r, hi)];
#pragma unroll
            for (int d = 0; d < NO; ++d) o[d][r] *= a; }
    }
    {
        const LAS unsigned char* vp = (const LAS unsigned char*)(uintptr_t)vb0;
#define VTR(off) __builtin_bit_cast(s16x4, __builtin_amdgcn_ds_read_tr16_b64_v4i16((LAS v4i16_t*)(vp + (off))))
#define GOFF(g) (((g) >> 2) * SUB + v_rd_off((g) & 3, 2 * HF, 0))
#define LOADG(V, g) do { V[0] = VTR(GOFF(g)); V[1] = VTR(GOFF(g) + 2048); V[2] = VTR(GOFF(g) + 4096); V[3] = VTR(GOFF(g) + 6144); } while (0)
#define MMAG(V, g) do { o[g] = __builtin_amdgcn_mfma_f32_32x32x16_bf16(pa0, (bf16x8){V[0][0], V[0][1], V[0][2], V[0][3], V[1][0], V[1][1], V[1][2], V[1][3]}, o[g], 0, 0, 0); \
                        o[g] = __builtin_amdgcn_mfma_f32_32x32x16_bf16(pa1, (bf16x8){V[2][0], V[2][1], V[2][2], V[2][3], V[3][0], V[3][1], V[3][2], V[3][3]}, o[g], 0, 0, 0); } while (0)
        s16x4 va[4], vc[4];
        LOADG(va, 0); LOADG(vc, 1); SBAR();
        MMAG(va, 0); LOADG(va, 2); SBAR();
        MMAG(vc, 1); LOADG(vc, 3); SBAR();
        if (DIFF) {
            MMAG(va, 2); LOADG(va, 4); SBAR();
            MMAG(vc, 3); LOADG(vc, 5); SBAR();
            MMAG(va, 4); LOADG(va, 6); SBAR();
            MMAG(vc, 5); LOADG(vc, 7); SBAR();
            MMAG(va, 6); SBAR();
            MMAG(vc, 7);
        } else {
            MMAG(va, 2); SBAR();
            MMAG(vc, 3);
        }
#undef MMAG
#undef LOADG
#undef GOFF
#undef VTR
    }
}

template <int DIFF>
__device__ __forceinline__ void attn_unit(LAS unsigned char* lds, const bf16* __restrict__ proj, bf16* __restrict__ mixed, const bf16* __restrict__ kmean,
                                          int b, int h, int idx, float lam, const float* __restrict__ subw, int pmode = 0) {
    constexpr int NO = DIFF ? 8 : 4;
    const int tid = threadIdx.x, lane = tid & 63, wid = __builtin_amdgcn_readfirstlane(tid >> 6), r32 = lane & 31, hi = lane >> 5;
    const int rg = wid & 3, comp = wid >> 2;
    const int q0 = DIFF ? (128 * idx + 32 * rg) : (256 * idx + 32 * wid);
    const size_t rowbase = (size_t)b * SEQ;
    const int qcol = DIFF ? (3072 + 256 * h + 128 * comp) : (128 * h);
    const int kcol = DIFF ? (4096 + 256 * h) : (1024 + 128 * h);
    const int vcol = DIFF ? (5120 + 256 * h) : (2048 + 128 * h);
    const float slope2 = (DIFF ? __builtin_amdgcn_exp2f(-2.f * (float)(h + 1)) : __builtin_amdgcn_exp2f(-(float)(h + 1))) * LOG2E;
    const int NT = DIFF ? 2 * (idx + 1) : 4 * (idx + 1);
    int koff, voff;
    { const int row = 4 * wid + (lane >> 4), ch = (lane & 15) ^ (row & 7); koff = row * PITCH + 8 * ch;
      const int sub = 2 * wid + (lane >> 5), kk = 8 * (sub >> 2) + ((lane & 31) >> 2), k = (kk & ~0xC) | ((kk & 4) << 1) | ((kk & 8) >> 1), c = 32 * (sub & 3) + 8 * (lane & 3);
      voff = k * PITCH + c; }
    LAS unsigned char* const dst0 = lds + wid * 1024;
#define ISSUE_TILE(st, kb_) do { const bf16* g_ = proj + (rowbase + (size_t)(kb_)) * PITCH; LAS unsigned char* d_ = dst0 + (st) * STAGE; \
        _Pragma("unroll") for (int i_ = 0; i_ < 2; ++i_) { \
            glds16(g_ + kcol + koff + i_ * 32 * PITCH, d_ + i_ * 8192); \
            if (DIFF) { glds16(g_ + kcol + 128 + koff + i_ * 32 * PITCH, d_ + SUB + i_ * 8192); \
                        glds16(g_ + vcol + voff + i_ * 32 * PITCH, d_ + 2 * SUB + i_ * 8192); \
                        glds16(g_ + vcol + 128 + voff + i_ * 32 * PITCH, d_ + 3 * SUB + i_ * 8192); } \
            else { glds16(g_ + vcol + voff + i_ * 32 * PITCH, d_ + SUB + i_ * 8192); } } } while (0)
#define TILE_KB(t_) (DIFF ? 64 * (NT - 1 - (t_)) : ((t_) < 4 ? 256 * idx + 64 * (3 - (t_)) : 256 * (idx - 1 - (((t_) - 4) >> 2)) + 64 * (3 - (((t_) - 4) & 3))))
    ISSUE_TILE(0, TILE_KB(0));
    if (!DIFF && idx > 0) {
        const int row = 4 * wid + (lane >> 4), ch = (lane & 15) ^ (row & 7);
        glds16(kmean + ((size_t)(b * 8 + h) * 32 + row) * 128 + 8 * ch, dst0 + STAGE);
    }
    bf16x8 qr[8];
    { const bf16* qp = proj + (rowbase + q0 + r32) * PITCH + qcol + hi * 8;
#pragma unroll
      for (int d0 = 0; d0 < 8; ++d0) qr[d0] = *(const bf16x8*)(qp + d0 * 16); }
    LAS float* const al_l = (LAS float*)(lds + ATT_SCR_OFF + wid * 512);
    LAS float* const li_l = al_l + 32;
    unsigned sel = 0u;
    if (!DIFF && idx > 0) {
        asm volatile("s_waitcnt vmcnt(0)" ::: "memory"); __syncthreads();
        f32x16 g = {};
        { const LAS unsigned char* Ks = lds + STAGE;
#pragma unroll
          for (int d0 = 0; d0 < 8; ++d0) { const LAS unsigned char* a = Ks + KSWZ(r32, ((d0 & 3) * 16 + hi * 8) * 2) + (d0 >> 2) * 128;
              g = __builtin_amdgcn_mfma_f32_32x32x16_bf16(*(const LAS bf16x8*)a, qr[d0], g, 0, 0, 0); } }
        float gv[16]; int gn[16];
#pragma unroll
        for (int r = 0; r < 8; ++r) { const int nb = (r & 3) + 8 * (r >> 2);
            gv[r] = g[r]; gn[r] = nb + 4 * hi; gv[8 + r] = __shfl_xor(g[r], 32); gn[8 + r] = nb + 4 * (1 - hi); }
        const float NEG = -__builtin_inff();
        float m1 = NEG, m2 = NEG, m3 = NEG;
#pragma unroll
        for (int i = 0; i < 16; ++i) { float v = gn[i] < idx ? gv[i] : NEG;
            float t1 = fmaxf(m1, v); v = fminf(m1, v); m1 = t1; float t2 = fmaxf(m2, v); v = fminf(m2, v); m2 = t2; m3 = fmaxf(m3, v); }
#pragma unroll
        for (int i = 0; i < 16; ++i) if (gn[i] < idx && gv[i] >= m3) sel |= 1u << gn[i];
    }
    float m_reg = -1e30f, l_reg = 0.f;
    f32x16 o[NO];
#pragma unroll
    for (int d = 0; d < NO; ++d) o[d] = f32x16{};
    const unsigned ldsu = (unsigned)(uintptr_t)lds;
    const int ksub = DIFF ? comp : 0;
    for (int t = 0; t < NT; ++t) {
        asm volatile("s_waitcnt vmcnt(0)" ::: "memory"); __syncthreads();
        if (t + 1 < NT && !(pmode & 1)) ISSUE_TILE((t + 1) & 1, TILE_KB(t + 1));
        const int kb = TILE_KB(t);
        const bool past = !DIFF && t >= 4;
        const bool selbit = past ? (((sel >> (idx - 1 - ((t - 4) >> 2))) & 1u) != 0u) : true;
        const int stoff = (t & 1) * STAGE;
        const LAS unsigned char* Kst = lds + stoff + ksub * SUB;
        const unsigned vb0 = ldsu + stoff + (DIFF ? 2 : 1) * SUB + v_rd_base(lane);
        if (!(pmode & 2)) {
        half_step<DIFF, 1>(o, m_reg, l_reg, qr, Kst, vb0, al_l, kb + 32, q0, r32, hi, slope2, selbit);
        half_step<DIFF, 0>(o, m_reg, l_reg, qr, Kst, vb0, al_l, kb, q0, r32, hi, slope2, selbit);
        }
    }
    if (hi == 0) li_l[r32] = l_reg;
    asm volatile("s_waitcnt lgkmcnt(0)" ::: "memory");
    float rli[16];
#pragma unroll
    for (int r = 0; r < 16; ++r) rli[r] = __builtin_amdgcn_rcpf(li_l[crow(r, hi)]);
    if (!DIFF) {
        bf16* Ow = mixed + (rowbase + q0) * D + 128 * h;
#pragma unroll
        for (int r = 0; r < 16; ++r) { const int orow = crow(r, hi);
#pragma unroll
            for (int d0 = 0; d0 < 4; ++d0) { const float v = o[d0][r] * rli[r]; const float vn = __shfl_xor(v, 1);
                if ((r32 & 1) == 0) *(unsigned*)(Ow + (size_t)orow * D + d0 * 32 + r32) = cvtpk(v, vn); } }
        __syncthreads();
    } else {
        __syncthreads();
        LAS float* xb = (LAS float*)(lds + rg * 32768) + lane;
        if (comp == 1) {
#pragma unroll
            for (int d0 = 0; d0 < 8; ++d0)
#pragma unroll
                for (int r = 0; r < 16; ++r) xb[(d0 * 16 + r) * 64] = lam * o[d0][r] * rli[r];
        }
        __syncthreads();
        if (comp == 0) {
            float ssq[16];
#pragma unroll
            for (int r = 0; r < 16; ++r) ssq[r] = 0.f;
#pragma unroll
            for (int d0 = 0; d0 < 8; ++d0)
#pragma unroll
                for (int r = 0; r < 16; ++r) { const float dv = o[d0][r] * rli[r] - xb[(d0 * 16 + r) * 64]; o[d0][r] = dv; ssq[r] += dv * dv; }
#pragma unroll
            for (int r = 0; r < 16; ++r) { float s = ssq[r]; s += __shfl_xor(s, 1); s += __shfl_xor(s, 2); s += __shfl_xor(s, 4); s += __shfl_xor(s, 8); s += __shfl_xor(s, 16);
                ssq[r] = __builtin_amdgcn_rsqf(s * (1.f / 256.f) + RMS_EPS) * 0.8f; }
            bf16* Ow = mixed + (rowbase + q0) * D + 1024 + 256 * h;
#pragma unroll
            for (int d0 = 0; d0 < 8; ++d0) { const float wv = subw[d0 * 32 + r32];
#pragma unroll
                for (int r = 0; r < 16; ++r) { const float v = o[d0][r] * ssq[r] * wv; const float vn = __shfl_xor(v, 1);
                    if ((r32 & 1) == 0) *(unsigned*)(Ow + (size_t)crow(r, hi) * D + d0 * 32 + r32) = cvtpk(v, vn); } }
        }
        __syncthreads();
    }
#undef ISSUE_TILE
#undef TILE_KB
}

#undef KSWZ
#undef SBAR
}

__device__ __forceinline__ void tr_item(const float* __restrict__ W, int N, int K, int k0, int n0, bf16* __restrict__ dst, LAS unsigned* scr, int lane) {
    { const int kr = lane >> 4, nc = (lane & 15) * 4;
      f32x4 v[16];
#pragma unroll
      for (int i = 0; i < 16; ++i) v[i] = *(const f32x4*)(W + (size_t)(k0 + 4 * i + kr) * N + n0 + nc);
#pragma unroll
      for (int i = 0; i < 16; ++i) { const int k = 4 * i + kr; scr[k * 33 + (nc >> 1)] = pk2(v[i][0], v[i][1]); scr[k * 33 + (nc >> 1) + 1] = pk2(v[i][2], v[i][3]); } }
    asm volatile("s_waitcnt lgkmcnt(0)" ::: "memory");
    { const int np = lane >> 3, c = lane & 7;
#pragma unroll
      for (int j = 0; j < 4; ++j) { const int n2 = np + 8 * j; unsigned d[8];
#pragma unroll
          for (int i = 0; i < 8; ++i) d[i] = scr[(8 * c + i) * 33 + n2];
          u32x4 lo, hi;
          lo.x = (d[0] & 0xffffu) | (d[1] << 16); lo.y = (d[2] & 0xffffu) | (d[3] << 16); lo.z = (d[4] & 0xffffu) | (d[5] << 16); lo.w = (d[6] & 0xffffu) | (d[7] << 16);
          hi.x = (d[0] >> 16) | (d[1] & 0xffff0000u); hi.y = (d[2] >> 16) | (d[3] & 0xffff0000u); hi.z = (d[4] >> 16) | (d[5] & 0xffff0000u); hi.w = (d[6] >> 16) | (d[7] & 0xffff0000u);
          *(u32x4*)(dst + (size_t)(2 * n2) * K + k0 + 8 * c) = lo;
          *(u32x4*)(dst + (size_t)(2 * n2 + 1) * K + k0 + 8 * c) = hi; } }
    asm volatile("s_waitcnt lgkmcnt(0)" ::: "memory");
}
__device__ __forceinline__ void rms_row_to_bf16(const float* __restrict__ xrow, const float* __restrict__ w, bf16* __restrict__ orow, int lane) {
    const f32x4* xr = (const f32x4*)xrow + lane; const f32x4* wr = (const f32x4*)w + lane;
    f32x4 v[8]; float s = 0.f;
#pragma unroll
    for (int j = 0; j < 8; ++j) { v[j] = xr[64 * j]; s += (v[j][0] * v[j][0] + v[j][1] * v[j][1]) + (v[j][2] * v[j][2] + v[j][3] * v[j][3]); }
    const float rstd = __builtin_amdgcn_rsqf(wave_sum(s) * (1.f / D) + RMS_EPS);
    u32x2* o8 = (u32x2*)orow + lane;
#pragma unroll
    for (int j = 0; j < 8; ++j) { const f32x4 ww = wr[64 * j]; u32x2 p; p.x = pk2(v[j][0] * rstd * ww[0], v[j][1] * rstd * ww[1]); p.y = pk2(v[j][2] * rstd * ww[2], v[j][3] * rstd * ww[3]); o8[64 * j] = p; }
}


struct Args { const float* in[18]; float* out; unsigned char* ws; int ph_lo, ph_hi, li, pad; };
__global__ void __launch_bounds__(NWAVES * 64, 2) trunk_fwd(Args args) {
    extern __shared__ __attribute__((aligned(16))) unsigned char lds_raw[];
    LAS unsigned char* const lds = (LAS unsigned char*)lds_raw;
    volatile LAS unsigned* const MISC = (volatile LAS unsigned*)(lds + MISC_OFF);
    const int tid = threadIdx.x, lane = tid & 63, wave = __builtin_amdgcn_readfirstlane(tid >> 6);
    const int G = gridDim.x, bx = blockIdx.x;
    const int gw = bx * NWAVES + wave, NGW = G * NWAVES;
    unsigned char* const ws = args.ws;
    unsigned* const ctl = (unsigned*)(ws + WS_CTL);
    const float* const x = args.in[0];
    bf16* const WinT = (bf16*)(ws + WS_WIN); bf16* const WoutT = (bf16*)(ws + WS_WOUT); bf16* const Hb = (bf16*)(ws + WS_H);
    bf16* const WguT = (bf16*)(ws + WS_WGU); bf16* const WdT = (bf16*)(ws + WS_WD);
    bf16* const PROJ = (bf16*)(ws + WS_PROJ); bf16* const XP = (bf16*)(ws + WS_XP); bf16* const MIX = (bf16*)(ws + WS_MIX); bf16* const ACT = (bf16*)(ws + WS_ACT);
    float* const X1 = (float*)(ws + WS_X1); bf16* const Y = (bf16*)(ws + WS_Y);
    bf16* const KMEAN = (bf16*)(ws + WS_KMEAN); u32x4* const TOKINFO = (u32x4*)(ws + WS_TOKINFO); float* const TOKRSTD = (float*)(ws + WS_TOKRSTD);
    int* const ROWINFO = (int*)(ws + WS_ROWINFO); bf16* const WRHI = (bf16*)(ws + WS_WRHI); bf16* const WRLO = (bf16*)(ws + WS_WRLO);

    for (int u = tid; u < (LDS_BYTES - ATT_SCR_OFF) / 4; u += NWAVES * 64) ((LAS unsigned*)(lds + ATT_SCR_OFF))[u] = 0u;
    __syncthreads();
    const int lo = args.ph_lo, hi_ph = args.ph_hi;
    XcdBarrier bar; bar.bar = ctl + CW_BAR + args.li * XCD_BAR_WORDS; bar.x = 0; bar.st = nullptr;
    if (hi_ph - lo > 1) bar = xcd_barrier_post(ctl + CW_BAR + args.li * XCD_BAR_WORDS, MISC + 8);
#define GRID_BAR() xcd_barrier(bar)
#if defined(PROBE_DUP)
    const int POFF = args.li == 1 ? 8192 : 0;
#else
    constexpr int POFF = 0;
#endif
#ifndef PH_MASK
#define PH_MASK 0x3ff
#endif
#define IN(k) (((PH_MASK >> (k)) & 1) && lo <= (k) && (k) < hi_ph)
#define BOTH(k) (IN(k) && IN((k) + 1))

    if (IN(0)) {
        LAS unsigned* scr = (LAS unsigned*)(lds + wave * 16384);
        constexpr int I_IN = 32 * 96, I_OUT = 32 * 32, I_G = 32 * 8 * 32, I_D = 8 * 32 * 32;
        constexpr int NITEMS = I_IN + I_OUT + 2 * I_G + I_D;
        for (int it = gw; it < NITEMS; it += NGW) {
            int r = it;
            if (r < I_IN) { const int kb = r / 96, nb = r % 96; tr_item(args.in[2], NIN, D, 64 * kb, 64 * nb, WinT + (size_t)(64 * nb) * D, scr, lane); continue; } r -= I_IN;
            if (r < I_OUT) { const int kb = r / 32, nb = r % 32; tr_item(args.in[8], D, D, 64 * kb, 64 * nb, WoutT + (size_t)(64 * nb) * D, scr, lane); continue; } r -= I_OUT;
            if (r < 2 * I_G) { const int up = r >= I_G ? 1 : 0; if (up) r -= I_G; const int e = r >> 8, q = r & 255, kb = q >> 3, nb = q & 7, n0 = 64 * nb;
                const float* W = (up ? args.in[15] : args.in[14]) + (size_t)e * D * DE;
                tr_item(W, DE, D, 64 * kb, n0, WguT + ((size_t)e * 1024 + (n0 >> 7) * 256 + (n0 & 127) + up * 128) * D, scr, lane); continue; } r -= 2 * I_G;
            { const int e = r >> 8, q = r & 255, kb = q >> 5, nb = q & 31;
              tr_item(args.in[16] + (size_t)e * DE * D, D, DE, 64 * kb, 64 * nb, WdT + ((size_t)e * 2048 + 64 * nb) * DE, scr, lane); }
        }
        for (int i = bx * 512 + tid; i < 48 * D; i += G * 512) { const int c = i / D, k = i % D;
            const float v = c < 4 ? args.in[10][k * 4 + c] : (c < 36 ? args.in[12][k * 32 + (c - 4)] : 0.f);
            const unsigned h = f2bf(v); WRHI[i] = (bf16)h; WRLO[i] = (bf16)f2bf(v - bf2f(h)); }
        for (int m = gw; m < T; m += NGW) rms_row_to_bf16(x + (size_t)m * D, args.in[1], Hb + (size_t)m * D, lane);
        if (BOTH(0)) GRID_BAR();
    }

    if (IN(1)) {
        pg8::Gemm g{Hb, WinT, T, NIN, D}; pg8::StaticOrder S; S.init(T, NIN, G, bx);
        pg8::EpiProj E{PROJ, NIN, QSCALE};
        pg8::gemm_phase<pg8::EpiProj, pg8::StaticOrder, true, true>(lds, g, S, E);
        if (BOTH(1)) GRID_BAR();
    }

    if (IN(2)) {
        LAS float* red = (LAS float*)lds;
        for (int u = bx; u < 256; u += G) { const int bh = u >> 4, blk = u & 15, b = bh >> 3, h = bh & 7;
            const bf16* kp = PROJ + ((size_t)b * SEQ + 256 * blk + 32 * wave) * NIN + 1024 + 128 * h + 2 * lane;
            float s0 = 0.f, s1 = 0.f;
#pragma unroll 8
            for (int r = 0; r < 32; ++r) { const unsigned v = *(const unsigned*)(kp + (size_t)r * NIN); s0 += bf2f(v & 0xffffu); s1 += bf2f(v >> 16); }
            red[wave * 128 + 2 * lane] = s0; red[wave * 128 + 2 * lane + 1] = s1;
            __syncthreads();
            if (tid < 128) { float s = 0.f;
#pragma unroll
                for (int w = 0; w < 8; ++w) s += red[w * 128 + tid];
                KMEAN[((size_t)bh * 32 + blk) * 128 + tid] = (bf16)f2bf(s * (1.f / 256.f)); }
            if (blk == 0) { for (int i = tid; i < 16 * 128; i += 512) KMEAN[((size_t)bh * 32 + 16) * 128 + i] = 0; }
            __syncthreads();
        }
        if (BOTH(2)) GRID_BAR();
    }

    if (IN(3)) {
        float lam;
        { const float a = args.in[3][lane] * args.in[4][lane] + args.in[3][lane + 64] * args.in[4][lane + 64];
          const float c = args.in[5][lane] * args.in[6][lane] + args.in[5][lane + 64] * args.in[6][lane + 64];
          lam = __expf(wave_sum(a)) - __expf(wave_sum(c)) + 0.2f; }
        LAS int* const ucost = (LAS int*)(lds + QTAB_OFF); LAS unsigned* const uperm = (LAS unsigned*)(lds + QTAB_OFF + 2048);
        { const int u = tid, ty = u >> 8, b = (u >> 7) & 1; int c; unsigned ent;
          if (ty) { const int h = (u >> 5) & 3, j = u & 31, nt = 2 * (j + 1); const int dh = h == 0 ? 444 : (h == 1 ? 1774 : 8192); int near = dh / 64 + 3; near = near < nt ? near : nt;
              c = near * 48 + (nt - near) * 18; ent = (1u << 16) | ((unsigned)b << 12) | ((unsigned)h << 8) | (unsigned)j; }
          else { const int h = (u >> 4) & 7, i = u & 15, nt = 4 * (i + 1); const int dh = h < 5 ? (222 << h) : 8192; int near = dh / 64 + 5; near = near < nt ? near : nt;
              c = near * 32 + (nt - near) * 17; ent = ((unsigned)b << 12) | ((unsigned)h << 8) | (unsigned)i; }
          ucost[u] = c; __syncthreads();
          int rank = 0;
          for (int v = 0; v < 512; ++v) { const int cv = ucost[v]; rank += (cv > c || (cv == c && v < u)) ? 1 : 0; }
          uperm[rank] = ent; __syncthreads(); }
        for (;;) {
            if (tid == 0) MISC[16] = __hip_atomic_fetch_add(ctl + CW_QHEAD + 64 * args.li, 1u, __ATOMIC_RELAXED, __HIP_MEMORY_SCOPE_AGENT);
            __syncthreads();
            const unsigned qi = __builtin_amdgcn_readfirstlane(MISC[16]);
            if (qi >= 512u) break;
            const unsigned e = __builtin_amdgcn_readfirstlane(uperm[qi]); const int ty = (int)(e >> 16), b = (int)((e >> 12) & 15u), h = (int)((e >> 8) & 15u), idx = (int)(e & 255u);
#if defined(PROBE_DUP) && defined(PROBE_MODE)
            const int pmode = args.li == 1 ? PROBE_MODE : 0; bf16* const mixo = args.li == 1 ? Hb : MIX;
#else
            constexpr int pmode = 0; bf16* const mixo = MIX;
#endif
            if (ty) att::attn_unit<1>(lds, PROJ, mixo, KMEAN, b, h, idx, lam, args.in[7], pmode);
            else att::attn_unit<0>(lds, PROJ, mixo, KMEAN, b, h, idx, lam, args.in[7], pmode);
        }
        if (BOTH(3)) GRID_BAR();
    }

    if (IN(4)) {
        pg8::Gemm g{MIX, WoutT, T, D, D}; pg8::StaticOrder S; S.init(T, D, G, bx);
        pg8::EpiResid E{x, X1, D};
        pg8::gemm_phase<pg8::EpiResid, pg8::StaticOrder, false, true>(lds, g, S, E);
        if (BOTH(4)) GRID_BAR();
    }

    if (IN(5)) {
        LAS float* lg = (LAS float*)(lds + wave * 4096);
        const float* nw = args.in[9];
        const int nit5 = (T / 16 + 2 * G - 1) / (2 * G);
        for (int it = 0; it < nit5; ++it) {
            const int tile = (2 * it + (wave >> 2)) * G + bx; const bool tvalid = tile < T / 16;
            const int t0 = (tvalid ? tile : 0) * 16, row = lane & 15, kq = lane >> 4, kpart = wave & 3;
            const float* xr = X1 + (size_t)(t0 + row) * D + 8 * kq;
            pg8::f32x4 acc[3] = {{0.f, 0.f, 0.f, 0.f}, {0.f, 0.f, 0.f, 0.f}, {0.f, 0.f, 0.f, 0.f}};
            float ss = 0.f;
#pragma unroll 2
            for (int s = 16 * kpart; s < 16 * kpart + 16; ++s) {
                const f32x4 a0 = *(const f32x4*)(xr + 32 * s), a1 = *(const f32x4*)(xr + 32 * s + 4);
                const f32x4 w0 = *(const f32x4*)(nw + 32 * s + 8 * kq), w1 = *(const f32x4*)(nw + 32 * s + 8 * kq + 4);
                ss += (a0[0] * a0[0] + a0[1] * a0[1]) + (a0[2] * a0[2] + a0[3] * a0[3]) + (a1[0] * a1[0] + a1[1] * a1[1]) + (a1[2] * a1[2] + a1[3] * a1[3]);
                const f32x4 u0 = a0 * w0, u1 = a1 * w1;
                unsigned hb[8]; float uf[8] = {u0[0], u0[1], u0[2], u0[3], u1[0], u1[1], u1[2], u1[3]};
                u32x4 ah, al;
#pragma unroll
                for (int j = 0; j < 8; ++j) hb[j] = f2bf(uf[j]);
                ah.x = hb[0] | (hb[1] << 16); ah.y = hb[2] | (hb[3] << 16); ah.z = hb[4] | (hb[5] << 16); ah.w = hb[6] | (hb[7] << 16);
                al.x = pk2(uf[0] - bf2f(hb[0]), uf[1] - bf2f(hb[1])); al.y = pk2(uf[2] - bf2f(hb[2]), uf[3] - bf2f(hb[3]));
                al.z = pk2(uf[4] - bf2f(hb[4]), uf[5] - bf2f(hb[5])); al.w = pk2(uf[6] - bf2f(hb[6]), uf[7] - bf2f(hb[7]));
                const bf16x8 afh = __builtin_bit_cast(bf16x8, ah), afl = __builtin_bit_cast(bf16x8, al);
#pragma unroll
                for (int ct = 0; ct < 3; ++ct) { const size_t wo = (size_t)(16 * ct + row) * D + 32 * s + 8 * kq;
                    const bf16x8 bh = *(const bf16x8*)(WRHI + wo), bl = *(const bf16x8*)(WRLO + wo);
                    acc[ct] = __builtin_amdgcn_mfma_f32_16x16x32_bf16(afh, bh, acc[ct], 0, 0, 0);
                    acc[ct] = __builtin_amdgcn_mfma_f32_16x16x32_bf16(afh, bl, acc[ct], 0, 0, 0);
                    acc[ct] = __builtin_amdgcn_mfma_f32_16x16x32_bf16(afl, bh, acc[ct], 0, 0, 0); }
            }
            ss += __shfl_xor(ss, 16); ss += __shfl_xor(ss, 32);
#pragma unroll
            for (int ct = 0; ct < 3; ++ct)
#pragma unroll
                for (int r = 0; r < 4; ++r) lg[(4 * kq + r) * 48 + 16 * ct + row] = acc[ct][r];
            if (kq == 0) lg[768 + row] = ss;
            __syncthreads();
            if (tvalid && kpart == 0 && lane < 16) {
                const LAS float* L0 = lg + lane * 48;
                const float rs = __builtin_amdgcn_rsqf((lg[768 + lane] + lg[1024 + 768 + lane] + lg[2048 + 768 + lane] + lg[3072 + 768 + lane]) * (1.f / D) + RMS_EPS);
#define LGT(c) ((L0[(c)] + L0[1024 + (c)]) + (L0[2048 + (c)] + L0[3072 + (c)]))
                float gmax = -__builtin_inff(); int gi = 0; float gl[4];
#pragma unroll
                for (int c = 0; c < 4; ++c) { gl[c] = LGT(c) * rs + args.in[11][c]; if (gl[c] > gmax) { gmax = gl[c]; gi = c; } }
                float gsum = 0.f;
#pragma unroll
                for (int c = 0; c < 4; ++c) gsum += __expf(gl[c] - gmax);
                const float gp = 1.f / gsum;
                float el[8], emax = -__builtin_inff();
#pragma unroll
                for (int j = 0; j < 8; ++j) { el[j] = LGT(4 + 8 * gi + j) * rs + args.in[13][8 * gi + j]; emax = fmaxf(emax, el[j]); }
#undef LGT
                float p0v = -1.f, p1v = -1.f; int i0 = 0, i1 = 0;
#pragma unroll
                for (int j = 0; j < 8; ++j) { const float p = __expf(el[j] - emax);
                    if (p > p0v) { p1v = p0v; i1 = i0; p0v = p; i0 = j; } else if (p > p1v) { p1v = p; i1 = j; } }
                const float inv = gp / (p0v + p1v);
                const int e0 = 8 * gi + i0, e1 = 8 * gi + i1;
                u32x4 info; info.x = (unsigned)e0; info.y = (unsigned)e1; info.z = __builtin_bit_cast(unsigned, p0v * inv); info.w = __builtin_bit_cast(unsigned, p1v * inv);
                TOKINFO[t0 + lane] = info; TOKRSTD[t0 + lane] = rs;
                atomicAdd(ctl + CW_ECNT + POFF + 64 * e0, 1u); atomicAdd(ctl + CW_ECNT + POFF + 64 * e1, 1u);
            }
            __syncthreads();
        }
        if (BOTH(5)) GRID_BAR();
    }

    LAS int* const tab = (LAS int*)(lds + MOE_TAB_OFF);
    if (IN(6) || IN(7) || IN(8)) {
        if (tid < 32) tab[120 + tid] = (int)__hip_atomic_load(ctl + CW_ECNT + 64 * tid, __ATOMIC_RELAXED, __HIP_MEMORY_SCOPE_AGENT);
        __syncthreads();
        if (tid == 0) { int ts = 0;
            for (int e = 0; e < 32; ++e) { const int c = tab[120 + e], nt = (c + 255) >> 8; tab[e] = ts; tab[40 + e] = ts; tab[80 + e] = ts * 256 + c; ts += nt; }
            tab[32] = ts; }
        __syncthreads();
    }

    if (IN(6)) {
        const float* nw = args.in[9];
        static_assert(T == 4 * 8 * 256, "P6 deal assumes 4 tokens per wave on 256 workgroups");
        for (int tb = gw; tb < T; tb += 4 * NGW) {
            int mp0 = 0, mp1 = 0; unsigned mw0 = 0u, mw1 = 0u; float mrs = 0.f;
            if (lane < 4 && tb + lane * NGW < T) { const int t = tb + lane * NGW; const u32x4 info = TOKINFO[t]; mrs = TOKRSTD[t];
                const int e0 = (int)info.x, e1 = (int)info.y; mw0 = info.z; mw1 = info.w;
                mp0 = (int)atomicAdd(ctl + CW_ECUR + POFF + 64 * e0, 1u) + tab[40 + e0] * 256; mp1 = (int)atomicAdd(ctl + CW_ECUR + POFF + 64 * e1, 1u) + tab[40 + e1] * 256; }
#pragma unroll
            for (int i = 0; i < 4; ++i) { const int t = tb + i * NGW; if (t >= T) break;
                const int p0 = __builtin_amdgcn_readlane(mp0, i), p1 = __builtin_amdgcn_readlane(mp1, i);
                const float rs = __builtin_bit_cast(float, __builtin_amdgcn_readlane(__builtin_bit_cast(int, mrs), i));
                const f32x4* xr = (const f32x4*)(X1 + (size_t)t * D) + lane; const f32x4* wr = (const f32x4*)nw + lane;
                u32x2* o0 = (u32x2*)(XP + (size_t)p0 * D) + lane; u32x2* o1 = (u32x2*)(XP + (size_t)p1 * D) + lane;
#pragma unroll
                for (int j = 0; j < 8; ++j) { const f32x4 v = xr[64 * j], ww = wr[64 * j]; u32x2 p; p.x = pk2(v[0] * rs * ww[0], v[1] * rs * ww[1]); p.y = pk2(v[2] * rs * ww[2], v[3] * rs * ww[3]);
                    o0[64 * j] = p; o1[64 * j] = p; }
                if (lane == i) { ROWINFO[2 * mp0] = 2 * t; ROWINFO[2 * mp0 + 1] = (int)mw0; ROWINFO[2 * mp1] = 2 * t + 1; ROWINFO[2 * mp1 + 1] = (int)mw1; }
            }
        }
        if (BOTH(6)) GRID_BAR();
    }

    if (IN(7)) {
        pg8::Gemm g{XP, WguT, XP_ROWS, NE * 1024, D}; pg8::MoeOrder S{tab, 4, tab[32] * 4, G, bx};
        pg8::EpiSwiGLU E{ACT};
        pg8::gemm_phase<pg8::EpiSwiGLU, pg8::MoeOrder, true, true>(lds, g, S, E);
        if (BOTH(7)) GRID_BAR();
    }

    if (IN(8)) {
        pg8::Gemm g{ACT, WdT, XP_ROWS, NE * 2048, DE}; pg8::MoeOrder S{tab, 8, tab[32] * 8, G, bx};
        pg8::EpiDown E{Y, ROWINFO, tab + 80};
        pg8::gemm_phase<pg8::EpiDown, pg8::MoeOrder, true, true>(lds, g, S, E);
        if (BOTH(8)) GRID_BAR();
    }

    if (IN(9)) {
        const float* nf = args.in[17];
        for (int t = gw; t < T; t += NGW) {
            const f32x4* xr = (const f32x4*)(X1 + (size_t)t * D) + lane;
            const u32x2* y0 = (const u32x2*)(Y + (size_t)(2 * t) * D) + lane; const u32x2* y1 = (const u32x2*)(Y + (size_t)(2 * t + 1) * D) + lane;
            f32x4 v[8]; float s = 0.f;
#pragma unroll
            for (int j = 0; j < 8; ++j) { f32x4 a = xr[64 * j]; const u32x2 p = y0[64 * j], q = y1[64 * j];
                a[0] += bf2f(p.x & 0xffffu) + bf2f(q.x & 0xffffu); a[1] += bf2f(p.x >> 16) + bf2f(q.x >> 16);
                a[2] += bf2f(p.y & 0xffffu) + bf2f(q.y & 0xffffu); a[3] += bf2f(p.y >> 16) + bf2f(q.y >> 16);
                v[j] = a; s += (a[0] * a[0] + a[1] * a[1]) + (a[2] * a[2] + a[3] * a[3]); }
            const float rstd = __builtin_amdgcn_rsqf(wave_sum(s) * (1.f / D) + RMS_EPS);
            f32x4* orow = (f32x4*)(args.out + (size_t)t * D) + lane; const f32x4* wr = (const f32x4*)nf + lane;
#pragma unroll
            for (int j = 0; j < 8; ++j) orow[64 * j] = v[j] * rstd * wr[64 * j];
        }
    }
#undef IN
#undef BOTH
#undef GRID_BAR
}

extern "C" void kernel_launch(void* const* d_in, const int* in_sizes, int n_in, void* d_out, int out_size, void* d_ws, size_t ws_size, hipStream_t stream) {
    static int grid = 0;
    if (grid == 0) {
        if (n_in != 18 || in_sizes[0] != T * D || out_size != T * D || ws_size < WS_END) { fprintf(stderr, "kernel_launch: unexpected shapes (n_in %d, in0 %d, out %d, ws %zu)\n", n_in, n_in > 0 ? in_sizes[0] : -1, out_size, ws_size); grid = -1; return; }
        int dev = 0, cus = 0, per_cu = 0;
        if (hipGetDevice(&dev) != hipSuccess || hipDeviceGetAttribute(&cus, hipDeviceAttributeMultiprocessorCount, dev) != hipSuccess) { grid = -1; return; }
        if (hipFuncSetAttribute((const void*)trunk_fwd, hipFuncAttributeMaxDynamicSharedMemorySize, LDS_BYTES) != hipSuccess) { fprintf(stderr, "kernel_launch: hipFuncSetAttribute failed\n"); grid = -1; return; }
        if (hipOccupancyMaxActiveBlocksPerMultiprocessor(&per_cu, (const void*)trunk_fwd, NWAVES * 64, LDS_BYTES) != hipSuccess || per_cu < 1)
            fprintf(stderr, "kernel_launch: note: occupancy query reports %d workgroups per CU\n", per_cu);
        (void)hipGetLastError();
        grid = cus;
    }
    if (grid < 0) return;
    if (hipMemsetAsync((char*)d_ws + WS_CTL, 0, CTL_ZERO_BYTES, stream) != hipSuccess) return;
    Args a{};
    for (int i = 0; i < 18; ++i) a.in[i] = (const float*)d_in[i];
    a.out = (float*)d_out; a.ws = (unsigned char*)d_ws;
    int plan[NPH + 2][2]; int nl = 0;
#if defined(PROBE_DUP)
    plan[nl][0] = 0; plan[nl][1] = PROBE_DUP + 1; ++nl; plan[nl][0] = PROBE_DUP; plan[nl][1] = PROBE_DUP + 1; ++nl;
    if (PROBE_DUP + 1 < NPH) { plan[nl][0] = PROBE_DUP + 1; plan[nl][1] = NPH; ++nl; }
#else
    if (N_LAUNCHES == 1) { plan[0][0] = 0; plan[0][1] = NPH; nl = 1; } else { for (int k = 0; k < NPH; ++k) { plan[k][0] = k; plan[k][1] = k + 1; } nl = NPH; }
#endif
    for (int li = 0; li < nl; ++li) {
        a.ph_lo = plan[li][0]; a.ph_hi = plan[li][1]; a.li = li;
        hipLaunchKernelGGL(trunk_fwd, dim3(grid), dim3(NWAVES * 64), LDS_BYTES, stream, a);
    }
}
```

```cpp
#include <hip/hip_runtime.h>
#include <cstdio>
#include <cstdint>

#ifndef MK_N_LAUNCHES
#define MK_N_LAUNCHES 1
#endif
constexpr int NPH = 10;
constexpr int N_LAUNCHES = MK_N_LAUNCHES;

constexpr int NWAVES = 8;
#ifndef N_MOE_P1
#define N_MOE_P1 0
#endif
#ifndef N_MOE_P0
#define N_MOE_P0 0
#endif
constexpr int BATCH = 2, SEQ = 4096, T = BATCH * SEQ, D = 2048, NIN = 6144;
constexpr int NE = 32, DE = 512, NPAIR = 2 * T;
constexpr int XP_ROWS = 24576;
constexpr float RMS_EPS = 1e-6f;
constexpr float LOG2E = 1.4426950408889634f;
constexpr float QSCALE = 0.08838834764831845f * 1.4426950408889634f;

constexpr size_t MiB = 1u << 20;
constexpr size_t WS_CTL = 0, CTL_ZERO_BYTES = 1 * MiB;
constexpr size_t WS_WIN = 1 * MiB;
constexpr size_t WS_WOUT = 25 * MiB;
constexpr size_t WS_H = 33 * MiB;
constexpr size_t WS_Y = 1 * MiB;
constexpr size_t WS_WGU = 65 * MiB;
constexpr size_t WS_WD = 193 * MiB;
constexpr size_t WS_PROJ = 257 * MiB;
constexpr size_t WS_XP = 257 * MiB;
constexpr size_t WS_MIX = 353 * MiB;
constexpr size_t WS_ACT = 353 * MiB;
constexpr size_t WS_X1 = 385 * MiB;
constexpr size_t WS_MISC = 449 * MiB;
constexpr size_t WS_KMEAN = WS_MISC;
constexpr size_t WS_TOKINFO = WS_MISC + 256 * 1024;
constexpr size_t WS_TOKRSTD = WS_MISC + 384 * 1024;
constexpr size_t WS_ROWINFO = WS_MISC + 512 * 1024;
constexpr size_t WS_WRHI = WS_MISC + 1024 * 1024;
constexpr size_t WS_WRLO = WS_MISC + 1280 * 1024;
constexpr size_t WS_END = 452 * MiB;
constexpr int CW_BAR = 4096;
constexpr int CW_ECNT = 16384;
constexpr int CW_ECUR = 16384 + 2048;
constexpr int CW_QHEAD = 16384 + 4096;

constexpr int RING_BYTES = 131072;
constexpr int ATT_SCR_OFF = 131072;
constexpr int MOE_TAB_OFF = 135168;
constexpr int MISC_OFF = 136192;
constexpr int QTAB_OFF = 136448;
constexpr int LDS_BYTES = 147456;

#define GAS __attribute__((address_space(1)))
#define LAS __attribute__((address_space(3)))
typedef unsigned short bf16;
typedef float f32x4 __attribute__((ext_vector_type(4)));
typedef float f32x16 __attribute__((ext_vector_type(16)));
typedef short bf16x8 __attribute__((ext_vector_type(8)));
typedef short s16x4 __attribute__((ext_vector_type(4)));
typedef unsigned u32x4 __attribute__((ext_vector_type(4)));
typedef unsigned u32x2 __attribute__((ext_vector_type(2)));

__device__ __forceinline__ unsigned f2bf(float f) { unsigned u = __builtin_bit_cast(unsigned, f); return (u + 0x7fffu + ((u >> 16) & 1u)) >> 16; }
__device__ __forceinline__ unsigned pk2(float lo, float hi) { return f2bf(lo) | (f2bf(hi) << 16); }
__device__ __forceinline__ float bf2f(unsigned b) { return __builtin_bit_cast(float, b << 16); }
__device__ __forceinline__ float wave_sum(float v) {
#pragma unroll
    for (int o = 1; o < 64; o <<= 1) v += __shfl_xor(v, o);
    return v;
}
namespace pg8 {
#define PG8_LAS __attribute__((address_space(3)))
typedef unsigned short bf16_t;
typedef short bf16x8 __attribute__((ext_vector_type(8)));
typedef float f32x4 __attribute__((ext_vector_type(4)));
typedef unsigned u32x4 __attribute__((ext_vector_type(4)));
constexpr int BM = 256, BK = 64, HALF = 128, HTB = HALF * BK * 2  , STAGE_BYTES = 8 * HTB, NXCD = 8, WGM = 8;

__host__ __device__ __forceinline__ int lds_byte(int r, int c) { const int st = (r >> 4) * 2 + (c >> 5), rr = r & 15, cc = c & 31, ob = rr * 64 + cc * 2; return st * 1024 + (ob ^ (((ob >> 9) & 1) << 5)); }
__host__ __device__ __forceinline__ void stage_rc(int b, int& R, int& C) { const int st = b / 1024, sb = b % 1024, swz = sb ^ (((sb >> 9) & 1) << 5); R = (st >> 1) * 16 + swz / 64; C = (st & 1) * 32 + (swz % 64) / 2; }
__host__ __device__ __forceinline__ int perm32(int rho) { const int n = rho >> 4, i = rho & 15; return 8 * (i >> 2) + 4 * n + (i & 3); }

struct Unit { int pm, pn; };
struct Gemm { const bf16_t* A; const bf16_t* Bt; int M, N, K; };

struct StaticOrder {
    int nM, nN, nwg, G, c;
    __host__ __device__ void init(int M, int N, int G_, int c_) { nM = M / BM; nN = N / BM; nwg = nM * nN; G = G_; c = c_; }
    __host__ __device__ bool next(int i, Unit& u) const {
        const long L = (long)i * G + c; if (L >= nwg) return false;
        int wgid = (int)L; { const int q = nwg / NXCD, r = nwg % NXCD, xcd = wgid % NXCD, off = wgid / NXCD; wgid = (xcd < r ? xcd * (q + 1) : r * (q + 1) + (xcd - r) * q) + off; }
        const int nig = WGM * nN, gid = wgid / nig, fm = gid * WGM, gsz = (nM - fm) < WGM ? (nM - fm) : WGM;
        u.pm = fm + ((wgid % nig) % gsz); u.pn = (wgid % nig) / gsz; return true;
    }
    __device__ __forceinline__ void a_ready(const Unit&) const {}
    __device__ __forceinline__ void done(const Unit&) const {}
};

__device__ __forceinline__ unsigned cvt_pk_bf16(float lo, float hi) { unsigned r; asm volatile("v_cvt_pk_bf16_f32 %0, %1, %2" : "=v"(r) : "v"(lo), "v"(hi)); return r; }
typedef float f32x2 __attribute__((ext_vector_type(2)));
struct EpiProj {
    static constexpr bool PERM = true, AFTER_DRAIN = false;
    bf16_t* O; int ldc; float qscale;
    __device__ __forceinline__ void operator()(const f32x4 (&acc)[2][2][4][2], const Unit& u, int wr, int wc, int fr, int fq) const {
        const int row0 = u.pm * BM + wr * 64 + fr, col0 = u.pn * BM + wc * 32 + 8 * fq;
        const float sc = (u.pn < 4 || (u.pn >= 12 && u.pn < 16)) ? qscale : 1.f;
#pragma unroll
        for (int ai = 0; ai < 2; ++ai)
#pragma unroll
            for (int m = 0; m < 4; ++m) { bf16_t* rowp = O + (size_t)(row0 + ai * HALF + m * 16) * ldc + col0;
#pragma unroll
                for (int bj = 0; bj < 2; ++bj) { const f32x4 v0 = acc[ai][bj][m][0] * sc, v1 = acc[ai][bj][m][1] * sc;
                    u32x4 w; w.x = cvt_pk_bf16(v0[0], v0[1]); w.y = cvt_pk_bf16(v0[2], v0[3]); w.z = cvt_pk_bf16(v1[0], v1[1]); w.w = cvt_pk_bf16(v1[2], v1[3]);
                    *(u32x4*)(rowp + bj * HALF) = w; } }
    }
};
struct EpiResid {
    static constexpr bool PERM = true, AFTER_DRAIN = false;
    const float* X; float* X1; int ldc;
    __device__ __forceinline__ void operator()(const f32x4 (&acc)[2][2][4][2], const Unit& u, int wr, int wc, int fr, int fq) const {
        const int row0 = u.pm * BM + wr * 64 + fr, col0 = u.pn * BM + wc * 32 + 8 * fq;
#pragma unroll
        for (int ai = 0; ai < 2; ++ai)
#pragma unroll
            for (int m = 0; m < 4; ++m) { const size_t off = (size_t)(row0 + ai * HALF + m * 16) * ldc + col0;
#pragma unroll
                for (int bj = 0; bj < 2; ++bj)
#pragma unroll
                    for (int n = 0; n < 2; ++n) { const f32x4 xv = *(const f32x4*)(X + off + bj * HALF + 4 * n); *(f32x4*)(X1 + off + bj * HALF + 4 * n) = xv + acc[ai][bj][m][n]; } }
    }
};
__device__ __forceinline__ float silu_mul(float g, float u) { return g * u * __builtin_amdgcn_rcpf(1.f + __builtin_amdgcn_exp2f(-1.4426950408889634f * g)); }
struct EpiSwiGLU {
    static constexpr bool PERM = true, AFTER_DRAIN = false;
    bf16_t* ACT;
    __device__ __forceinline__ void operator()(const f32x4 (&acc)[2][2][4][2], const Unit& u, int wr, int wc, int fr, int fq) const {
        const int row0 = u.pm * BM + wr * 64 + fr, col0 = (u.pn & 3) * 128 + wc * 32 + 8 * fq;
#pragma unroll
        for (int ai = 0; ai < 2; ++ai)
#pragma unroll
            for (int m = 0; m < 4; ++m) { const f32x4 g0 = acc[ai][0][m][0], g1 = acc[ai][0][m][1], u0 = acc[ai][1][m][0], u1 = acc[ai][1][m][1];
                u32x4 w; w.x = cvt_pk_bf16(silu_mul(g0[0], u0[0]), silu_mul(g0[1], u0[1])); w.y = cvt_pk_bf16(silu_mul(g0[2], u0[2]), silu_mul(g0[3], u0[3]));
                w.z = cvt_pk_bf16(silu_mul(g1[0], u1[0]), silu_mul(g1[1], u1[1])); w.w = cvt_pk_bf16(silu_mul(g1[2], u1[2]), silu_mul(g1[3], u1[3]));
                *(u32x4*)(ACT + (size_t)(row0 + ai * HALF + m * 16) * 512 + col0) = w; }
    }
};
struct EpiDown {
    static constexpr bool PERM = true, AFTER_DRAIN = false;
    bf16_t* Y; const int* rowinfo; const PG8_LAS int* rowend;
    __device__ __forceinline__ void operator()(const f32x4 (&acc)[2][2][4][2], const Unit& u, int wr, int wc, int fr, int fq) const {
        const int e = u.pn >> 3, rend = rowend[e];
        const int row0 = u.pm * BM + wr * 64 + fr, col0 = (u.pn & 7) * BM + wc * 32 + 8 * fq;
#pragma unroll
        for (int ai = 0; ai < 2; ++ai)
#pragma unroll
            for (int m = 0; m < 4; ++m) { const int pos = row0 + ai * HALF + m * 16;
                if (pos < rend) { const int pair = rowinfo[2 * pos]; const float wgt = __builtin_bit_cast(float, rowinfo[2 * pos + 1]);
                    bf16_t* rowp = Y + (size_t)pair * 2048 + col0;
#pragma unroll
                    for (int bj = 0; bj < 2; ++bj) { const f32x4 v0 = acc[ai][bj][m][0] * wgt, v1 = acc[ai][bj][m][1] * wgt;
                        u32x4 w; w.x = cvt_pk_bf16(v0[0], v0[1]); w.y = cvt_pk_bf16(v0[2], v0[3]); w.z = cvt_pk_bf16(v1[0], v1[1]); w.w = cvt_pk_bf16(v1[2], v1[3]);
                        *(u32x4*)(rowp + bj * HALF) = w; } } }
    }
};
struct MoeOrder {
    const PG8_LAS int* tab; int npn, total, G, c;
    __device__ __forceinline__ bool next(int i, Unit& u) const {
        const int L = i * G + c; if (L >= total) return false;
        const int tile = L / npn, pn = L - tile * npn; int e = 0;
#pragma unroll 4
        for (int j = 1; j < 32; ++j) e += (tab[j] <= tile) ? 1 : 0;
        u.pm = tab[40 + e] + (tile - tab[e]); u.pn = e * npn + pn; return true;
    }
    __device__ __forceinline__ void a_ready(const Unit&) const {}
    __device__ __forceinline__ void done(const Unit&) const {}
};

template <class Epi, class Sched, bool ALIGN_EPI = false, bool SP2 = false>
__device__ __forceinline__ void gemm_phase(PG8_LAS unsigned char* lds, const Gemm g, const Sched& S, const Epi& E) {
    const int tid = threadIdx.x, wid = __builtin_amdgcn_readfirstlane(tid >> 6), lane = tid & 63, wr = wid >> 2, wc = wid & 3, fr = lane & 15, fq = lane >> 4;
    const int K = g.K, nt = K / BK;
    unsigned voffA[2], voffB[2];
#pragma unroll
    for (int i = 0; i < 2; ++i) { int R, C; stage_rc(tid * 16 + i * 8192, R, C); const int Rb = Epi::PERM ? ((R & ~31) + perm32(R & 31)) : R;
        voffA[i] = (unsigned)(R * K + C) * 2u; voffB[i] = (unsigned)(Rb * K + C) * 2u; }
    const size_t kstep = (size_t)(BK * 2);
    const size_t hstep = (size_t)HALF * K * 2;
    const size_t tstep = 2 * hstep;
    const unsigned ldsw = (unsigned)wid * 1024u;
    const int aoff = lds_byte(wr * 64 + fr, fq * 8), boff = lds_byte(wc * 32 + fr, fq * 8);
#define PG8_SA(b, h) (((b) * 2 + (h)) * HTB)
#define PG8_SB(b, h) ((4 + (b) * 2 + (h)) * HTB)
#define PG8_STAGE(bufoff, gbase, voff) do { _Pragma("unroll") for (int _i = 0; _i < 2; ++_i) \
        __builtin_amdgcn_global_load_lds((const unsigned*)((const char*)(gbase) + (voff)[_i]), (PG8_LAS unsigned*)(lds + (bufoff) + ldsw + _i * 8192), 16, 0, 0); } while (0)
#define PG8_LDA(dst, b, h) do { _Pragma("unroll") for (int m = 0; m < 4; ++m) _Pragma("unroll") for (int k = 0; k < 2; ++k) dst[m][k] = *(const PG8_LAS bf16x8*)(lds + PG8_SA(b, h) + aoff + m * 2048 + k * 1024); } while (0)
#define PG8_LDB(dst, b, h) do { _Pragma("unroll") for (int n = 0; n < 2; ++n) _Pragma("unroll") for (int k = 0; k < 2; ++k) dst[n][k] = *(const PG8_LAS bf16x8*)(lds + PG8_SB(b, h) + boff + n * 2048 + k * 1024); } while (0)
#define PG8_MMA(ai, bj, At, Bt) do { __builtin_amdgcn_s_setprio(1); _Pragma("unroll") for (int m = 0; m < 4; ++m) _Pragma("unroll") for (int n = 0; n < 2; ++n) _Pragma("unroll") for (int k = 0; k < 2; ++k) \
        acc[ai][bj][m][n] = __builtin_amdgcn_mfma_f32_16x16x32_bf16(Bt[n][k], At[m][k], acc[ai][bj][m][n], 0, 0, 0); __builtin_amdgcn_s_setprio(0); } while (0)
#define PG8_WAIT_V(n) asm volatile("s_waitcnt vmcnt(" #n ")" ::: "memory")
#define PG8_WAIT_L(n) asm volatile("s_waitcnt lgkmcnt(" #n ")" ::: "memory")
#define PG8_BAR __builtin_amdgcn_s_barrier()
#define PG8_SCHED __builtin_amdgcn_sched_barrier(0)
    Unit cur, nxt; int ui = 0;
    if (!S.next(0, cur)) return;
    f32x4 acc[2][2][4][2];
#pragma unroll
    for (int a = 0; a < 2; ++a)
#pragma unroll
        for (int b = 0; b < 2; ++b)
#pragma unroll
            for (int m = 0; m < 4; ++m)
#pragma unroll
                for (int n = 0; n < 2; ++n) acc[a][b][m][n] = (f32x4){0.f, 0.f, 0.f, 0.f};
    bf16x8 At[4][2], B0[2][2], B1[2][2];
    const char* cA = (const char*)g.A + (size_t)cur.pm * tstep; const char* cB = (const char*)g.Bt + (size_t)cur.pn * tstep;
    S.a_ready(cur);
    if constexpr (SP2) {
        PG8_STAGE(PG8_SB(0, 0), cB, voffB); PG8_STAGE(PG8_SB(0, 1), cB + hstep, voffB); PG8_STAGE(PG8_SA(0, 0), cA, voffA); PG8_STAGE(PG8_SA(0, 1), cA + hstep, voffA);
        if (wr == 1) PG8_BAR;
        PG8_WAIT_V(2); PG8_BAR;
        PG8_STAGE(PG8_SB(1, 0), cB + kstep, voffB); PG8_STAGE(PG8_SA(1, 0), cA + kstep, voffA); PG8_STAGE(PG8_SB(1, 1), cB + hstep + kstep, voffB);
        PG8_WAIT_V(6); PG8_BAR;
    } else {
        PG8_STAGE(PG8_SB(0, 0), cB, voffB); PG8_STAGE(PG8_SA(0, 0), cA, voffA); PG8_STAGE(PG8_SB(0, 1), cB + hstep, voffB); PG8_STAGE(PG8_SA(0, 1), cA + hstep, voffA);
        if (wr == 1) PG8_BAR;
        PG8_WAIT_V(4); PG8_BAR;
        PG8_STAGE(PG8_SB(1, 0), cB + kstep, voffB); PG8_STAGE(PG8_SA(1, 0), cA + kstep, voffA); PG8_STAGE(PG8_SB(1, 1), cB + hstep + kstep, voffB);
        PG8_WAIT_V(6); PG8_BAR;
    }
    for (;;) {
        const bool has_next = S.next(ui + 1, nxt);
        const char* nA = has_next ? (const char*)g.A + (size_t)nxt.pm * tstep : cA; const char* nB = has_next ? (const char*)g.Bt + (size_t)nxt.pn * tstep : cB;
        for (int t = 0; t < nt; t += 2) {
            const bool last = (t == nt - 2);
            const char* a1 = cA + (size_t)(t + 1) * kstep;
            const char* a2 = last ? nA : cA + (size_t)(t + 2) * kstep; const char* b2 = last ? nB : cB + (size_t)(t + 2) * kstep;
            const char* a3 = a2 + kstep; const char* b3 = b2 + kstep;
            if (last && has_next) S.a_ready(nxt);
            if constexpr (SP2) {
            PG8_LDB(B0, 0, 0); PG8_LDB(B1, 0, 1); PG8_SCHED; PG8_LDA(At, 0, 0); PG8_STAGE(PG8_SA(1, 1), a1 + hstep, voffA);
            PG8_WAIT_V(8); PG8_WAIT_L(0); PG8_BAR; PG8_MMA(0, 0, At, B0); PG8_MMA(0, 1, At, B1); PG8_BAR; PG8_SCHED;
            PG8_LDA(At, 0, 1); PG8_STAGE(PG8_SB(0, 0), b2, voffB); PG8_STAGE(PG8_SB(0, 1), b2 + hstep, voffB); PG8_STAGE(PG8_SA(0, 0), a2, voffA);
            PG8_WAIT_V(8); PG8_WAIT_L(0); PG8_BAR; PG8_MMA(1, 0, At, B0); PG8_MMA(1, 1, At, B1); PG8_BAR; PG8_SCHED;
            PG8_LDB(B0, 1, 0); PG8_LDB(B1, 1, 1); PG8_SCHED; PG8_LDA(At, 1, 0); PG8_STAGE(PG8_SA(0, 1), a2 + hstep, voffA);
            PG8_WAIT_V(8); PG8_WAIT_L(0); PG8_BAR; PG8_MMA(0, 0, At, B0); PG8_MMA(0, 1, At, B1); PG8_BAR; PG8_SCHED;
            PG8_LDA(At, 1, 1); PG8_STAGE(PG8_SB(1, 0), b3, voffB); PG8_STAGE(PG8_SB(1, 1), b3 + hstep, voffB); PG8_STAGE(PG8_SA(1, 0), a3, voffA);
            PG8_WAIT_V(8); PG8_WAIT_L(0); PG8_BAR; PG8_MMA(1, 0, At, B0); PG8_MMA(1, 1, At, B1); PG8_BAR; PG8_SCHED;
            } else {
            PG8_LDB(B0, 0, 0); PG8_SCHED; PG8_LDA(At, 0, 0); PG8_STAGE(PG8_SA(1, 1), a1 + hstep, voffA);
            PG8_WAIT_L(8); PG8_BAR; PG8_WAIT_L(0); PG8_MMA(0, 0, At, B0); PG8_BAR; PG8_SCHED;
            PG8_LDB(B1, 0, 1); PG8_STAGE(PG8_SB(0, 0), b2, voffB);
            PG8_BAR; PG8_WAIT_L(0); PG8_MMA(0, 1, At, B1); PG8_BAR;
            PG8_LDA(At, 0, 1); PG8_STAGE(PG8_SA(0, 0), a2, voffA);
            PG8_BAR; PG8_WAIT_L(0); PG8_MMA(1, 0, At, B0); PG8_BAR; PG8_SCHED;
            PG8_STAGE(PG8_SB(0, 1), b2 + hstep, voffB);
            PG8_WAIT_V(6); PG8_BAR; PG8_MMA(1, 1, At, B1); PG8_BAR;
            PG8_LDB(B0, 1, 0); PG8_SCHED; PG8_LDA(At, 1, 0); PG8_STAGE(PG8_SA(0, 1), a2 + hstep, voffA);
            PG8_WAIT_L(8); PG8_BAR; PG8_WAIT_L(0); PG8_MMA(0, 0, At, B0); PG8_BAR; PG8_SCHED;
            PG8_LDB(B1, 1, 1); PG8_STAGE(PG8_SB(1, 0), b3, voffB);
            PG8_BAR; PG8_WAIT_L(0); PG8_MMA(0, 1, At, B1); PG8_BAR;
            PG8_LDA(At, 1, 1); PG8_STAGE(PG8_SA(1, 0), a3, voffA);
            PG8_BAR; PG8_WAIT_L(0); PG8_MMA(1, 0, At, B0); PG8_BAR; PG8_SCHED;
            PG8_STAGE(PG8_SB(1, 1), b3 + hstep, voffB);
            PG8_WAIT_V(6); PG8_BAR; PG8_MMA(1, 1, At, B1); PG8_BAR;
            }
        }
        if constexpr (ALIGN_EPI) { if (wr == 0) PG8_BAR; }
        if constexpr (!Epi::AFTER_DRAIN) { E(acc, cur, wr, wc, fr, fq); S.done(cur); }
        if (!has_next) break;
#pragma unroll
        for (int a = 0; a < 2; ++a)
#pragma unroll
            for (int b = 0; b < 2; ++b)
#pragma unroll
                for (int m = 0; m < 4; ++m)
#pragma unroll
                    for (int n = 0; n < 2; ++n) acc[a][b][m][n] = (f32x4){0.f, 0.f, 0.f, 0.f};
        cur = nxt; cA = nA; cB = nB; ++ui;
        if constexpr (ALIGN_EPI) { if (wr == 1) PG8_BAR; }
    }
    PG8_WAIT_V(0);
    if constexpr (!ALIGN_EPI) { if (wr == 0) PG8_BAR; }
    PG8_BAR;
    if constexpr (Epi::AFTER_DRAIN) { E.fused(acc, cur, wr, wc, fr, fq, lds, wid, lane); S.done(cur); }
#undef PG8_SA
#undef PG8_SB
#undef PG8_STAGE
#undef PG8_LDA
#undef PG8_LDB
#undef PG8_MMA
#undef PG8_WAIT_V
#undef PG8_WAIT_L
#undef PG8_BAR
#undef PG8_SCHED
}
}
#define XB_TMO      128
#define XB_XCNT(j)  (256  + 64 * (j))
#define XB_XSUB(j)  (1280 + 64 * (j))
#define XB_XGEN(j)  (2304 + 64 * (j))
#define XB_TOP      3328
#define XB_TOPGEN   3392
#define XCD_BAR_WORDS 3456
#define XB_SPIN_CAP (1u << 18)

__device__ __forceinline__ unsigned xb_ld(unsigned* p)              { return __hip_atomic_load(p, __ATOMIC_RELAXED, __HIP_MEMORY_SCOPE_AGENT); }
__device__ __forceinline__ unsigned xb_add(unsigned* p, unsigned v) { return __hip_atomic_fetch_add(p, v, __ATOMIC_RELAXED, __HIP_MEMORY_SCOPE_AGENT); }
__device__ __forceinline__ unsigned xb_xcc_id() { return (unsigned)__builtin_amdgcn_s_getreg((3 << 11) | 20) & 0xFu; }
#define XB_SPIN(cond, bar) do { unsigned _sp = 0; while (cond) { __builtin_amdgcn_s_sleep(1); \
    if ((++_sp & 255u) == 0u) { if (xb_ld(&(bar)[XB_TMO])) break; if (_sp > XB_SPIN_CAP) { atomicAdd(&(bar)[XB_TMO], 1u); break; } } } } while (0)

struct XcdBarrier {
    unsigned* bar; unsigned x;
    volatile LAS unsigned* st;
};

__device__ __forceinline__ XcdBarrier xcd_barrier_post(unsigned* bar, volatile LAS unsigned* st) {
    XcdBarrier b; b.bar = bar; b.x = xb_xcc_id(); b.st = st;
    if (threadIdx.x == 0) (void)xb_add(&bar[XB_XCNT(b.x)], 1u);
    return b;
}
__device__ __forceinline__ void xcd_barrier_complete(unsigned* bar, unsigned x, unsigned& nloc, unsigned& nx) {
    const unsigned G = gridDim.x * gridDim.y * gridDim.z;
    unsigned sum, cnt, mine, sp = 0u;
    for (;;) {
        sum = 0u; cnt = 0u; mine = 0u;
#pragma unroll
        for (unsigned j = 0; j < 16; ++j) { const unsigned c = xb_ld(&bar[XB_XCNT(j)]); sum += c; cnt += (c > 0u) ? 1u : 0u; mine = (j == x) ? c : mine; }
        if (sum == G) break;
        __builtin_amdgcn_s_sleep(1);
        if ((++sp & 255u) == 0u) { if (xb_ld(&bar[XB_TMO])) break; if (sp > XB_SPIN_CAP) { atomicAdd(&bar[XB_TMO], 1u); break; } }
    }
    nloc = mine > 0u ? mine : 1u; nx = cnt > 0u ? cnt : 1u;
}

__device__ __forceinline__ void xcd_barrier(const XcdBarrier& b) {
    asm volatile("s_waitcnt vmcnt(0)" ::: "memory");
    __syncthreads();
    if (threadIdx.x == 0) {
        unsigned* bar = b.bar;
        __builtin_amdgcn_s_waitcnt(0);
        unsigned nloc = b.st[0], nx = b.st[1];
        if (nloc == 0u) { xcd_barrier_complete(bar, b.x, nloc, nx); b.st[0] = nloc; b.st[1] = nx; }
        const unsigned old = xb_add(&bar[XB_XSUB(b.x)], 1u);
        const unsigned gen = old / nloc;
        if (old + 1u == (gen + 1u) * nloc) {
            __builtin_amdgcn_fence(__ATOMIC_RELEASE, "agent");
            asm volatile("s_waitcnt vmcnt(0)" ::: "memory");
            const unsigned og = xb_add(&bar[XB_TOP], 1u);
            const unsigned tg = og / nx;
            if (og + 1u == (tg + 1u) * nx) xb_add(&bar[XB_TOPGEN], 1u);
            else XB_SPIN(xb_ld(&bar[XB_TOPGEN]) == tg, bar);
            __builtin_amdgcn_fence(__ATOMIC_ACQUIRE, "agent");
            xb_add(&bar[XB_XGEN(b.x)], 1u);
            asm volatile("s_waitcnt vmcnt(0)" ::: "memory");
        } else {
            XB_SPIN(xb_ld(&bar[XB_XGEN(b.x)]) == gen, bar);
            __builtin_amdgcn_fence(__ATOMIC_ACQUIRE, "agent");
            asm volatile("s_waitcnt vmcnt(0)" ::: "memory");
        }
    }
    __syncthreads();
}

namespace att {
constexpr int PITCH = NIN;
constexpr int STAGE = 65536, SUB = 16384;
typedef short v4i16_t __attribute__((ext_vector_type(4)));
constexpr float THR2 = 11.5f;
constexpr float PSKIP = -140.f;
#define KSWZ(row, colB) ((row) * 256 + ((colB) ^ (((row) & 7) << 4)))
#define SBAR() __builtin_amdgcn_sched_barrier(0)
__device__ __forceinline__ int v_rd_base(int lane) { return ((lane & 3) << 3) | (((lane >> 2) & 3) << 6) | (((lane >> 4) & 1) << 5) | (((lane >> 5) & 1) << 8); }
constexpr int v_rd_off(int d0, int ks, int half) { return d0 * 512 + ks * 4096 + half * 2048; }
__device__ __forceinline__ int crow(int r, int hi) { return (r & 3) + 8 * (r >> 2) + 4 * hi; }
__device__ __forceinline__ unsigned cvtpk(float lo, float hi) { unsigned r; asm volatile("v_cvt_pk_bf16_f32 %0, %1, %2" : "=v"(r) : "v"(lo), "v"(hi)); return r; }

__device__ __forceinline__ void qkt(f32x16& p0, f32x16& p1, const LAS unsigned char* Ks, int r32, int hi, const bf16x8* qr) {
    const LAS unsigned char* kb[4];
#pragma unroll
    for (int dd = 0; dd < 4; ++dd) kb[dd] = Ks + KSWZ(r32, (dd * 16 + hi * 8) * 2);
#pragma unroll
    for (int d0 = 0; d0 < 8; ++d0) { const LAS unsigned char* a = kb[d0 & 3] + (d0 >> 2) * 128;
        const bf16x8 b0 = *(const LAS bf16x8*)a;
        const bf16x8 b1 = *(const LAS bf16x8*)(a + 32 * 256);
        p0 = __builtin_amdgcn_mfma_f32_32x32x16_bf16(b0, qr[d0], p0, 0, 0, 0);
        p1 = __builtin_amdgcn_mfma_f32_32x32x16_bf16(b1, qr[d0], p1, 0, 0, 0); }
}
__device__ __forceinline__ void pv_tile(f32x16* o, unsigned vb0, bf16x8 pa0, bf16x8 pa1, bf16x8 pa2, bf16x8 pa3) {
#define TRRD(dst, off) asm volatile("ds_read_b64_tr_b16 %0, %1 offset:%2" : "=&v"(dst) : "v"(vb0), "i"(off) : "memory")
#define PV_D0(d0) do { s16x4 l0, l1, l2, l3, h0, h1, h2, h3; constexpr int b_ = v_rd_off(d0, 0, 0); \
        TRRD(l0, b_); TRRD(h0, b_ + 2048); TRRD(l1, b_ + 4096); TRRD(h1, b_ + 6144); TRRD(l2, b_ + 8192); TRRD(h2, b_ + 10240); TRRD(l3, b_ + 12288); TRRD(h3, b_ + 14336); \
        asm volatile("s_waitcnt lgkmcnt(0)" ::: "memory"); SBAR(); \
        o[d0] = __builtin_amdgcn_mfma_f32_32x32x16_bf16(pa0, (bf16x8){l0[0], l0[1], l0[2], l0[3], h0[0], h0[1], h0[2], h0[3]}, o[d0], 0, 0, 0); \
        o[d0] = __builtin_amdgcn_mfma_f32_32x32x16_bf16(pa1, (bf16x8){l1[0], l1[1], l1[2], l1[3], h1[0], h1[1], h1[2], h1[3]}, o[d0], 0, 0, 0); \
        o[d0] = __builtin_amdgcn_mfma_f32_32x32x16_bf16(pa2, (bf16x8){l2[0], l2[1], l2[2], l2[3], h2[0], h2[1], h2[2], h2[3]}, o[d0], 0, 0, 0); \
        o[d0] = __builtin_amdgcn_mfma_f32_32x32x16_bf16(pa3, (bf16x8){l3[0], l3[1], l3[2], l3[3], h3[0], h3[1], h3[2], h3[3]}, o[d0], 0, 0, 0); } while (0)
    PV_D0(0); PV_D0(1); PV_D0(2); PV_D0(3);
#undef PV_D0
#undef TRRD
}
__device__ __forceinline__ void glds16(const bf16* g, LAS unsigned char* l) {
    __builtin_amdgcn_global_load_lds((const unsigned*)g, (LAS unsigned*)l, 16, 0, 0);
}

template <int DIFF, int HF>
__device__ __forceinline__ void half_step(f32x16* o, float& m_reg, float& l_reg, const bf16x8* qr, const LAS unsigned char* Kst, unsigned vb0, LAS float* al_l,
                                          int kbh, int q0, int r32, int hi, float slope2, bool selbit) {
    constexpr int NO = DIFF ? 8 : 4;
    if (kbh > q0 + 31) return;
    float binit = slope2 * (float)(kbh - (q0 + r32) + 4 * hi);
    if (!selbit) binit = -__builtin_inff();
    f32x16 p;
#pragma unroll
    for (int r = 0; r < 16; ++r) p[r] = fmaf(slope2, (float)((r & 3) + 8 * (r >> 2)), binit);
    {
        const LAS unsigned char* kb4[4];
#pragma unroll
        for (int dd = 0; dd < 4; ++dd) kb4[dd] = Kst + KSWZ(r32, (dd * 16 + hi * 8) * 2) + HF * 8192;
        if (DIFF) {
            bf16x8 kf[4];
#pragma unroll
            for (int d0 = 0; d0 < 4; ++d0) kf[d0] = *(const LAS bf16x8*)(kb4[d0]);
            SBAR();
#pragma unroll
            for (int d0 = 0; d0 < 4; ++d0) { p = __builtin_amdgcn_mfma_f32_32x32x16_bf16(kf[d0], qr[d0], p, 0, 0, 0); kf[d0] = *(const LAS bf16x8*)(kb4[d0] + 128); }
            SBAR();
#pragma unroll
            for (int d0 = 0; d0 < 4; ++d0) p = __builtin_amdgcn_mfma_f32_32x32x16_bf16(kf[d0], qr[4 + d0], p, 0, 0, 0);
        } else {
            bf16x8 kf[8];
#pragma unroll
            for (int d0 = 0; d0 < 8; ++d0) kf[d0] = *(const LAS bf16x8*)(kb4[d0 & 3] + (d0 >> 2) * 128);
            SBAR();
#pragma unroll
            for (int d0 = 0; d0 < 8; ++d0) p = __builtin_amdgcn_mfma_f32_32x32x16_bf16(kf[d0], qr[d0], p, 0, 0, 0);
        }
    }
    if (kbh + 31 > q0) {
        const int dq = q0 + r32 - kbh - 4 * hi; const float NEG = -__builtin_inff();
#pragma unroll
        for (int r = 0; r < 16; ++r) { const int c = (r & 3) + 8 * (r >> 2); if (c > dq) p[r] = NEG; }
    }
    float pmax = p[0];
#pragma unroll
    for (int r = 1; r < 16; ++r) pmax = fmaxf(pmax, p[r]);
    { auto rr = __builtin_amdgcn_permlane32_swap(__float_as_uint(pmax), __float_as_uint(pmax), false, false); pmax = fmaxf(__uint_as_float(rr[0]), __uint_as_float(rr[1])); }
    if (__all(pmax - m_reg < PSKIP)) return;
    float mn, alpha;
    if (__all(pmax - m_reg <= THR2)) { mn = m_reg; alpha = 1.f; }
    else { mn = fmaxf(m_reg, pmax); alpha = __builtin_amdgcn_exp2f(m_reg - mn); m_reg = mn; }
#pragma unroll
    for (int r = 0; r < 16; ++r) p[r] = __builtin_amdgcn_exp2f(p[r] - mn);
    float ps = 0.f;
#pragma unroll
    for (int r = 0; r < 16; ++r) ps += p[r];
    { auto rr = __builtin_amdgcn_permlane32_swap(__float_as_uint(ps), __float_as_uint(ps), false, false); ps = __uint_as_float(rr[0]) + __uint_as_float(rr[1]); }
    l_reg = l_reg * alpha + ps;
    bf16x8 pa0, pa1;
#define PK4(P, B_, OUT) do { unsigned a0 = cvtpk(P[B_ + 0], P[B_ + 1]), a1 = cvtpk(P[B_ + 2], P[B_ + 3]); \
        unsigned b0 = cvtpk(P[B_ + 4], P[B_ + 5]), b1 = cvtpk(P[B_ + 6], P[B_ + 7]); \
        auto r0 = __builtin_amdgcn_permlane32_swap(a0, b0, false, false); auto r1 = __builtin_amdgcn_permlane32_swap(a1, b1, false, false); \
        u32x4 w = {r0[0], r1[0], r0[1], r1[1]}; OUT = __builtin_bit_cast(bf16x8, w); } while (0)
    PK4(p, 0, pa0); PK4(p, 8, pa1);
#undef PK4
    if (__any(alpha < 1.f)) {
        if (hi == 0) al_l[r32] = alpha;
        asm volatile("s_waitcnt lgkmcnt(0)" ::: "memory");
#pragma unroll
        for (int r = 0; r < 16; ++r) { const float a = al_l[crow(r, hi)];
#pragma unroll
            for (int d = 0; d < NO; ++d) o[d][r] *= a; }
    }
    {
        const LAS unsigned char* vp = (const LAS unsigned char*)(uintptr_t)vb0;
#define VTR(off) __builtin_bit_cast(s16x4, __builtin_amdgcn_ds_read_tr16_b64_v4i16((LAS v4i16_t*)(vp + (off))))
#define GOFF(g) (((g) >> 2) * SUB + v_rd_off((g) & 3, 2 * HF, 0))
#define LOADG(V, g) do { V[0] = VTR(GOFF(g)); V[1] = VTR(GOFF(g) + 2048); V[2] = VTR(GOFF(g) + 4096); V[3] = VTR(GOFF(g) + 6144); } while (0)
#define MMAG(V, g) do { o[g] = __builtin_amdgcn_mfma_f32_32x32x16_bf16(pa0, (bf16x8){V[0][0], V[0][1], V[0][2], V[0][3], V[1][0], V[1][1], V[1][2], V[1][3]}, o[g], 0, 0, 0); \
                        o[g] = __builtin_amdgcn_mfma_f32_32x32x16_bf16(pa1, (bf16x8){V[2][0], V[2][1], V[2][2], V[2][3], V[3][0], V[3][1], V[3][2], V[3][3]}, o[g], 0, 0, 0); } while (0)
        s16x4 va[4], vc[4];
        LOADG(va, 0); LOADG(vc, 1); SBAR();
        MMAG(va, 0); LOADG(va, 2); SBAR();
        MMAG(vc, 1); LOADG(vc, 3); SBAR();
        if (DIFF) {
            MMAG(va, 2); LOADG(va, 4); SBAR();
            MMAG(vc, 3); LOADG(vc, 5); SBAR();
            MMAG(va, 4); LOADG(va, 6); SBAR();
            MMAG(vc, 5); LOADG(vc, 7); SBAR();
            MMAG(va, 6); SBAR();
            MMAG(vc, 7);
        } else {
            MMAG(va, 2); SBAR();
            MMAG(vc, 3);
        }
#undef MMAG
#undef LOADG
#undef GOFF
#undef VTR
    }
}

template <int DIFF>
__device__ __forceinline__ void attn_unit(LAS unsigned char* lds, const bf16* __restrict__ proj, bf16* __restrict__ mixed, const bf16* __restrict__ kmean,
                                          int b, int h, int idx, float lam, const float* __restrict__ subw, int pmode = 0) {
    constexpr int NO = DIFF ? 8 : 4;
    const int tid = threadIdx.x, lane = tid & 63, wid = __builtin_amdgcn_readfirstlane(tid >> 6), r32 = lane & 31, hi = lane >> 5;
    const int rg = wid & 3, comp = wid >> 2;
    const int q0 = DIFF ? (128 * idx + 32 * rg) : (256 * idx + 32 * wid);
    const size_t rowbase = (size_t)b * SEQ;
    const int qcol = DIFF ? (3072 + 256 * h + 128 * comp) : (128 * h);
    const int kcol = DIFF ? (4096 + 256 * h) : (1024 + 128 * h);
    const int vcol = DIFF ? (5120 + 256 * h) : (2048 + 128 * h);
    const float slope2 = (DIFF ? __builtin_amdgcn_exp2f(-2.f * (float)(h + 1)) : __builtin_amdgcn_exp2f(-(float)(h + 1))) * LOG2E;
    const int NT = DIFF ? 2 * (idx + 1) : 4 * (idx + 1);
    int koff, voff;
    { const int row = 4 * wid + (lane >> 4), ch = (lane & 15) ^ (row & 7); koff = row * PITCH + 8 * ch;
      const int sub = 2 * wid + (lane >> 5), kk = 8 * (sub >> 2) + ((lane & 31) >> 2), k = (kk & ~0xC) | ((kk & 4) << 1) | ((kk & 8) >> 1), c = 32 * (sub & 3) + 8 * (lane & 3);
      voff = k * PITCH + c; }
    LAS unsigned char* const dst0 = lds + wid * 1024;
#define ISSUE_TILE(st, kb_) do { const bf16* g_ = proj + (rowbase + (size_t)(kb_)) * PITCH; LAS unsigned char* d_ = dst0 + (st) * STAGE; \
        _Pragma("unroll") for (int i_ = 0; i_ < 2; ++i_) { \
            glds16(g_ + kcol + koff + i_ * 32 * PITCH, d_ + i_ * 8192); \
            if (DIFF) { glds16(g_ + kcol + 128 + koff + i_ * 32 * PITCH, d_ + SUB + i_ * 8192); \
                        glds16(g_ + vcol + voff + i_ * 32 * PITCH, d_ + 2 * SUB + i_ * 8192); \
                        glds16(g_ + vcol + 128 + voff + i_ * 32 * PITCH, d_ + 3 * SUB + i_ * 8192); } \
            else { glds16(g_ + vcol + voff + i_ * 32 * PITCH, d_ + SUB + i_ * 8192); } } } while (0)
#define TILE_KB(t_) (DIFF ? 64 * (NT - 1 - (t_)) : ((t_) < 4 ? 256 * idx + 64 * (3 - (t_)) : 256 * (idx - 1 - (((t_) - 4) >> 2)) + 64 * (3 - (((t_) - 4) & 3))))
    ISSUE_TILE(0, TILE_KB(0));
    if (!DIFF && idx > 0) {
        const int row = 4 * wid + (lane >> 4), ch = (lane & 15) ^ (row & 7);
        glds16(kmean + ((size_t)(b * 8 + h) * 32 + row) * 128 + 8 * ch, dst0 + STAGE);
    }
    bf16x8 qr[8];
    { const bf16* qp = proj + (rowbase + q0 + r32) * PITCH + qcol + hi * 8;
#pragma unroll
      for (int d0 = 0; d0 < 8; ++d0) qr[d0] = *(const bf16x8*)(qp + d0 * 16); }
    LAS float* const al_l = (LAS float*)(lds + ATT_SCR_OFF + wid * 512);
    LAS float* const li_l = al_l + 32;
    unsigned sel = 0u;
    if (!DIFF && idx > 0) {
        asm volatile("s_waitcnt vmcnt(0)" ::: "memory"); __syncthreads();
        f32x16 g = {};
        { const LAS unsigned char* Ks = lds + STAGE;
#pragma unroll
          for (int d0 = 0; d0 < 8; ++d0) { const LAS unsigned char* a = Ks + KSWZ(r32, ((d0 & 3) * 16 + hi * 8) * 2) + (d0 >> 2) * 128;
              g = __builtin_amdgcn_mfma_f32_32x32x16_bf16(*(const LAS bf16x8*)a, qr[d0], g, 0, 0, 0); } }
        float gv[16]; int gn[16];
#pragma unroll
        for (int r = 0; r < 8; ++r) { const int nb = (r & 3) + 8 * (r >> 2);
            gv[r] = g[r]; gn[r] = nb + 4 * hi; gv[8 + r] = __shfl_xor(g[r], 32); gn[8 + r] = nb + 4 * (1 - hi); }
        const float NEG = -__builtin_inff();
        float m1 = NEG, m2 = NEG, m3 = NEG;
#pragma unroll
        for (int i = 0; i < 16; ++i) { float v = gn[i] < idx ? gv[i] : NEG;
            float t1 = fmaxf(m1, v); v = fminf(m1, v); m1 = t1; float t2 = fmaxf(m2, v); v = fminf(m2, v); m2 = t2; m3 = fmaxf(m3, v); }
#pragma unroll
        for (int i = 0; i < 16; ++i) if (gn[i] < idx && gv[i] >= m3) sel |= 1u << gn[i];
    }
    float m_reg = -1e30f, l_reg = 0.f;
    f32x16 o[NO];
#pragma unroll
    for (int d = 0; d < NO; ++d) o[d] = f32x16{};
    const unsigned ldsu = (unsigned)(uintptr_t)lds;
    const int ksub = DIFF ? comp : 0;
    for (int t = 0; t < NT; ++t) {
        asm volatile("s_waitcnt vmcnt(0)" ::: "memory"); __syncthreads();
        if (t + 1 < NT && !(pmode & 1)) ISSUE_TILE((t + 1) & 1, TILE_KB(t + 1));
        const int kb = TILE_KB(t);
        const bool past = !DIFF && t >= 4;
        const bool selbit = past ? (((sel >> (idx - 1 - ((t - 4) >> 2))) & 1u) != 0u) : true;
        const int stoff = (t & 1) * STAGE;
        const LAS unsigned char* Kst = lds + stoff + ksub * SUB;
        const unsigned vb0 = ldsu + stoff + (DIFF ? 2 : 1) * SUB + v_rd_base(lane);
        if (!(pmode & 2)) {
        half_step<DIFF, 1>(o, m_reg, l_reg, qr, Kst, vb0, al_l, kb + 32, q0, r32, hi, slope2, selbit);
        half_step<DIFF, 0>(o, m_reg, l_reg, qr, Kst, vb0, al_l, kb, q0, r32, hi, slope2, selbit);
        }
    }
    if (hi == 0) li_l[r32] = l_reg;
    asm volatile("s_waitcnt lgkmcnt(0)" ::: "memory");
    float rli[16];
#pragma unroll
    for (int r = 0; r < 16; ++r) rli[r] = __builtin_amdgcn_rcpf(li_l[crow(r, hi)]);
    if (!DIFF) {
        bf16* Ow = mixed + (rowbase + q0) * D + 128 * h;
#pragma unroll
        for (int r = 0; r < 16; ++r) { const int orow = crow(r, hi);
#pragma unroll
            for (int d0 = 0; d0 < 4; ++d0) { const float v = o[d0][r] * rli[r]; const float vn = __shfl_xor(v, 1);
                if ((r32 & 1) == 0) *(unsigned*)(Ow + (size_t)orow * D + d0 * 32 + r32) = cvtpk(v, vn); } }
        __syncthreads();
    } else {
        __syncthreads();
        LAS float* xb = (LAS float*)(lds + rg * 32768) + lane;
        if (comp == 1) {
#pragma unroll
            for (int d0 = 0; d0 < 8; ++d0)
#pragma unroll
                for (int r = 0; r < 16; ++r) xb[(d0 * 16 + r) * 64] = lam * o[d0][r] * rli[r];
        }
        __syncthreads();
        if (comp == 0) {
            float ssq[16];
#pragma unroll
            for (int r = 0; r < 16; ++r) ssq[r] = 0.f;
#pragma unroll
            for (int d0 = 0; d0 < 8; ++d0)
#pragma unroll
                for (int r = 0; r < 16; ++r) { const float dv = o[d0][r] * rli[r] - xb[(d0 * 16 + r) * 64]; o[d0][r] = dv; ssq[r] += dv * dv; }
#pragma unroll
            for (int r = 0; r < 16; ++r) { float s = ssq[r]; s += __shfl_xor(s, 1); s += __shfl_xor(s, 2); s += __shfl_xor(s, 4); s += __shfl_xor(s, 8); s += __shfl_xor(s, 16);
                ssq[r] = __builtin_amdgcn_rsqf(s * (1.f / 256.f) + RMS_EPS) * 0.8f; }
            bf16* Ow = mixed + (rowbase + q0) * D + 1024 + 256 * h;
#pragma unroll
            for (int d0 = 0; d0 < 8; ++d0) { const float wv = subw[d0 * 32 + r32];
#pragma unroll
                for (int r = 0; r < 16; ++r) { const float v = o[d0][r] * ssq[r] * wv; const float vn = __shfl_xor(v, 1);
                    if ((r32 & 1) == 0) *(unsigned*)(Ow + (size_t)crow(r, hi) * D + d0 * 32 + r32) = cvtpk(v, vn); } }
        }
        __syncthreads();
    }
#undef ISSUE_TILE
#undef TILE_KB
}

#undef KSWZ
#undef SBAR
}

__device__ __forceinline__ void tr_item(const float* __restrict__ W, int N, int K, int k0, int n0, bf16* __restrict__ dst, LAS unsigned* scr, int lane) {
    { const int kr = lane >> 4, nc = (lane & 15) * 4;
      f32x4 v[16];
#pragma unroll
      for (int i = 0; i < 16; ++i) v[i] = *(const f32x4*)(W + (size_t)(k0 + 4 * i + kr) * N + n0 + nc);
#pragma unroll
      for (int i = 0; i < 16; ++i) { const int k = 4 * i + kr; scr[k * 33 + (nc >> 1)] = pk2(v[i][0], v[i][1]); scr[k * 33 + (nc >> 1) + 1] = pk2(v[i][2], v[i][3]); } }
    asm volatile("s_waitcnt lgkmcnt(0)" ::: "memory");
    { const int np = lane >> 3, c = lane & 7;
#pragma unroll
      for (int j = 0; j < 4; ++j) { const int n2 = np + 8 * j; unsigned d[8];
#pragma unroll
          for (int i = 0; i < 8; ++i) d[i] = scr[(8 * c + i) * 33 + n2];
          u32x4 lo, hi;
          lo.x = (d[0] & 0xffffu) | (d[1] << 16); lo.y = (d[2] & 0xffffu) | (d[3] << 16); lo.z = (d[4] & 0xffffu) | (d[5] << 16); lo.w = (d[6] & 0xffffu) | (d[7] << 16);
          hi.x = (d[0] >> 16) | (d[1] & 0xffff0000u); hi.y = (d[2] >> 16) | (d[3] & 0xffff0000u); hi.z = (d[4] >> 16) | (d[5] & 0xffff0000u); hi.w = (d[6] >> 16) | (d[7] & 0xffff0000u);
          *(u32x4*)(dst + (size_t)(2 * n2) * K + k0 + 8 * c) = lo;
          *(u32x4*)(dst + (size_t)(2 * n2 + 1) * K + k0 + 8 * c) = hi; } }
    asm volatile("s_waitcnt lgkmcnt(0)" ::: "memory");
}
__device__ __forceinline__ void rms_row_to_bf16(const float* __restrict__ xrow, const float* __restrict__ w, bf16* __restrict__ orow, int lane) {
    const f32x4* xr = (const f32x4*)xrow + lane; const f32x4* wr = (const f32x4*)w + lane;
    f32x4 v[8]; float s = 0.f;
#pragma unroll
    for (int j = 0; j < 8; ++j) { v[j] = xr[64 * j]; s += (v[j][0] * v[j][0] + v[j][1] * v[j][1]) + (v[j][2] * v[j][2] + v[j][3] * v[j][3]); }
    const float rstd = __builtin_amdgcn_rsqf(wave_sum(s) * (1.f / D) + RMS_EPS);
    u32x2* o8 = (u32x2*)orow + lane;
#pragma unroll
    for (int j = 0; j < 8; ++j) { const f32x4 ww = wr[64 * j]; u32x2 p; p.x = pk2(v[j][0] * rstd * ww[0], v[j][1] * rstd * ww[1]); p.y = pk2(v[j][2] * rstd * ww[2], v[j][3] * rstd * ww[3]); o8[64 * j] = p; }
}


struct Args { const float* in[18]; float* out; unsigned char* ws; int ph_lo, ph_hi, li, pad; };
__global__ void __launch_bounds__(NWAVES * 64, 2) trunk_fwd(Args args) {
    extern __shared__ __attribute__((aligned(16))) unsigned char lds_raw[];
    LAS unsigned char* const lds = (LAS unsigned char*)lds_raw;
    volatile LAS unsigned* const MISC = (volatile LAS unsigned*)(lds + MISC_OFF);
    const int tid = threadIdx.x, lane = tid & 63, wave = __builtin_amdgcn_readfirstlane(tid >> 6);
    const int G = gridDim.x, bx = blockIdx.x;
    const int gw = bx * NWAVES + wave, NGW = G * NWAVES;
    unsigned char* const ws = args.ws;
    unsigned* const ctl = (unsigned*)(ws + WS_CTL);
    const float* const x = args.in[0];
    bf16* const WinT = (bf16*)(ws + WS_WIN); bf16* const WoutT = (bf16*)(ws + WS_WOUT); bf16* const Hb = (bf16*)(ws + WS_H);
    bf16* const WguT = (bf16*)(ws + WS_WGU); bf16* const WdT = (bf16*)(ws + WS_WD);
    bf16* const PROJ = (bf16*)(ws + WS_PROJ); bf16* const XP = (bf16*)(ws + WS_XP); bf16* const MIX = (bf16*)(ws + WS_MIX); bf16* const ACT = (bf16*)(ws + WS_ACT);
    float* const X1 = (float*)(ws + WS_X1); bf16* const Y = (bf16*)(ws + WS_Y);
    bf16* const KMEAN = (bf16*)(ws + WS_KMEAN); u32x4* const TOKINFO = (u32x4*)(ws + WS_TOKINFO); float* const TOKRSTD = (float*)(ws + WS_TOKRSTD);
    int* const ROWINFO = (int*)(ws + WS_ROWINFO); bf16* const WRHI = (bf16*)(ws + WS_WRHI); bf16* const WRLO = (bf16*)(ws + WS_WRLO);

    for (int u = tid; u < (LDS_BYTES - ATT_SCR_OFF) / 4; u += NWAVES * 64) ((LAS unsigned*)(lds + ATT_SCR_OFF))[u] = 0u;
    __syncthreads();
    const int lo = args.ph_lo, hi_ph = args.ph_hi;
    XcdBarrier bar; bar.bar = ctl + CW_BAR + args.li * XCD_BAR_WORDS; bar.x = 0; bar.st = nullptr;
    if (hi_ph - lo > 1) bar = xcd_barrier_post(ctl + CW_BAR + args.li * XCD_BAR_WORDS, MISC + 8);
#define GRID_BAR() xcd_barrier(bar)
#if defined(PROBE_DUP)
    const int POFF = args.li == 1 ? 8192 : 0;
#else
    constexpr int POFF = 0;
#endif
#ifndef PH_MASK
#define PH_MASK 0x3ff
#endif
#define IN(k) (((PH_MASK >> (k)) & 1) && lo <= (k) && (k) < hi_ph)
#define BOTH(k) (IN(k) && IN((k) + 1))

    constexpr int I_IN = 32 * 96, I_OUT = 32 * 32, I_G = 32 * 8 * 32, I_D = 8 * 32 * 32;
    constexpr int N_DENSE = I_IN + I_OUT, N_MOE = 2 * I_G + I_D;
#define DENSE_ITEM(r_) do { int r = (r_); \
        if (r < I_IN) { const int kb = r / 96, nb = r % 96; tr_item(args.in[2], NIN, D, 64 * kb, 64 * nb, WinT + (size_t)(64 * nb) * D, scr, lane); } \
        else { r -= I_IN; const int kb = r / 32, nb = r % 32; tr_item(args.in[8], D, D, 64 * kb, 64 * nb, WoutT + (size_t)(64 * nb) * D, scr, lane); } } while (0)
#define MOE_ITEM(r_) do { int r = (r_); \
        if (r < 2 * I_G) { const int up = r >= I_G ? 1 : 0; if (up) r -= I_G; const int e = r >> 8, q = r & 255, kb = q >> 3, nb = q & 7, n0 = 64 * nb; \
            const float* W = (up ? args.in[15] : args.in[14]) + (size_t)e * D * DE; \
            tr_item(W, DE, D, 64 * kb, n0, WguT + ((size_t)e * 1024 + (n0 >> 7) * 256 + (n0 & 127) + up * 128) * D, scr, lane); } \
        else { r -= 2 * I_G; const int e = r >> 8, q = r & 255, kb = q >> 5, nb = q & 31; \
            tr_item(args.in[16] + (size_t)e * DE * D, D, DE, 64 * kb, 64 * nb, WdT + ((size_t)e * 2048 + 64 * nb) * DE, scr, lane); } } while (0)
    const int n_moe_p0 = N_MOE_P0, n_moe_p1 = (G == 256) ? N_MOE_P1 : N_MOE_P0;
    const int GP1 = (n_moe_p1 > n_moe_p0) ? 192 : G;

    if (IN(0)) {
        LAS unsigned* scr = (LAS unsigned*)(lds + wave * 16384);
        for (int it = gw; it < N_DENSE; it += NGW) DENSE_ITEM(it);
        for (int it = gw; it < n_moe_p0; it += NGW) MOE_ITEM(it);
        for (int i = bx * 512 + tid; i < 48 * D; i += G * 512) { const int c = i / D, k = i % D;
            const float v = c < 4 ? args.in[10][k * 4 + c] : (c < 36 ? args.in[12][k * 32 + (c - 4)] : 0.f);
            const unsigned h = f2bf(v); WRHI[i] = (bf16)h; WRLO[i] = (bf16)f2bf(v - bf2f(h)); }
        for (int m = gw; m < T; m += NGW) rms_row_to_bf16(x + (size_t)m * D, args.in[1], Hb + (size_t)m * D, lane);
        if (BOTH(0)) GRID_BAR();
    }

    if (IN(1)) {
        if (bx < GP1) {
            pg8::Gemm g{Hb, WinT, T, NIN, D}; pg8::StaticOrder S; S.init(T, NIN, GP1, bx);
            pg8::EpiProj E{PROJ, NIN, QSCALE};
            pg8::gemm_phase<pg8::EpiProj, pg8::StaticOrder, true, true>(lds, g, S, E);
        } else {
            LAS unsigned* scr = (LAS unsigned*)(lds + wave * 16384);
            for (int it = n_moe_p0 + (bx - GP1) * NWAVES + wave; it < n_moe_p1; it += (G - GP1) * NWAVES) MOE_ITEM(it);
        }
        if (BOTH(1)) GRID_BAR();
    }

    if (IN(2)) {
        LAS float* red = (LAS float*)lds;
        for (int u = bx; u < 256; u += G) { const int bh = u >> 4, blk = u & 15, b = bh >> 3, h = bh & 7;
            const bf16* kp = PROJ + ((size_t)b * SEQ + 256 * blk + 32 * wave) * NIN + 1024 + 128 * h + 2 * lane;
            float s0 = 0.f, s1 = 0.f;
#pragma unroll 8
            for (int r = 0; r < 32; ++r) { const unsigned v = *(const unsigned*)(kp + (size_t)r * NIN); s0 += bf2f(v & 0xffffu); s1 += bf2f(v >> 16); }
            red[wave * 128 + 2 * lane] = s0; red[wave * 128 + 2 * lane + 1] = s1;
            __syncthreads();
            if (tid < 128) { float s = 0.f;
#pragma unroll
                for (int w = 0; w < 8; ++w) s += red[w * 128 + tid];
                KMEAN[((size_t)bh * 32 + blk) * 128 + tid] = (bf16)f2bf(s * (1.f / 256.f)); }
            if (blk == 0) { for (int i = tid; i < 16 * 128; i += 512) KMEAN[((size_t)bh * 32 + 16) * 128 + i] = 0; }
            __syncthreads();
        }
        if (BOTH(2)) GRID_BAR();
    }

    if (IN(3)) {
        float lam;
        { const float a = args.in[3][lane] * args.in[4][lane] + args.in[3][lane + 64] * args.in[4][lane + 64];
          const float c = args.in[5][lane] * args.in[6][lane] + args.in[5][lane + 64] * args.in[6][lane + 64];
          lam = __expf(wave_sum(a)) - __expf(wave_sum(c)) + 0.2f; }
        LAS int* const ucost = (LAS int*)(lds + QTAB_OFF); LAS unsigned* const uperm = (LAS unsigned*)(lds + QTAB_OFF + 2048);
        { const int u = tid, ty = u >> 8, b = (u >> 7) & 1; int c; unsigned ent;
          if (ty) { const int h = (u >> 5) & 3, j = u & 31, nt = 2 * (j + 1); const int dh = h == 0 ? 444 : (h == 1 ? 1774 : 8192); int near = dh / 64 + 3; near = near < nt ? near : nt;
              c = near * 48 + (nt - near) * 18; ent = (1u << 16) | ((unsigned)b << 12) | ((unsigned)h << 8) | (unsigned)j; }
          else { const int h = (u >> 4) & 7, i = u & 15, nt = 4 * (i + 1); const int dh = h < 5 ? (222 << h) : 8192; int near = dh / 64 + 5; near = near < nt ? near : nt;
              c = near * 32 + (nt - near) * 17; ent = ((unsigned)b << 12) | ((unsigned)h << 8) | (unsigned)i; }
          ucost[u] = c; __syncthreads();
          int rank = 0;
          for (int v = 0; v < 512; ++v) { const int cv = ucost[v]; rank += (cv > c || (cv == c && v < u)) ? 1 : 0; }
          uperm[rank] = ent; __syncthreads(); }
        unsigned qi;
        for (;;) {
            if (tid == 0) MISC[16] = __hip_atomic_fetch_add(ctl + CW_QHEAD + 64 * args.li, 1u, __ATOMIC_RELAXED, __HIP_MEMORY_SCOPE_AGENT);
            __syncthreads();
            qi = __builtin_amdgcn_readfirstlane(MISC[16]);
            if (qi >= 512u) break;
            const unsigned e = __builtin_amdgcn_readfirstlane(uperm[qi]); const int ty = (int)(e >> 16), b = (int)((e >> 12) & 15u), h = (int)((e >> 8) & 15u), idx = (int)(e & 255u);
#if defined(PROBE_DUP) && defined(PROBE_MODE)
            const int pmode = args.li == 1 ? PROBE_MODE : 0; bf16* const mixo = args.li == 1 ? Hb : MIX;
#else
            constexpr int pmode = 0; bf16* const mixo = MIX;
#endif
            if (ty) att::attn_unit<1>(lds, PROJ, mixo, KMEAN, b, h, idx, lam, args.in[7], pmode);
            else att::attn_unit<0>(lds, PROJ, mixo, KMEAN, b, h, idx, lam, args.in[7], pmode);
        }
        { const unsigned ncu = (unsigned)((N_MOE - n_moe_p1 + NWAVES - 1) / NWAVES); LAS unsigned* scr = (LAS unsigned*)(lds + wave * 16384);
          while (qi < 512u + ncu) {
              const int it = n_moe_p1 + (int)(qi - 512u) * NWAVES + wave; if (it < N_MOE) MOE_ITEM(it);
              __syncthreads();
              if (tid == 0) MISC[16] = __hip_atomic_fetch_add(ctl + CW_QHEAD + 64 * args.li, 1u, __ATOMIC_RELAXED, __HIP_MEMORY_SCOPE_AGENT);
              __syncthreads();
              qi = __builtin_amdgcn_readfirstlane(MISC[16]); } }
        if (BOTH(3)) GRID_BAR();
    }

    if (IN(4)) {
        pg8::Gemm g{MIX, WoutT, T, D, D}; pg8::StaticOrder S; S.init(T, D, G, bx);
        pg8::EpiResid E{x, X1, D};
        pg8::gemm_phase<pg8::EpiResid, pg8::StaticOrder, false, true>(lds, g, S, E);
        if (BOTH(4)) GRID_BAR();
    }

    if (IN(5)) {
        LAS float* lg = (LAS float*)(lds + wave * 4096);
        const float* nw = args.in[9];
        const int nit5 = (T / 16 + 2 * G - 1) / (2 * G);
        for (int it = 0; it < nit5; ++it) {
            const int tile = (2 * it + (wave >> 2)) * G + bx; const bool tvalid = tile < T / 16;
            const int t0 = (tvalid ? tile : 0) * 16, row = lane & 15, kq = lane >> 4, kpart = wave & 3;
            const float* xr = X1 + (size_t)(t0 + row) * D + 8 * kq;
            pg8::f32x4 acc[3] = {{0.f, 0.f, 0.f, 0.f}, {0.f, 0.f, 0.f, 0.f}, {0.f, 0.f, 0.f, 0.f}};
            float ss = 0.f;
#pragma unroll 2
            for (int s = 16 * kpart; s < 16 * kpart + 16; ++s) {
                const f32x4 a0 = *(const f32x4*)(xr + 32 * s), a1 = *(const f32x4*)(xr + 32 * s + 4);
                const f32x4 w0 = *(const f32x4*)(nw + 32 * s + 8 * kq), w1 = *(const f32x4*)(nw + 32 * s + 8 * kq + 4);
                ss += (a0[0] * a0[0] + a0[1] * a0[1]) + (a0[2] * a0[2] + a0[3] * a0[3]) + (a1[0] * a1[0] + a1[1] * a1[1]) + (a1[2] * a1[2] + a1[3] * a1[3]);
                const f32x4 u0 = a0 * w0, u1 = a1 * w1;
                unsigned hb[8]; float uf[8] = {u0[0], u0[1], u0[2], u0[3], u1[0], u1[1], u1[2], u1[3]};
                u32x4 ah, al;
#pragma unroll
                for (int j = 0; j < 8; ++j) hb[j] = f2bf(uf[j]);
                ah.x = hb[0] | (hb[1] << 16); ah.y = hb[2] | (hb[3] << 16); ah.z = hb[4] | (hb[5] << 16); ah.w = hb[6] | (hb[7] << 16);
                al.x = pk2(uf[0] - bf2f(hb[0]), uf[1] - bf2f(hb[1])); al.y = pk2(uf[2] - bf2f(hb[2]), uf[3] - bf2f(hb[3]));
                al.z = pk2(uf[4] - bf2f(hb[4]), uf[5] - bf2f(hb[5])); al.w = pk2(uf[6] - bf2f(hb[6]), uf[7] - bf2f(hb[7]));
                const bf16x8 afh = __builtin_bit_cast(bf16x8, ah), afl = __builtin_bit_cast(bf16x8, al);
#pragma unroll
                for (int ct = 0; ct < 3; ++ct) { const size_t wo = (size_t)(16 * ct + row) * D + 32 * s + 8 * kq;
                    const bf16x8 bh = *(const bf16x8*)(WRHI + wo), bl = *(const bf16x8*)(WRLO + wo);
                    acc[ct] = __builtin_amdgcn_mfma_f32_16x16x32_bf16(afh, bh, acc[ct], 0, 0, 0);
                    acc[ct] = __builtin_amdgcn_mfma_f32_16x16x32_bf16(afh, bl, acc[ct], 0, 0, 0);
                    acc[ct] = __builtin_amdgcn_mfma_f32_16x16x32_bf16(afl, bh, acc[ct], 0, 0, 0); }
            }
            ss += __shfl_xor(ss, 16); ss += __shfl_xor(ss, 32);
#pragma unroll
            for (int ct = 0; ct < 3; ++ct)
#pragma unroll
                for (int r = 0; r < 4; ++r) lg[(4 * kq + r) * 48 + 16 * ct + row] = acc[ct][r];
            if (kq == 0) lg[768 + row] = ss;
            __syncthreads();
            if (tvalid && kpart == 0 && lane < 16) {
                const LAS float* L0 = lg + lane * 48;
                const float rs = __builtin_amdgcn_rsqf((lg[768 + lane] + lg[1024 + 768 + lane] + lg[2048 + 768 + lane] + lg[3072 + 768 + lane]) * (1.f / D) + RMS_EPS);
#define LGT(c) ((L0[(c)] + L0[1024 + (c)]) + (L0[2048 + (c)] + L0[3072 + (c)]))
                float gmax = -__builtin_inff(); int gi = 0; float gl[4];
#pragma unroll
                for (int c = 0; c < 4; ++c) { gl[c] = LGT(c) * rs + args.in[11][c]; if (gl[c] > gmax) { gmax = gl[c]; gi = c; } }
                float gsum = 0.f;
#pragma unroll
                for (int c = 0; c < 4; ++c) gsum += __expf(gl[c] - gmax);
                const float gp = 1.f / gsum;
                float el[8], emax = -__builtin_inff();
#pragma unroll
                for (int j = 0; j < 8; ++j) { el[j] = LGT(4 + 8 * gi + j) * rs + args.in[13][8 * gi + j]; emax = fmaxf(emax, el[j]); }
#undef LGT
                float p0v = -1.f, p1v = -1.f; int i0 = 0, i1 = 0;
#pragma unroll
                for (int j = 0; j < 8; ++j) { const float p = __expf(el[j] - emax);
                    if (p > p0v) { p1v = p0v; i1 = i0; p0v = p; i0 = j; } else if (p > p1v) { p1v = p; i1 = j; } }
                const float inv = gp / (p0v + p1v);
                const int e0 = 8 * gi + i0, e1 = 8 * gi + i1;
                u32x4 info; info.x = (unsigned)e0; info.y = (unsigned)e1; info.z = __builtin_bit_cast(unsigned, p0v * inv); info.w = __builtin_bit_cast(unsigned, p1v * inv);
                TOKINFO[t0 + lane] = info; TOKRSTD[t0 + lane] = rs;
                atomicAdd(ctl + CW_ECNT + POFF + 64 * e0, 1u); atomicAdd(ctl + CW_ECNT + POFF + 64 * e1, 1u);
            }
            __syncthreads();
        }
        if (BOTH(5)) GRID_BAR();
    }

    LAS int* const tab = (LAS int*)(lds + MOE_TAB_OFF);
    if (IN(6) || IN(7) || IN(8)) {
        if (tid < 32) tab[120 + tid] = (int)__hip_atomic_load(ctl + CW_ECNT + 64 * tid, __ATOMIC_RELAXED, __HIP_MEMORY_SCOPE_AGENT);
        __syncthreads();
        if (tid == 0) { int ts = 0;
            for (int e = 0; e < 32; ++e) { const int c = tab[120 + e], nt = (c + 255) >> 8; tab[e] = ts; tab[40 + e] = ts; tab[80 + e] = ts * 256 + c; ts += nt; }
            tab[32] = ts; }
        __syncthreads();
    }

    if (IN(6)) {
        const float* nw = args.in[9];
        static_assert(T == 4 * 8 * 256, "P6 deal assumes 4 tokens per wave on 256 workgroups");
        for (int tb = gw; tb < T; tb += 4 * NGW) {
            int mp0 = 0, mp1 = 0; unsigned mw0 = 0u, mw1 = 0u; float mrs = 0.f;
            if (lane < 4 && tb + lane * NGW < T) { const int t = tb + lane * NGW; const u32x4 info = TOKINFO[t]; mrs = TOKRSTD[t];
                const int e0 = (int)info.x, e1 = (int)info.y; mw0 = info.z; mw1 = info.w;
                mp0 = (int)atomicAdd(ctl + CW_ECUR + POFF + 64 * e0, 1u) + tab[40 + e0] * 256; mp1 = (int)atomicAdd(ctl + CW_ECUR + POFF + 64 * e1, 1u) + tab[40 + e1] * 256; }
#pragma unroll
            for (int i = 0; i < 4; ++i) { const int t = tb + i * NGW; if (t >= T) break;
                const int p0 = __builtin_amdgcn_readlane(mp0, i), p1 = __builtin_amdgcn_readlane(mp1, i);
                const float rs = __builtin_bit_cast(float, __builtin_amdgcn_readlane(__builtin_bit_cast(int, mrs), i));
                const f32x4* xr = (const f32x4*)(X1 + (size_t)t * D) + lane; const f32x4* wr = (const f32x4*)nw + lane;
                u32x2* o0 = (u32x2*)(XP + (size_t)p0 * D) + lane; u32x2* o1 = (u32x2*)(XP + (size_t)p1 * D) + lane;
#pragma unroll
                for (int j = 0; j < 8; ++j) { const f32x4 v = xr[64 * j], ww = wr[64 * j]; u32x2 p; p.x = pk2(v[0] * rs * ww[0], v[1] * rs * ww[1]); p.y = pk2(v[2] * rs * ww[2], v[3] * rs * ww[3]);
                    o0[64 * j] = p; o1[64 * j] = p; }
                if (lane == i) { ROWINFO[2 * mp0] = 2 * t; ROWINFO[2 * mp0 + 1] = (int)mw0; ROWINFO[2 * mp1] = 2 * t + 1; ROWINFO[2 * mp1 + 1] = (int)mw1; }
            }
        }
        if (BOTH(6)) GRID_BAR();
    }

    if (IN(7)) {
        pg8::Gemm g{XP, WguT, XP_ROWS, NE * 1024, D}; pg8::MoeOrder S{tab, 4, tab[32] * 4, G, bx};
        pg8::EpiSwiGLU E{ACT};
        pg8::gemm_phase<pg8::EpiSwiGLU, pg8::MoeOrder, true, true>(lds, g, S, E);
        if (BOTH(7)) GRID_BAR();
    }

    if (IN(8)) {
        pg8::Gemm g{ACT, WdT, XP_ROWS, NE * 2048, DE}; pg8::MoeOrder S{tab, 8, tab[32] * 8, G, bx};
        pg8::EpiDown E{Y, ROWINFO, tab + 80};
        pg8::gemm_phase<pg8::EpiDown, pg8::MoeOrder, true, true>(lds, g, S, E);
        if (BOTH(8)) GRID_BAR();
    }

    if (IN(9)) {
        const float* nf = args.in[17];
        for (int t = gw; t < T; t += NGW) {
            const f32x4* xr = (const f32x4*)(X1 + (size_t)t * D) + lane;
            const u32x2* y0 = (const u32x2*)(Y + (size_t)(2 * t) * D) + lane; const u32x2* y1 = (const u32x2*)(Y + (size_t)(2 * t + 1) * D) + lane;
            f32x4 v[8]; float s = 0.f;
#pragma unroll
            for (int j = 0; j < 8; ++j) { f32x4 a = xr[64 * j]; const u32x2 p = y0[64 * j], q = y1[64 * j];
                a[0] += bf2f(p.x & 0xffffu) + bf2f(q.x & 0xffffu); a[1] += bf2f(p.x >> 16) + bf2f(q.x >> 16);
                a[2] += bf2f(p.y & 0xffffu) + bf2f(q.y & 0xffffu); a[3] += bf2f(p.y >> 16) + bf2f(q.y >> 16);
                v[j] = a; s += (a[0] * a[0] + a[1] * a[1]) + (a[2] * a[2] + a[3] * a[3]); }
            const float rstd = __builtin_amdgcn_rsqf(wave_sum(s) * (1.f / D) + RMS_EPS);
            f32x4* orow = (f32x4*)(args.out + (size_t)t * D) + lane; const f32x4* wr = (const f32x4*)nf + lane;
#pragma unroll
            for (int j = 0; j < 8; ++j) orow[64 * j] = v[j] * rstd * wr[64 * j];
        }
    }
#undef IN
#undef BOTH
#undef GRID_BAR
}

extern "C" void kernel_launch(void* const* d_in, const int* in_sizes, int n_in, void* d_out, int out_size, void* d_ws, size_t ws_size, hipStream_t stream) {
    static int grid = 0;
    if (grid == 0) {
        if (n_in != 18 || in_sizes[0] != T * D || out_size != T * D || ws_size < WS_END) { fprintf(stderr, "kernel_launch: unexpected shapes (n_in %d, in0 %d, out %d, ws %zu)\n", n_in, n_in > 0 ? in_sizes[0] : -1, out_size, ws_size); grid = -1; return; }
        int dev = 0, cus = 0, per_cu = 0;
        if (hipGetDevice(&dev) != hipSuccess || hipDeviceGetAttribute(&cus, hipDeviceAttributeMultiprocessorCount, dev) != hipSuccess) { grid = -1; return; }
        if (hipFuncSetAttribute((const void*)trunk_fwd, hipFuncAttributeMaxDynamicSharedMemorySize, LDS_BYTES) != hipSuccess) { fprintf(stderr, "kernel_launch: hipFuncSetAttribute failed\n"); grid = -1; return; }
        if (hipOccupancyMaxActiveBlocksPerMultiprocessor(&per_cu, (const void*)trunk_fwd, NWAVES * 64, LDS_BYTES) != hipSuccess || per_cu < 1)
            fprintf(stderr, "kernel_launch: note: occupancy query reports %d workgroups per CU\n", per_cu);
        (void)hipGetLastError();
        grid = cus;
    }
    if (grid < 0) return;
    if (hipMemsetAsync((char*)d_ws + WS_CTL, 0, CTL_ZERO_BYTES, stream) != hipSuccess) return;
    Args a{};
    for (int i = 0; i < 18; ++i) a.in[i] = (const float*)d_in[i];
    a.out = (float*)d_out; a.ws = (unsigned char*)d_ws;
    int plan[NPH + 2][2]; int nl = 0;
#if defined(PROBE_DUP)
    plan[nl][0] = 0; plan[nl][1] = PROBE_DUP + 1; ++nl; plan[nl][0] = PROBE_DUP; plan[nl][1] = PROBE_DUP + 1; ++nl;
    if (PROBE_DUP + 1 < NPH) { plan[nl][0] = PROBE_DUP + 1; plan[nl][1] = NPH; ++nl; }
#else
    if (N_LAUNCHES == 1) { plan[0][0] = 0; plan[0][1] = NPH; nl = 1; } else { for (int k = 0; k < NPH; ++k) { plan[k][0] = k; plan[k][1] = k + 1; } nl = NPH; }
#endif
    for (int li = 0; li < nl; ++li) {
        a.ph_lo = plan[li][0]; a.ph_hi = plan[li][1]; a.li = li;
        hipLaunchKernelGGL(trunk_fwd, dim3(grid), dim3(NWAVES * 64), LDS_BYTES, stream, a);
    }
}
```

```cpp
#include <hip/hip_runtime.h>
#include <cstdio>
#include <cstdint>

#ifndef MK_N_LAUNCHES
#define MK_N_LAUNCHES 1
#endif
constexpr int NPH = 10;
constexpr int N_LAUNCHES = MK_N_LAUNCHES;

constexpr int NWAVES = 8;
#ifndef N_MOE_P1
#define N_MOE_P1 0
#endif
#ifndef N_MOE_P0
#define N_MOE_P0 0
#endif
constexpr int BATCH = 2, SEQ = 4096, T = BATCH * SEQ, D = 2048, NIN = 6144;
constexpr int NE = 32, DE = 512, NPAIR = 2 * T;
constexpr int XP_ROWS = 24576;
constexpr float RMS_EPS = 1e-6f;
constexpr float LOG2E = 1.4426950408889634f;
constexpr float QSCALE = 0.08838834764831845f * 1.4426950408889634f;

constexpr size_t MiB = 1u << 20;
constexpr size_t WS_CTL = 0, CTL_ZERO_BYTES = 1 * MiB;
constexpr size_t WS_WIN = 1 * MiB;
constexpr size_t WS_WOUT = 25 * MiB;
constexpr size_t WS_H = 33 * MiB;
constexpr size_t WS_Y = 1 * MiB;
constexpr size_t WS_WGU = 65 * MiB;
constexpr size_t WS_WD = 193 * MiB;
constexpr size_t WS_PROJ = 257 * MiB;
constexpr size_t WS_XP = 257 * MiB;
constexpr size_t WS_MIX = 353 * MiB;
constexpr size_t WS_ACT = 353 * MiB;
constexpr size_t WS_X1 = 385 * MiB;
constexpr size_t WS_MISC = 449 * MiB;
constexpr size_t WS_KMEAN = WS_MISC;
constexpr size_t WS_TOKINFO = WS_MISC + 256 * 1024;
constexpr size_t WS_TOKRSTD = WS_MISC + 384 * 1024;
constexpr size_t WS_ROWINFO = WS_MISC + 512 * 1024;
constexpr size_t WS_WRHI = WS_MISC + 1024 * 1024;
constexpr size_t WS_WRLO = WS_MISC + 1280 * 1024;
constexpr size_t WS_END = 452 * MiB;
constexpr int CW_BAR = 4096;
constexpr int CW_ECNT = 16384;
constexpr int CW_ECUR = 16384 + 2048;
constexpr int CW_QHEAD = 16384 + 4096;

constexpr int RING_BYTES = 131072;
constexpr int ATT_SCR_OFF = 131072;
constexpr int MOE_TAB_OFF = 135168;
constexpr int MISC_OFF = 136192;
constexpr int QTAB_OFF = 136448;
constexpr int LDS_BYTES = 147456;

#define GAS __attribute__((address_space(1)))
#define LAS __attribute__((address_space(3)))
typedef unsigned short bf16;
typedef float f32x4 __attribute__((ext_vector_type(4)));
typedef float f32x16 __attribute__((ext_vector_type(16)));
typedef short bf16x8 __attribute__((ext_vector_type(8)));
typedef short s16x4 __attribute__((ext_vector_type(4)));
typedef unsigned u32x4 __attribute__((ext_vector_type(4)));
typedef unsigned u32x2 __attribute__((ext_vector_type(2)));

__device__ __forceinline__ unsigned f2bf(float f) { unsigned u = __builtin_bit_cast(unsigned, f); return (u + 0x7fffu + ((u >> 16) & 1u)) >> 16; }
__device__ __forceinline__ unsigned pk2(float lo, float hi) { return f2bf(lo) | (f2bf(hi) << 16); }
__device__ __forceinline__ float bf2f(unsigned b) { return __builtin_bit_cast(float, b << 16); }
__device__ __forceinline__ float wave_sum(float v) {
#pragma unroll
    for (int o = 1; o < 64; o <<= 1) v += __shfl_xor(v, o);
    return v;
}
namespace pg8 {
#define PG8_LAS __attribute__((address_space(3)))
typedef unsigned short bf16_t;
typedef short bf16x8 __attribute__((ext_vector_type(8)));
typedef float f32x4 __attribute__((ext_vector_type(4)));
typedef unsigned u32x4 __attribute__((ext_vector_type(4)));
constexpr int BM = 256, BK = 64, HALF = 128, HTB = HALF * BK * 2  , STAGE_BYTES = 8 * HTB, NXCD = 8, WGM = 8;

__host__ __device__ __forceinline__ int lds_byte(int r, int c) { const int st = (r >> 4) * 2 + (c >> 5), rr = r & 15, cc = c & 31, ob = rr * 64 + cc * 2; return st * 1024 + (ob ^ (((ob >> 9) & 1) << 5)); }
__host__ __device__ __forceinline__ void stage_rc(int b, int& R, int& C) { const int st = b / 1024, sb = b % 1024, swz = sb ^ (((sb >> 9) & 1) << 5); R = (st >> 1) * 16 + swz / 64; C = (st & 1) * 32 + (swz % 64) / 2; }
__host__ __device__ __forceinline__ int perm32(int rho) { const int n = rho >> 4, i = rho & 15; return 8 * (i >> 2) + 4 * n + (i & 3); }

struct Unit { int pm, pn; };
struct Gemm { const bf16_t* A; const bf16_t* Bt; int M, N, K; };

struct StaticOrder {
    int nM, nN, nwg, G, c;
    __host__ __device__ void init(int M, int N, int G_, int c_) { nM = M / BM; nN = N / BM; nwg = nM * nN; G = G_; c = c_; }
    __host__ __device__ bool next(int i, Unit& u) const {
        const long L = (long)i * G + c; if (L >= nwg) return false;
        int wgid = (int)L; { const int q = nwg / NXCD, r = nwg % NXCD, xcd = wgid % NXCD, off = wgid / NXCD; wgid = (xcd < r ? xcd * (q + 1) : r * (q + 1) + (xcd - r) * q) + off; }
        const int nig = WGM * nN, gid = wgid / nig, fm = gid * WGM, gsz = (nM - fm) < WGM ? (nM - fm) : WGM;
        u.pm = fm + ((wgid % nig) % gsz); u.pn = (wgid % nig) / gsz; return true;
    }
    __device__ __forceinline__ void a_ready(const Unit&) const {}
    __device__ __forceinline__ void done(const Unit&) const {}
};

__device__ __forceinline__ unsigned cvt_pk_bf16(float lo, float hi) { unsigned r; asm volatile("v_cvt_pk_bf16_f32 %0, %1, %2" : "=v"(r) : "v"(lo), "v"(hi)); return r; }
typedef float f32x2 __attribute__((ext_vector_type(2)));
struct EpiProj {
    static constexpr bool PERM = true, AFTER_DRAIN = false;
    bf16_t* O; int ldc; float qscale; float* kmp;
    __device__ __forceinline__ void operator()(const f32x4 (&acc)[2][2][4][2], const Unit& u, int wr, int wc, int fr, int fq) const {
        const int row0 = u.pm * BM + wr * 64 + fr, col0 = u.pn * BM + wc * 32 + 8 * fq;
        const float sc = (u.pn < 4 || (u.pn >= 12 && u.pn < 16)) ? qscale : 1.f;
#pragma unroll
        for (int ai = 0; ai < 2; ++ai)
#pragma unroll
            for (int m = 0; m < 4; ++m) { bf16_t* rowp = O + (size_t)(row0 + ai * HALF + m * 16) * ldc + col0;
#pragma unroll
                for (int bj = 0; bj < 2; ++bj) { const f32x4 v0 = acc[ai][bj][m][0] * sc, v1 = acc[ai][bj][m][1] * sc;
                    u32x4 w; w.x = cvt_pk_bf16(v0[0], v0[1]); w.y = cvt_pk_bf16(v0[2], v0[3]); w.z = cvt_pk_bf16(v1[0], v1[1]); w.w = cvt_pk_bf16(v1[2], v1[3]);
                    *(u32x4*)(rowp + bj * HALF) = w; } }
        if (u.pn >= 4 && u.pn < 8) {
            const int lane = fq * 16 + fr;
#pragma unroll
            for (int bj = 0; bj < 2; ++bj)
#pragma unroll
                for (int n = 0; n < 2; ++n) { f32x4 s = (acc[0][bj][0][n] + acc[0][bj][1][n]) + (acc[0][bj][2][n] + acc[0][bj][3][n]) + (acc[1][bj][0][n] + acc[1][bj][1][n]) + (acc[1][bj][2][n] + acc[1][bj][3][n]);
#pragma unroll
                    for (int i = 0; i < 4; ++i) { float v = s[i]; v += __shfl_xor(v, 1); v += __shfl_xor(v, 2); v += __shfl_xor(v, 4); v += __shfl_xor(v, 8); s[i] = v; }
                    if (fr == 0) { const int bh = (u.pm >> 4) * 8 + 2 * (u.pn - 4) + bj, blk = u.pm & 15;
                        *(f32x4*)(kmp + ((size_t)((bh * 16 + blk) * 2 + wr)) * 128 + wc * 32 + 8 * fq + 4 * n) = s; } }
            (void)lane;
        }
    }
};
struct EpiResid {
    static constexpr bool PERM = true, AFTER_DRAIN = false;
    const float* X; float* X1; int ldc;
    __device__ __forceinline__ void operator()(const f32x4 (&acc)[2][2][4][2], const Unit& u, int wr, int wc, int fr, int fq) const {
        const int row0 = u.pm * BM + wr * 64 + fr, col0 = u.pn * BM + wc * 32 + 8 * fq;
#pragma unroll
        for (int ai = 0; ai < 2; ++ai)
#pragma unroll
            for (int m = 0; m < 4; ++m) { const size_t off = (size_t)(row0 + ai * HALF + m * 16) * ldc + col0;
#pragma unroll
                for (int bj = 0; bj < 2; ++bj)
#pragma unroll
                    for (int n = 0; n < 2; ++n) { const f32x4 xv = *(const f32x4*)(X + off + bj * HALF + 4 * n); *(f32x4*)(X1 + off + bj * HALF + 4 * n) = xv + acc[ai][bj][m][n]; } }
    }
};
__device__ __forceinline__ float silu_mul(float g, float u) { return g * u * __builtin_amdgcn_rcpf(1.f + __builtin_amdgcn_exp2f(-1.4426950408889634f * g)); }
struct EpiSwiGLU {
    static constexpr bool PERM = true, AFTER_DRAIN = false;
    bf16_t* ACT;
    __device__ __forceinline__ void operator()(const f32x4 (&acc)[2][2][4][2], const Unit& u, int wr, int wc, int fr, int fq) const {
        const int row0 = u.pm * BM + wr * 64 + fr, col0 = (u.pn & 3) * 128 + wc * 32 + 8 * fq;
#pragma unroll
        for (int ai = 0; ai < 2; ++ai)
#pragma unroll
            for (int m = 0; m < 4; ++m) { const f32x4 g0 = acc[ai][0][m][0], g1 = acc[ai][0][m][1], u0 = acc[ai][1][m][0], u1 = acc[ai][1][m][1];
                u32x4 w; w.x = cvt_pk_bf16(silu_mul(g0[0], u0[0]), silu_mul(g0[1], u0[1])); w.y = cvt_pk_bf16(silu_mul(g0[2], u0[2]), silu_mul(g0[3], u0[3]));
                w.z = cvt_pk_bf16(silu_mul(g1[0], u1[0]), silu_mul(g1[1], u1[1])); w.w = cvt_pk_bf16(silu_mul(g1[2], u1[2]), silu_mul(g1[3], u1[3]));
                *(u32x4*)(ACT + (size_t)(row0 + ai * HALF + m * 16) * 512 + col0) = w; }
    }
};
struct EpiDown {
    static constexpr bool PERM = true, AFTER_DRAIN = false;
    bf16_t* Y; const int* rowinfo; const PG8_LAS int* rowend;
    __device__ __forceinline__ void operator()(const f32x4 (&acc)[2][2][4][2], const Unit& u, int wr, int wc, int fr, int fq) const {
        const int e = u.pn >> 3, rend = rowend[e];
        const int row0 = u.pm * BM + wr * 64 + fr, col0 = (u.pn & 7) * BM + wc * 32 + 8 * fq;
#pragma unroll
        for (int ai = 0; ai < 2; ++ai)
#pragma unroll
            for (int m = 0; m < 4; ++m) { const int pos = row0 + ai * HALF + m * 16;
                if (pos < rend) { const int pair = rowinfo[2 * pos]; const float wgt = __builtin_bit_cast(float, rowinfo[2 * pos + 1]);
                    bf16_t* rowp = Y + (size_t)pair * 2048 + col0;
#pragma unroll
                    for (int bj = 0; bj < 2; ++bj) { const f32x4 v0 = acc[ai][bj][m][0] * wgt, v1 = acc[ai][bj][m][1] * wgt;
                        u32x4 w; w.x = cvt_pk_bf16(v0[0], v0[1]); w.y = cvt_pk_bf16(v0[2], v0[3]); w.z = cvt_pk_bf16(v1[0], v1[1]); w.w = cvt_pk_bf16(v1[2], v1[3]);
                        *(u32x4*)(rowp + bj * HALF) = w; } } }
    }
};
struct MoeOrder {
    const PG8_LAS int* tab; int npn, total, G, c;
    __device__ __forceinline__ bool next(int i, Unit& u) const {
        const int L = i * G + c; if (L >= total) return false;
        const int tile = L / npn, pn = L - tile * npn; int e = 0;
#pragma unroll 4
        for (int j = 1; j < 32; ++j) e += (tab[j] <= tile) ? 1 : 0;
        u.pm = tab[40 + e] + (tile - tab[e]); u.pn = e * npn + pn; return true;
    }
    __device__ __forceinline__ void a_ready(const Unit&) const {}
    __device__ __forceinline__ void done(const Unit&) const {}
};

template <class Epi, class Sched, bool ALIGN_EPI = false, bool SP2 = false>
__device__ __forceinline__ void gemm_phase(PG8_LAS unsigned char* lds, const Gemm g, const Sched& S, const Epi& E) {
    const int tid = threadIdx.x, wid = __builtin_amdgcn_readfirstlane(tid >> 6), lane = tid & 63, wr = wid >> 2, wc = wid & 3, fr = lane & 15, fq = lane >> 4;
    const int K = g.K, nt = K / BK;
    unsigned voffA[2], voffB[2];
#pragma unroll
    for (int i = 0; i < 2; ++i) { int R, C; stage_rc(tid * 16 + i * 8192, R, C); const int Rb = Epi::PERM ? ((R & ~31) + perm32(R & 31)) : R;
        voffA[i] = (unsigned)(R * K + C) * 2u; voffB[i] = (unsigned)(Rb * K + C) * 2u; }
    const size_t kstep = (size_t)(BK * 2);
    const size_t hstep = (size_t)HALF * K * 2;
    const size_t tstep = 2 * hstep;
    const unsigned ldsw = (unsigned)wid * 1024u;
    const int aoff = lds_byte(wr * 64 + fr, fq * 8), boff = lds_byte(wc * 32 + fr, fq * 8);
#define PG8_SA(b, h) (((b) * 2 + (h)) * HTB)
#define PG8_SB(b, h) ((4 + (b) * 2 + (h)) * HTB)
#define PG8_STAGE(bufoff, gbase, voff) do { _Pragma("unroll") for (int _i = 0; _i < 2; ++_i) \
        __builtin_amdgcn_global_load_lds((const unsigned*)((const char*)(gbase) + (voff)[_i]), (PG8_LAS unsigned*)(lds + (bufoff) + ldsw + _i * 8192), 16, 0, 0); } while (0)
#define PG8_LDA(dst, b, h) do { _Pragma("unroll") for (int m = 0; m < 4; ++m) _Pragma("unroll") for (int k = 0; k < 2; ++k) dst[m][k] = *(const PG8_LAS bf16x8*)(lds + PG8_SA(b, h) + aoff + m * 2048 + k * 1024); } while (0)
#define PG8_LDB(dst, b, h) do { _Pragma("unroll") for (int n = 0; n < 2; ++n) _Pragma("unroll") for (int k = 0; k < 2; ++k) dst[n][k] = *(const PG8_LAS bf16x8*)(lds + PG8_SB(b, h) + boff + n * 2048 + k * 1024); } while (0)
#define PG8_MMA(ai, bj, At, Bt) do { __builtin_amdgcn_s_setprio(1); _Pragma("unroll") for (int m = 0; m < 4; ++m) _Pragma("unroll") for (int n = 0; n < 2; ++n) _Pragma("unroll") for (int k = 0; k < 2; ++k) \
        acc[ai][bj][m][n] = __builtin_amdgcn_mfma_f32_16x16x32_bf16(Bt[n][k], At[m][k], acc[ai][bj][m][n], 0, 0, 0); __builtin_amdgcn_s_setprio(0); } while (0)
#define PG8_WAIT_V(n) asm volatile("s_waitcnt vmcnt(" #n ")" ::: "memory")
#define PG8_WAIT_L(n) asm volatile("s_waitcnt lgkmcnt(" #n ")" ::: "memory")
#define PG8_BAR __builtin_amdgcn_s_barrier()
#define PG8_SCHED __builtin_amdgcn_sched_barrier(0)
    Unit cur, nxt; int ui = 0;
    if (!S.next(0, cur)) return;
    f32x4 acc[2][2][4][2];
#pragma unroll
    for (int a = 0; a < 2; ++a)
#pragma unroll
        for (int b = 0; b < 2; ++b)
#pragma unroll
            for (int m = 0; m < 4; ++m)
#pragma unroll
                for (int n = 0; n < 2; ++n) acc[a][b][m][n] = (f32x4){0.f, 0.f, 0.f, 0.f};
    bf16x8 At[4][2], B0[2][2], B1[2][2];
    const char* cA = (const char*)g.A + (size_t)cur.pm * tstep; const char* cB = (const char*)g.Bt + (size_t)cur.pn * tstep;
    S.a_ready(cur);
    if constexpr (SP2) {
        PG8_STAGE(PG8_SB(0, 0), cB, voffB); PG8_STAGE(PG8_SB(0, 1), cB + hstep, voffB); PG8_STAGE(PG8_SA(0, 0), cA, voffA); PG8_STAGE(PG8_SA(0, 1), cA + hstep, voffA);
        if (wr == 1) PG8_BAR;
        PG8_WAIT_V(2); PG8_BAR;
        PG8_STAGE(PG8_SB(1, 0), cB + kstep, voffB); PG8_STAGE(PG8_SA(1, 0), cA + kstep, voffA); PG8_STAGE(PG8_SB(1, 1), cB + hstep + kstep, voffB);
        PG8_WAIT_V(6); PG8_BAR;
    } else {
        PG8_STAGE(PG8_SB(0, 0), cB, voffB); PG8_STAGE(PG8_SA(0, 0), cA, voffA); PG8_STAGE(PG8_SB(0, 1), cB + hstep, voffB); PG8_STAGE(PG8_SA(0, 1), cA + hstep, voffA);
        if (wr == 1) PG8_BAR;
        PG8_WAIT_V(4); PG8_BAR;
        PG8_STAGE(PG8_SB(1, 0), cB + kstep, voffB); PG8_STAGE(PG8_SA(1, 0), cA + kstep, voffA); PG8_STAGE(PG8_SB(1, 1), cB + hstep + kstep, voffB);
        PG8_WAIT_V(6); PG8_BAR;
    }
    for (;;) {
        const bool has_next = S.next(ui + 1, nxt);
        const char* nA = has_next ? (const char*)g.A + (size_t)nxt.pm * tstep : cA; const char* nB = has_next ? (const char*)g.Bt + (size_t)nxt.pn * tstep : cB;
        for (int t = 0; t < nt; t += 2) {
            const bool last = (t == nt - 2);
            const char* a1 = cA + (size_t)(t + 1) * kstep;
            const char* a2 = last ? nA : cA + (size_t)(t + 2) * kstep; const char* b2 = last ? nB : cB + (size_t)(t + 2) * kstep;
            const char* a3 = a2 + kstep; const char* b3 = b2 + kstep;
            if (last && has_next) S.a_ready(nxt);
            if constexpr (SP2) {
            PG8_LDB(B0, 0, 0); PG8_LDB(B1, 0, 1); PG8_SCHED; PG8_LDA(At, 0, 0); PG8_STAGE(PG8_SA(1, 1), a1 + hstep, voffA);
            PG8_WAIT_V(8); PG8_WAIT_L(0); PG8_BAR; PG8_MMA(0, 0, At, B0); PG8_MMA(0, 1, At, B1); PG8_BAR; PG8_SCHED;
            PG8_LDA(At, 0, 1); PG8_STAGE(PG8_SB(0, 0), b2, voffB); PG8_STAGE(PG8_SB(0, 1), b2 + hstep, voffB); PG8_STAGE(PG8_SA(0, 0), a2, voffA);
            PG8_WAIT_V(8); PG8_WAIT_L(0); PG8_BAR; PG8_MMA(1, 0, At, B0); PG8_MMA(1, 1, At, B1); PG8_BAR; PG8_SCHED;
            PG8_LDB(B0, 1, 0); PG8_LDB(B1, 1, 1); PG8_SCHED; PG8_LDA(At, 1, 0); PG8_STAGE(PG8_SA(0, 1), a2 + hstep, voffA);
            PG8_WAIT_V(8); PG8_WAIT_L(0); PG8_BAR; PG8_MMA(0, 0, At, B0); PG8_MMA(0, 1, At, B1); PG8_BAR; PG8_SCHED;
            PG8_LDA(At, 1, 1); PG8_STAGE(PG8_SB(1, 0), b3, voffB); PG8_STAGE(PG8_SB(1, 1), b3 + hstep, voffB); PG8_STAGE(PG8_SA(1, 0), a3, voffA);
            PG8_WAIT_V(8); PG8_WAIT_L(0); PG8_BAR; PG8_MMA(1, 0, At, B0); PG8_MMA(1, 1, At, B1); PG8_BAR; PG8_SCHED;
            } else {
            PG8_LDB(B0, 0, 0); PG8_SCHED; PG8_LDA(At, 0, 0); PG8_STAGE(PG8_SA(1, 1), a1 + hstep, voffA);
            PG8_WAIT_L(8); PG8_BAR; PG8_WAIT_L(0); PG8_MMA(0, 0, At, B0); PG8_BAR; PG8_SCHED;
            PG8_LDB(B1, 0, 1); PG8_STAGE(PG8_SB(0, 0), b2, voffB);
            PG8_BAR; PG8_WAIT_L(0); PG8_MMA(0, 1, At, B1); PG8_BAR;
            PG8_LDA(At, 0, 1); PG8_STAGE(PG8_SA(0, 0), a2, voffA);
            PG8_BAR; PG8_WAIT_L(0); PG8_MMA(1, 0, At, B0); PG8_BAR; PG8_SCHED;
            PG8_STAGE(PG8_SB(0, 1), b2 + hstep, voffB);
            PG8_WAIT_V(6); PG8_BAR; PG8_MMA(1, 1, At, B1); PG8_BAR;
            PG8_LDB(B0, 1, 0); PG8_SCHED; PG8_LDA(At, 1, 0); PG8_STAGE(PG8_SA(0, 1), a2 + hstep, voffA);
            PG8_WAIT_L(8); PG8_BAR; PG8_WAIT_L(0); PG8_MMA(0, 0, At, B0); PG8_BAR; PG8_SCHED;
            PG8_LDB(B1, 1, 1); PG8_STAGE(PG8_SB(1, 0), b3, voffB);
            PG8_BAR; PG8_WAIT_L(0); PG8_MMA(0, 1, At, B1); PG8_BAR;
            PG8_LDA(At, 1, 1); PG8_STAGE(PG8_SA(1, 0), a3, voffA);
            PG8_BAR; PG8_WAIT_L(0); PG8_MMA(1, 0, At, B0); PG8_BAR; PG8_SCHED;
            PG8_STAGE(PG8_SB(1, 1), b3 + hstep, voffB);
            PG8_WAIT_V(6); PG8_BAR; PG8_MMA(1, 1, At, B1); PG8_BAR;
            }
        }
        if constexpr (ALIGN_EPI) { if (wr == 0) PG8_BAR; }
        if constexpr (!Epi::AFTER_DRAIN) { E(acc, cur, wr, wc, fr, fq); S.done(cur); }
        if (!has_next) break;
#pragma unroll
        for (int a = 0; a < 2; ++a)
#pragma unroll
            for (int b = 0; b < 2; ++b)
#pragma unroll
                for (int m = 0; m < 4; ++m)
#pragma unroll
                    for (int n = 0; n < 2; ++n) acc[a][b][m][n] = (f32x4){0.f, 0.f, 0.f, 0.f};
        cur = nxt; cA = nA; cB = nB; ++ui;
        if constexpr (ALIGN_EPI) { if (wr == 1) PG8_BAR; }
    }
    PG8_WAIT_V(0);
    if constexpr (!ALIGN_EPI) { if (wr == 0) PG8_BAR; }
    PG8_BAR;
    if constexpr (Epi::AFTER_DRAIN) { E.fused(acc, cur, wr, wc, fr, fq, lds, wid, lane); S.done(cur); }
#undef PG8_SA
#undef PG8_SB
#undef PG8_STAGE
#undef PG8_LDA
#undef PG8_LDB
#undef PG8_MMA
#undef PG8_WAIT_V
#undef PG8_WAIT_L
#undef PG8_BAR
#undef PG8_SCHED
}
}
#define XB_TMO      128
#define XB_XCNT(j)  (256  + 64 * (j))
#define XB_XSUB(j)  (1280 + 64 * (j))
#define XB_XGEN(j)  (2304 + 64 * (j))
#define XB_TOP      3328
#define XB_TOPGEN   3392
#define XCD_BAR_WORDS 3456
#define XB_SPIN_CAP (1u << 18)

__device__ __forceinline__ unsigned xb_ld(unsigned* p)              { return __hip_atomic_load(p, __ATOMIC_RELAXED, __HIP_MEMORY_SCOPE_AGENT); }
__device__ __forceinline__ unsigned xb_add(unsigned* p, unsigned v) { return __hip_atomic_fetch_add(p, v, __ATOMIC_RELAXED, __HIP_MEMORY_SCOPE_AGENT); }
__device__ __forceinline__ unsigned xb_xcc_id() { return (unsigned)__builtin_amdgcn_s_getreg((3 << 11) | 20) & 0xFu; }
#define XB_SPIN(cond, bar) do { unsigned _sp = 0; while (cond) { __builtin_amdgcn_s_sleep(1); \
    if ((++_sp & 255u) == 0u) { if (xb_ld(&(bar)[XB_TMO])) break; if (_sp > XB_SPIN_CAP) { atomicAdd(&(bar)[XB_TMO], 1u); break; } } } } while (0)

struct XcdBarrier {
    unsigned* bar; unsigned x;
    volatile LAS unsigned* st;
};

__device__ __forceinline__ XcdBarrier xcd_barrier_post(unsigned* bar, volatile LAS unsigned* st) {
    XcdBarrier b; b.bar = bar; b.x = xb_xcc_id(); b.st = st;
    if (threadIdx.x == 0) (void)xb_add(&bar[XB_XCNT(b.x)], 1u);
    return b;
}
__device__ __forceinline__ void xcd_barrier_complete(unsigned* bar, unsigned x, unsigned& nloc, unsigned& nx) {
    const unsigned G = gridDim.x * gridDim.y * gridDim.z;
    unsigned sum, cnt, mine, sp = 0u;
    for (;;) {
        sum = 0u; cnt = 0u; mine = 0u;
#pragma unroll
        for (unsigned j = 0; j < 16; ++j) { const unsigned c = xb_ld(&bar[XB_XCNT(j)]); sum += c; cnt += (c > 0u) ? 1u : 0u; mine = (j == x) ? c : mine; }
        if (sum == G) break;
        __builtin_amdgcn_s_sleep(1);
        if ((++sp & 255u) == 0u) { if (xb_ld(&bar[XB_TMO])) break; if (sp > XB_SPIN_CAP) { atomicAdd(&bar[XB_TMO], 1u); break; } }
    }
    nloc = mine > 0u ? mine : 1u; nx = cnt > 0u ? cnt : 1u;
}

__device__ __forceinline__ void xcd_barrier(const XcdBarrier& b) {
    asm volatile("s_waitcnt vmcnt(0)" ::: "memory");
    __syncthreads();
    if (threadIdx.x == 0) {
        unsigned* bar = b.bar;
        __builtin_amdgcn_s_waitcnt(0);
        unsigned nloc = b.st[0], nx = b.st[1];
        if (nloc == 0u) { xcd_barrier_complete(bar, b.x, nloc, nx); b.st[0] = nloc; b.st[1] = nx; }
        const unsigned old = xb_add(&bar[XB_XSUB(b.x)], 1u);
        const unsigned gen = old / nloc;
        if (old + 1u == (gen + 1u) * nloc) {
            __builtin_amdgcn_fence(__ATOMIC_RELEASE, "agent");
            asm volatile("s_waitcnt vmcnt(0)" ::: "memory");
            const unsigned og = xb_add(&bar[XB_TOP], 1u);
            const unsigned tg = og / nx;
            if (og + 1u == (tg + 1u) * nx) xb_add(&bar[XB_TOPGEN], 1u);
            else XB_SPIN(xb_ld(&bar[XB_TOPGEN]) == tg, bar);
            __builtin_amdgcn_fence(__ATOMIC_ACQUIRE, "agent");
            xb_add(&bar[XB_XGEN(b.x)], 1u);
            asm volatile("s_waitcnt vmcnt(0)" ::: "memory");
        } else {
            XB_SPIN(xb_ld(&bar[XB_XGEN(b.x)]) == gen, bar);
            __builtin_amdgcn_fence(__ATOMIC_ACQUIRE, "agent");
            asm volatile("s_waitcnt vmcnt(0)" ::: "memory");
        }
    }
    __syncthreads();
}

namespace att {
constexpr int PITCH = NIN;
constexpr int STAGE = 65536, SUB = 16384;
typedef short v4i16_t __attribute__((ext_vector_type(4)));
constexpr float THR2 = 11.5f;
constexpr float PSKIP = -140.f;
#define KSWZ(row, colB) ((row) * 256 + ((colB) ^ (((row) & 7) << 4)))
#define SBAR() __builtin_amdgcn_sched_barrier(0)
__device__ __forceinline__ int v_rd_base(int lane) { return ((lane & 3) << 3) | (((lane >> 2) & 3) << 6) | (((lane >> 4) & 1) << 5) | (((lane >> 5) & 1) << 8); }
constexpr int v_rd_off(int d0, int ks, int half) { return d0 * 512 + ks * 4096 + half * 2048; }
__device__ __forceinline__ int crow(int r, int hi) { return (r & 3) + 8 * (r >> 2) + 4 * hi; }
__device__ __forceinline__ unsigned cvtpk(float lo, float hi) { unsigned r; asm volatile("v_cvt_pk_bf16_f32 %0, %1, %2" : "=v"(r) : "v"(lo), "v"(hi)); return r; }

__device__ __forceinline__ void qkt(f32x16& p0, f32x16& p1, const LAS unsigned char* Ks, int r32, int hi, const bf16x8* qr) {
    const LAS unsigned char* kb[4];
#pragma unroll
    for (int dd = 0; dd < 4; ++dd) kb[dd] = Ks + KSWZ(r32, (dd * 16 + hi * 8) * 2);
#pragma unroll
    for (int d0 = 0; d0 < 8; ++d0) { const LAS unsigned char* a = kb[d0 & 3] + (d0 >> 2) * 128;
        const bf16x8 b0 = *(const LAS bf16x8*)a;
        const bf16x8 b1 = *(const LAS bf16x8*)(a + 32 * 256);
        p0 = __builtin_amdgcn_mfma_f32_32x32x16_bf16(b0, qr[d0], p0, 0, 0, 0);
        p1 = __builtin_amdgcn_mfma_f32_32x32x16_bf16(b1, qr[d0], p1, 0, 0, 0); }
}
__device__ __forceinline__ void pv_tile(f32x16* o, unsigned vb0, bf16x8 pa0, bf16x8 pa1, bf16x8 pa2, bf16x8 pa3) {
#define TRRD(dst, off) asm volatile("ds_read_b64_tr_b16 %0, %1 offset:%2" : "=&v"(dst) : "v"(vb0), "i"(off) : "memory")
#define PV_D0(d0) do { s16x4 l0, l1, l2, l3, h0, h1, h2, h3; constexpr int b_ = v_rd_off(d0, 0, 0); \
        TRRD(l0, b_); TRRD(h0, b_ + 2048); TRRD(l1, b_ + 4096); TRRD(h1, b_ + 6144); TRRD(l2, b_ + 8192); TRRD(h2, b_ + 10240); TRRD(l3, b_ + 12288); TRRD(h3, b_ + 14336); \
        asm volatile("s_waitcnt lgkmcnt(0)" ::: "memory"); SBAR(); \
        o[d0] = __builtin_amdgcn_mfma_f32_32x32x16_bf16(pa0, (bf16x8){l0[0], l0[1], l0[2], l0[3], h0[0], h0[1], h0[2], h0[3]}, o[d0], 0, 0, 0); \
        o[d0] = __builtin_amdgcn_mfma_f32_32x32x16_bf16(pa1, (bf16x8){l1[0], l1[1], l1[2], l1[3], h1[0], h1[1], h1[2], h1[3]}, o[d0], 0, 0, 0); \
        o[d0] = __builtin_amdgcn_mfma_f32_32x32x16_bf16(pa2, (bf16x8){l2[0], l2[1], l2[2], l2[3], h2[0], h2[1], h2[2], h2[3]}, o[d0], 0, 0, 0); \
        o[d0] = __builtin_amdgcn_mfma_f32_32x32x16_bf16(pa3, (bf16x8){l3[0], l3[1], l3[2], l3[3], h3[0], h3[1], h3[2], h3[3]}, o[d0], 0, 0, 0); } while (0)
    PV_D0(0); PV_D0(1); PV_D0(2); PV_D0(3);
#undef PV_D0
#undef TRRD
}
__device__ __forceinline__ void glds16(const bf16* g, LAS unsigned char* l) {
    __builtin_amdgcn_global_load_lds((const unsigned*)g, (LAS unsigned*)l, 16, 0, 0);
}

template <int DIFF, int HF>
__device__ __forceinline__ void half_step(f32x16* o, float& m_reg, float& l_reg, const bf16x8* qr, const LAS unsigned char* Kst, unsigned vb0, LAS float* al_l,
                                          int kbh, int q0, int r32, int hi, float slope2, bool selbit, int pmode = 0) {
    constexpr int NO = DIFF ? 8 : 4;
    if (kbh > q0 + 31) return;
    float binit = slope2 * (float)(kbh - (q0 + r32) + 4 * hi);
    if (!selbit) binit = -__builtin_inff();
    f32x16 p;
#pragma unroll
    for (int r = 0; r < 16; ++r) p[r] = fmaf(slope2, (float)((r & 3) + 8 * (r >> 2)), binit);
    if (!(pmode & 16)) {
        const LAS unsigned char* kb4[4];
#pragma unroll
        for (int dd = 0; dd < 4; ++dd) kb4[dd] = Kst + KSWZ(r32, (dd * 16 + hi * 8) * 2) + HF * 8192;
        if (DIFF) {
            bf16x8 kf[4];
#pragma unroll
            for (int d0 = 0; d0 < 4; ++d0) kf[d0] = *(const LAS bf16x8*)(kb4[d0]);
            SBAR();
#pragma unroll
            for (int d0 = 0; d0 < 4; ++d0) { p = __builtin_amdgcn_mfma_f32_32x32x16_bf16(kf[d0], qr[d0], p, 0, 0, 0); kf[d0] = *(const LAS bf16x8*)(kb4[d0] + 128); }
            SBAR();
#pragma unroll
            for (int d0 = 0; d0 < 4; ++d0) p = __builtin_amdgcn_mfma_f32_32x32x16_bf16(kf[d0], qr[4 + d0], p, 0, 0, 0);
        } else {
            bf16x8 kf[8];
#pragma unroll
            for (int d0 = 0; d0 < 8; ++d0) kf[d0] = *(const LAS bf16x8*)(kb4[d0 & 3] + (d0 >> 2) * 128);
            SBAR();
#pragma unroll
            for (int d0 = 0; d0 < 8; ++d0) p = __builtin_amdgcn_mfma_f32_32x32x16_bf16(kf[d0], qr[d0], p, 0, 0, 0);
        }
    }
    if (kbh + 31 > q0) {
        const int dq = q0 + r32 - kbh - 4 * hi; const float NEG = -__builtin_inff();
#pragma unroll
        for (int r = 0; r < 16; ++r) { const int c = (r & 3) + 8 * (r >> 2); if (c > dq) p[r] = NEG; }
    }
    float pmax = p[0];
#pragma unroll
    for (int r = 1; r < 16; ++r) pmax = fmaxf(pmax, p[r]);
    { auto rr = __builtin_amdgcn_permlane32_swap(__float_as_uint(pmax), __float_as_uint(pmax), false, false); pmax = fmaxf(__uint_as_float(rr[0]), __uint_as_float(rr[1])); }
    if (__all(pmax - m_reg < PSKIP)) return;
    float mn, alpha;
    if (__all(pmax - m_reg <= THR2)) { mn = m_reg; alpha = 1.f; }
    else { mn = fmaxf(m_reg, pmax); alpha = __builtin_amdgcn_exp2f(m_reg - mn); m_reg = mn; }
    float ps = 0.f;
    if (!(pmode & 8)) {
#pragma unroll
    for (int r = 0; r < 16; ++r) p[r] = __builtin_amdgcn_exp2f(p[r] - mn);
#pragma unroll
    for (int r = 0; r < 16; ++r) ps += p[r];
    }
    { auto rr = __builtin_amdgcn_permlane32_swap(__float_as_uint(ps), __float_as_uint(ps), false, false); ps = __uint_as_float(rr[0]) + __uint_as_float(rr[1]); }
    l_reg = l_reg * alpha + ps;
    bf16x8 pa0, pa1;
#define PK4(P, B_, OUT) do { unsigned a0 = cvtpk(P[B_ + 0], P[B_ + 1]), a1 = cvtpk(P[B_ + 2], P[B_ + 3]); \
        unsigned b0 = cvtpk(P[B_ + 4], P[B_ + 5]), b1 = cvtpk(P[B_ + 6], P[B_ + 7]); \
        auto r0 = __builtin_amdgcn_permlane32_swap(a0, b0, false, false); auto r1 = __builtin_amdgcn_permlane32_swap(a1, b1, false, false); \
        u32x4 w = {r0[0], r1[0], r0[1], r1[1]}; OUT = __builtin_bit_cast(bf16x8, w); } while (0)
    PK4(p, 0, pa0); PK4(p, 8, pa1);
#undef PK4
    if (__any(alpha < 1.f)) {
        if (hi == 0) al_l[r32] = alpha;
        asm volatile("s_waitcnt lgkmcnt(0)" ::: "memory");
#pragma unroll
        for (int r = 0; r < 16; ++r) { const float a = al_l[crow(r, hi)];
#pragma unroll
            for (int d = 0; d < NO; ++d) o[d][r] *= a; }
    }
    if (!(pmode & 4)) {
        const LAS unsigned char* vp = (const LAS unsigned char*)(uintptr_t)vb0;
#define VTR(off) __builtin_bit_cast(s16x4, __builtin_amdgcn_ds_read_tr16_b64_v4i16((LAS v4i16_t*)(vp + (off))))
#define GOFF(g) (((g) >> 2) * SUB + v_rd_off((g) & 3, 2 * HF, 0))
#define LOADG(V, g) do { V[0] = VTR(GOFF(g)); V[1] = VTR(GOFF(g) + 2048); V[2] = VTR(GOFF(g) + 4096); V[3] = VTR(GOFF(g) + 6144); } while (0)
#define MMAG(V, g) do { o[g] = __builtin_amdgcn_mfma_f32_32x32x16_bf16(pa0, (bf16x8){V[0][0], V[0][1], V[0][2], V[0][3], V[1][0], V[1][1], V[1][2], V[1][3]}, o[g], 0, 0, 0); \
                        o[g] = __builtin_amdgcn_mfma_f32_32x32x16_bf16(pa1, (bf16x8){V[2][0], V[2][1], V[2][2], V[2][3], V[3][0], V[3][1], V[3][2], V[3][3]}, o[g], 0, 0, 0); } while (0)
        s16x4 va[4], vc[4];
        LOADG(va, 0); LOADG(vc, 1); SBAR();
        MMAG(va, 0); LOADG(va, 2); SBAR();
        MMAG(vc, 1); LOADG(vc, 3); SBAR();
        if (DIFF) {
            MMAG(va, 2); LOADG(va, 4); SBAR();
            MMAG(vc, 3); LOADG(vc, 5); SBAR();
            MMAG(va, 4); LOADG(va, 6); SBAR();
            MMAG(vc, 5); LOADG(vc, 7); SBAR();
            MMAG(va, 6); SBAR();
            MMAG(vc, 7);
        } else {
            MMAG(va, 2); SBAR();
            MMAG(vc, 3);
        }
#undef MMAG
#undef LOADG
#undef GOFF
#undef VTR
    }
}

template <int DIFF>
__device__ __forceinline__ void attn_unit(LAS unsigned char* lds, const bf16* __restrict__ proj, bf16* __restrict__ mixed, const float* __restrict__ kmp,
                                          int b, int h, int idx, float lam, const float* __restrict__ subw, int pmode = 0) {
    constexpr int NO = DIFF ? 8 : 4;
    const int tid = threadIdx.x, lane = tid & 63, wid = __builtin_amdgcn_readfirstlane(tid >> 6), r32 = lane & 31, hi = lane >> 5;
    const int rg = wid & 3, comp = wid >> 2;
    const int q0 = DIFF ? (128 * idx + 32 * rg) : (256 * idx + 32 * wid);
    const size_t rowbase = (size_t)b * SEQ;
    const int qcol = DIFF ? (3072 + 256 * h + 128 * comp) : (128 * h);
    const int kcol = DIFF ? (4096 + 256 * h) : (1024 + 128 * h);
    const int vcol = DIFF ? (5120 + 256 * h) : (2048 + 128 * h);
    const float slope2 = (DIFF ? __builtin_amdgcn_exp2f(-2.f * (float)(h + 1)) : __builtin_amdgcn_exp2f(-(float)(h + 1))) * LOG2E;
    const int NT = DIFF ? 2 * (idx + 1) : 4 * (idx + 1);
    int koff, voff;
    { const int row = 4 * wid + (lane >> 4), ch = (lane & 15) ^ (row & 7); koff = row * PITCH + 8 * ch;
      const int sub = 2 * wid + (lane >> 5), kk = 8 * (sub >> 2) + ((lane & 31) >> 2), k = (kk & ~0xC) | ((kk & 4) << 1) | ((kk & 8) >> 1), c = 32 * (sub & 3) + 8 * (lane & 3);
      voff = k * PITCH + c; }
    LAS unsigned char* const dst0 = lds + wid * 1024;
#define ISSUE_TILE(st, kb_) do { const bf16* g_ = proj + (rowbase + (size_t)(kb_)) * PITCH; LAS unsigned char* d_ = dst0 + (st) * STAGE; \
        _Pragma("unroll") for (int i_ = 0; i_ < 2; ++i_) { \
            glds16(g_ + kcol + koff + i_ * 32 * PITCH, d_ + i_ * 8192); \
            if (DIFF) { glds16(g_ + kcol + 128 + koff + i_ * 32 * PITCH, d_ + SUB + i_ * 8192); \
                        glds16(g_ + vcol + voff + i_ * 32 * PITCH, d_ + 2 * SUB + i_ * 8192); \
                        glds16(g_ + vcol + 128 + voff + i_ * 32 * PITCH, d_ + 3 * SUB + i_ * 8192); } \
            else { glds16(g_ + vcol + voff + i_ * 32 * PITCH, d_ + SUB + i_ * 8192); } } } while (0)
#define TILE_KB(t_) (DIFF ? 64 * (NT - 1 - (t_)) : ((t_) < 4 ? 256 * idx + 64 * (3 - (t_)) : 256 * (idx - 1 - (((t_) - 4) >> 2)) + 64 * (3 - (((t_) - 4) & 3))))
    ISSUE_TILE(0, TILE_KB(0));
    if (!DIFF && idx > 0) {
        const int row = tid >> 4, ch = tid & 15; u32x4 w = {0u, 0u, 0u, 0u};
        if (row < 16) { const float* s0 = kmp + ((size_t)((b * 8 + h) * 16 + row) * 2) * 128 + 8 * ch;
            const f32x4 a0 = *(const f32x4*)s0, a1 = *(const f32x4*)(s0 + 4), b0 = *(const f32x4*)(s0 + 128), b1 = *(const f32x4*)(s0 + 132);
            const f32x4 m0 = (a0 + b0) * (1.f / 256.f), m1 = (a1 + b1) * (1.f / 256.f);
            w.x = cvtpk(m0[0], m0[1]); w.y = cvtpk(m0[2], m0[3]); w.z = cvtpk(m1[0], m1[1]); w.w = cvtpk(m1[2], m1[3]); }
        *(LAS u32x4*)(lds + STAGE + KSWZ(row, 16 * ch)) = w;
    }
    bf16x8 qr[8];
    { const bf16* qp = proj + (rowbase + q0 + r32) * PITCH + qcol + hi * 8;
#pragma unroll
      for (int d0 = 0; d0 < 8; ++d0) qr[d0] = *(const bf16x8*)(qp + d0 * 16); }
    LAS float* const al_l = (LAS float*)(lds + ATT_SCR_OFF + wid * 512);
    LAS float* const li_l = al_l + 32;
    unsigned sel = 0u;
    if (!DIFF && idx > 0) {
        asm volatile("s_waitcnt vmcnt(0)" ::: "memory"); __syncthreads();
        f32x16 g = {};
        { const LAS unsigned char* Ks = lds + STAGE;
#pragma unroll
          for (int d0 = 0; d0 < 8; ++d0) { const LAS unsigned char* a = Ks + KSWZ(r32, ((d0 & 3) * 16 + hi * 8) * 2) + (d0 >> 2) * 128;
              g = __builtin_amdgcn_mfma_f32_32x32x16_bf16(*(const LAS bf16x8*)a, qr[d0], g, 0, 0, 0); } }
        float gv[16]; int gn[16];
#pragma unroll
        for (int r = 0; r < 8; ++r) { const int nb = (r & 3) + 8 * (r >> 2);
            gv[r] = g[r]; gn[r] = nb + 4 * hi; gv[8 + r] = __shfl_xor(g[r], 32); gn[8 + r] = nb + 4 * (1 - hi); }
        const float NEG = -__builtin_inff();
        float m1 = NEG, m2 = NEG, m3 = NEG;
#pragma unroll
        for (int i = 0; i < 16; ++i) { float v = gn[i] < idx ? gv[i] : NEG;
            float t1 = fmaxf(m1, v); v = fminf(m1, v); m1 = t1; float t2 = fmaxf(m2, v); v = fminf(m2, v); m2 = t2; m3 = fmaxf(m3, v); }
#pragma unroll
        for (int i = 0; i < 16; ++i) if (gn[i] < idx && gv[i] >= m3) sel |= 1u << gn[i];
    }
    float m_reg = -1e30f, l_reg = 0.f;
    f32x16 o[NO];
#pragma unroll
    for (int d = 0; d < NO; ++d) o[d] = f32x16{};
    const unsigned ldsu = (unsigned)(uintptr_t)lds;
    const int ksub = DIFF ? comp : 0;
    for (int t = 0; t < NT; ++t) {
        asm volatile("s_waitcnt vmcnt(0)" ::: "memory"); __syncthreads();
        if (t + 1 < NT && !(pmode & 1)) ISSUE_TILE((t + 1) & 1, TILE_KB(t + 1));
        const int kb = TILE_KB(t);
        const bool past = !DIFF && t >= 4;
        const bool selbit = past ? (((sel >> (idx - 1 - ((t - 4) >> 2))) & 1u) != 0u) : true;
        const int stoff = (t & 1) * STAGE;
        const LAS unsigned char* Kst = lds + stoff + ksub * SUB;
        const unsigned vb0 = ldsu + stoff + (DIFF ? 2 : 1) * SUB + v_rd_base(lane);
        if (!(pmode & 2)) {
        half_step<DIFF, 1>(o, m_reg, l_reg, qr, Kst, vb0, al_l, kb + 32, q0, r32, hi, slope2, selbit, pmode);
        half_step<DIFF, 0>(o, m_reg, l_reg, qr, Kst, vb0, al_l, kb, q0, r32, hi, slope2, selbit, pmode);
        }
    }
    if (hi == 0) li_l[r32] = l_reg;
    asm volatile("s_waitcnt lgkmcnt(0)" ::: "memory");
    float rli[16];
#pragma unroll
    for (int r = 0; r < 16; ++r) rli[r] = __builtin_amdgcn_rcpf(li_l[crow(r, hi)]);
    if (!DIFF) {
        bf16* Ow = mixed + (rowbase + q0) * D + 128 * h;
#pragma unroll
        for (int r = 0; r < 16; ++r) { const int orow = crow(r, hi);
#pragma unroll
            for (int d0 = 0; d0 < 4; ++d0) { const float v = o[d0][r] * rli[r]; const float vn = __shfl_xor(v, 1);
                if ((r32 & 1) == 0) *(unsigned*)(Ow + (size_t)orow * D + d0 * 32 + r32) = cvtpk(v, vn); } }
        __syncthreads();
    } else {
        __syncthreads();
        LAS float* xb = (LAS float*)(lds + rg * 32768) + lane;
        if (comp == 1) {
#pragma unroll
            for (int d0 = 0; d0 < 8; ++d0)
#pragma unroll
                for (int r = 0; r < 16; ++r) xb[(d0 * 16 + r) * 64] = lam * o[d0][r] * rli[r];
        }
        __syncthreads();
        if (comp == 0) {
            float ssq[16];
#pragma unroll
            for (int r = 0; r < 16; ++r) ssq[r] = 0.f;
#pragma unroll
            for (int d0 = 0; d0 < 8; ++d0)
#pragma unroll
                for (int r = 0; r < 16; ++r) { const float dv = o[d0][r] * rli[r] - xb[(d0 * 16 + r) * 64]; o[d0][r] = dv; ssq[r] += dv * dv; }
#pragma unroll
            for (int r = 0; r < 16; ++r) { float s = ssq[r]; s += __shfl_xor(s, 1); s += __shfl_xor(s, 2); s += __shfl_xor(s, 4); s += __shfl_xor(s, 8); s += __shfl_xor(s, 16);
                ssq[r] = __builtin_amdgcn_rsqf(s * (1.f / 256.f) + RMS_EPS) * 0.8f; }
            bf16* Ow = mixed + (rowbase + q0) * D + 1024 + 256 * h;
#pragma unroll
            for (int d0 = 0; d0 < 8; ++d0) { const float wv = subw[d0 * 32 + r32];
#pragma unroll
                for (int r = 0; r < 16; ++r) { const float v = o[d0][r] * ssq[r] * wv; const float vn = __shfl_xor(v, 1);
                    if ((r32 & 1) == 0) *(unsigned*)(Ow + (size_t)crow(r, hi) * D + d0 * 32 + r32) = cvtpk(v, vn); } }
        }
        __syncthreads();
    }
#undef ISSUE_TILE
#undef TILE_KB
}

#undef KSWZ
#undef SBAR
}

__device__ __forceinline__ void tr_item(const float* __restrict__ W, int N, int K, int k0, int n0, bf16* __restrict__ dst, LAS unsigned* scr, int lane) {
    { const int kr = lane >> 4, nc = (lane & 15) * 4;
      f32x4 v[16];
#pragma unroll
      for (int i = 0; i < 16; ++i) v[i] = *(const f32x4*)(W + (size_t)(k0 + 4 * i + kr) * N + n0 + nc);
#pragma unroll
      for (int i = 0; i < 16; ++i) { const int k = 4 * i + kr; scr[k * 33 + (nc >> 1)] = pk2(v[i][0], v[i][1]); scr[k * 33 + (nc >> 1) + 1] = pk2(v[i][2], v[i][3]); } }
    asm volatile("s_waitcnt lgkmcnt(0)" ::: "memory");
    { const int np = lane >> 3, c = lane & 7;
#pragma unroll
      for (int j = 0; j < 4; ++j) { const int n2 = np + 8 * j; unsigned d[8];
#pragma unroll
          for (int i = 0; i < 8; ++i) d[i] = scr[(8 * c + i) * 33 + n2];
          u32x4 lo, hi;
          lo.x = (d[0] & 0xffffu) | (d[1] << 16); lo.y = (d[2] & 0xffffu) | (d[3] << 16); lo.z = (d[4] & 0xffffu) | (d[5] << 16); lo.w = (d[6] & 0xffffu) | (d[7] << 16);
          hi.x = (d[0] >> 16) | (d[1] & 0xffff0000u); hi.y = (d[2] >> 16) | (d[3] & 0xffff0000u); hi.z = (d[4] >> 16) | (d[5] & 0xffff0000u); hi.w = (d[6] >> 16) | (d[7] & 0xffff0000u);
          *(u32x4*)(dst + (size_t)(2 * n2) * K + k0 + 8 * c) = lo;
          *(u32x4*)(dst + (size_t)(2 * n2 + 1) * K + k0 + 8 * c) = hi; } }
    asm volatile("s_waitcnt lgkmcnt(0)" ::: "memory");
}
__device__ __forceinline__ void rms_row_to_bf16(const float* __restrict__ xrow, const float* __restrict__ w, bf16* __restrict__ orow, int lane) {
    const f32x4* xr = (const f32x4*)xrow + lane; const f32x4* wr = (const f32x4*)w + lane;
    f32x4 v[8]; float s = 0.f;
#pragma unroll
    for (int j = 0; j < 8; ++j) { v[j] = xr[64 * j]; s += (v[j][0] * v[j][0] + v[j][1] * v[j][1]) + (v[j][2] * v[j][2] + v[j][3] * v[j][3]); }
    const float rstd = __builtin_amdgcn_rsqf(wave_sum(s) * (1.f / D) + RMS_EPS);
    u32x2* o8 = (u32x2*)orow + lane;
#pragma unroll
    for (int j = 0; j < 8; ++j) { const f32x4 ww = wr[64 * j]; u32x2 p; p.x = pk2(v[j][0] * rstd * ww[0], v[j][1] * rstd * ww[1]); p.y = pk2(v[j][2] * rstd * ww[2], v[j][3] * rstd * ww[3]); o8[64 * j] = p; }
}


struct Args { const float* in[18]; float* out; unsigned char* ws; int ph_lo, ph_hi, li, pad; };
__global__ void __launch_bounds__(NWAVES * 64, 2) trunk_fwd(Args args) {
    extern __shared__ __attribute__((aligned(16))) unsigned char lds_raw[];
    LAS unsigned char* const lds = (LAS unsigned char*)lds_raw;
    volatile LAS unsigned* const MISC = (volatile LAS unsigned*)(lds + MISC_OFF);
    const int tid = threadIdx.x, lane = tid & 63, wave = __builtin_amdgcn_readfirstlane(tid >> 6);
    const int G = gridDim.x, bx = blockIdx.x;
    const int gw = bx * NWAVES + wave, NGW = G * NWAVES;
    unsigned char* const ws = args.ws;
    unsigned* const ctl = (unsigned*)(ws + WS_CTL);
    const float* const x = args.in[0];
    bf16* const WinT = (bf16*)(ws + WS_WIN); bf16* const WoutT = (bf16*)(ws + WS_WOUT); bf16* const Hb = (bf16*)(ws + WS_H);
    bf16* const WguT = (bf16*)(ws + WS_WGU); bf16* const WdT = (bf16*)(ws + WS_WD);
    bf16* const PROJ = (bf16*)(ws + WS_PROJ); bf16* const XP = (bf16*)(ws + WS_XP); bf16* const MIX = (bf16*)(ws + WS_MIX); bf16* const ACT = (bf16*)(ws + WS_ACT);
    float* const X1 = (float*)(ws + WS_X1); bf16* const Y = (bf16*)(ws + WS_Y);
    float* const KMP = (float*)(ws + WS_KMEAN); u32x4* const TOKINFO = (u32x4*)(ws + WS_TOKINFO); float* const TOKRSTD = (float*)(ws + WS_TOKRSTD);
    int* const ROWINFO = (int*)(ws + WS_ROWINFO); bf16* const WRHI = (bf16*)(ws + WS_WRHI); bf16* const WRLO = (bf16*)(ws + WS_WRLO);

    for (int u = tid; u < (LDS_BYTES - ATT_SCR_OFF) / 4; u += NWAVES * 64) ((LAS unsigned*)(lds + ATT_SCR_OFF))[u] = 0u;
    __syncthreads();
    const int lo = args.ph_lo, hi_ph = args.ph_hi;
    XcdBarrier bar; bar.bar = ctl + CW_BAR + args.li * XCD_BAR_WORDS; bar.x = 0; bar.st = nullptr;
    if (hi_ph - lo > 1) bar = xcd_barrier_post(ctl + CW_BAR + args.li * XCD_BAR_WORDS, MISC + 8);
#define GRID_BAR() xcd_barrier(bar)
#if defined(PROBE_DUP)
    const int POFF = args.li == 1 ? 8192 : 0;
#else
    constexpr int POFF = 0;
#endif
#ifndef PH_MASK
#define PH_MASK 0x3ff
#endif
#define IN(k) (((PH_MASK >> (k)) & 1) && lo <= (k) && (k) < hi_ph)
#define BOTH(k) (IN(k) && IN((k) + 1))

    constexpr int I_IN = 32 * 96, I_OUT = 32 * 32, I_G = 32 * 8 * 32, I_D = 8 * 32 * 32;
    constexpr int N_DENSE = I_IN + I_OUT, N_MOE = 2 * I_G + I_D;
#define DENSE_ITEM(r_) do { int r = (r_); \
        if (r < I_IN) { const int kb = r / 96, nb = r % 96; tr_item(args.in[2], NIN, D, 64 * kb, 64 * nb, WinT + (size_t)(64 * nb) * D, scr, lane); } \
        else { r -= I_IN; const int kb = r / 32, nb = r % 32; tr_item(args.in[8], D, D, 64 * kb, 64 * nb, WoutT + (size_t)(64 * nb) * D, scr, lane); } } while (0)
#define MOE_ITEM(r_) do { int r = (r_); \
        if (r < 2 * I_G) { const int up = r >= I_G ? 1 : 0; if (up) r -= I_G; const int e = r >> 8, q = r & 255, kb = q >> 3, nb = q & 7, n0 = 64 * nb; \
            const float* W = (up ? args.in[15] : args.in[14]) + (size_t)e * D * DE; \
            tr_item(W, DE, D, 64 * kb, n0, WguT + ((size_t)e * 1024 + (n0 >> 7) * 256 + (n0 & 127) + up * 128) * D, scr, lane); } \
        else { r -= 2 * I_G; const int e = r >> 8, q = r & 255, kb = q >> 5, nb = q & 31; \
            tr_item(args.in[16] + (size_t)e * DE * D, D, DE, 64 * kb, 64 * nb, WdT + ((size_t)e * 2048 + 64 * nb) * DE, scr, lane); } } while (0)
    const int n_moe_p0 = N_MOE_P0, n_moe_p1 = (G == 256) ? N_MOE_P1 : N_MOE_P0;
    const int GP1 = (n_moe_p1 > n_moe_p0) ? 192 : G;

    if (IN(0)) {
        LAS unsigned* scr = (LAS unsigned*)(lds + wave * 16384);
        for (int it = gw; it < N_DENSE; it += NGW) DENSE_ITEM(it);
        for (int it = gw; it < n_moe_p0; it += NGW) MOE_ITEM(it);
        for (int i = bx * 512 + tid; i < 48 * D; i += G * 512) { const int c = i / D, k = i % D;
            const float v = c < 4 ? args.in[10][k * 4 + c] : (c < 36 ? args.in[12][k * 32 + (c - 4)] : 0.f);
            const unsigned h = f2bf(v); WRHI[i] = (bf16)h; WRLO[i] = (bf16)f2bf(v - bf2f(h)); }
        for (int m = gw; m < T; m += NGW) rms_row_to_bf16(x + (size_t)m * D, args.in[1], Hb + (size_t)m * D, lane);
        if (BOTH(0)) GRID_BAR();
    }

    if (IN(1)) {
        if (bx < GP1) {
            pg8::Gemm g{Hb, WinT, T, NIN, D}; pg8::StaticOrder S; S.init(T, NIN, GP1, bx);
            pg8::EpiProj E{PROJ, NIN, QSCALE, KMP};
            pg8::gemm_phase<pg8::EpiProj, pg8::StaticOrder, true, true>(lds, g, S, E);
        } else {
            LAS unsigned* scr = (LAS unsigned*)(lds + wave * 16384);
            for (int it = n_moe_p0 + (bx - GP1) * NWAVES + wave; it < n_moe_p1; it += (G - GP1) * NWAVES) MOE_ITEM(it);
        }
        if (BOTH(1)) GRID_BAR();
    }


    if (IN(3)) {
        float lam;
        { const float a = args.in[3][lane] * args.in[4][lane] + args.in[3][lane + 64] * args.in[4][lane + 64];
          const float c = args.in[5][lane] * args.in[6][lane] + args.in[5][lane + 64] * args.in[6][lane + 64];
          lam = __expf(wave_sum(a)) - __expf(wave_sum(c)) + 0.2f; }
        LAS int* const ucost = (LAS int*)(lds + QTAB_OFF); LAS unsigned* const uperm = (LAS unsigned*)(lds + QTAB_OFF + 2048);
        { const int u = tid, ty = u >> 8, b = (u >> 7) & 1; int c; unsigned ent;
          if (ty) { const int h = (u >> 5) & 3, j = u & 31, nt = 2 * (j + 1); const int dh = h == 0 ? 444 : (h == 1 ? 1774 : 8192); int near = dh / 64 + 3; near = near < nt ? near : nt;
              c = near * 48 + (nt - near) * 18; ent = (1u << 16) | ((unsigned)b << 12) | ((unsigned)h << 8) | (unsigned)j; }
          else { const int h = (u >> 4) & 7, i = u & 15, nt = 4 * (i + 1); const int dh = h < 5 ? (222 << h) : 8192; int near = dh / 64 + 5; near = near < nt ? near : nt;
              c = near * 32 + (nt - near) * 17; ent = ((unsigned)b << 12) | ((unsigned)h << 8) | (unsigned)i; }
          ucost[u] = c; __syncthreads();
          int rank = 0; const int v0 = u & 256;
          for (int v = v0; v < v0 + 256; ++v) { const int cv = ucost[v]; rank += (cv > c || (cv == c && v < u)) ? 1 : 0; }
          uperm[v0 + rank] = ent; __syncthreads(); }
#if defined(PROBE_DUP) && defined(PROBE_MODE)
        const int pmode = args.li == 1 ? PROBE_MODE : 0; bf16* const mixo = args.li == 1 ? Hb : MIX;
#else
        constexpr int pmode = 0; bf16* const mixo = MIX;
#endif
#define QFETCH(word) do { __syncthreads(); if (tid == 0) MISC[16] = __hip_atomic_fetch_add(ctl + CW_QHEAD + 64 * args.li + (word), 1u, __ATOMIC_RELAXED, __HIP_MEMORY_SCOPE_AGENT); \
                          __syncthreads(); qi = __builtin_amdgcn_readfirstlane(MISC[16]); } while (0)
        unsigned qi;
        for (;;) { QFETCH(0); if (qi >= 256u) break;
            const unsigned e = __builtin_amdgcn_readfirstlane(uperm[256 + qi]);
            att::attn_unit<1>(lds, PROJ, mixo, KMP, (int)((e >> 12) & 15u), (int)((e >> 8) & 15u), (int)(e & 255u), lam, args.in[7], pmode); }
        for (;;) { QFETCH(1024); if (qi >= 256u) break;
            const unsigned e = __builtin_amdgcn_readfirstlane(uperm[qi]);
            att::attn_unit<0>(lds, PROJ, mixo, KMP, (int)((e >> 12) & 15u), (int)((e >> 8) & 15u), (int)(e & 255u), lam, args.in[7], pmode); }
#if defined(PROBE_DUP) && defined(PROBE_MODE)
        if (args.li != 1)
#endif
        { const unsigned ncu = (unsigned)((N_MOE - n_moe_p1 + NWAVES - 1) / NWAVES); LAS unsigned* scr = (LAS unsigned*)(lds + wave * 16384);
          for (;;) { QFETCH(2048); if (qi >= ncu) break;
              const int it = n_moe_p1 + (int)qi * NWAVES + wave; if (it < N_MOE) MOE_ITEM(it); } }
#undef QFETCH
        if (BOTH(3)) GRID_BAR();
    }

    if (IN(4)) {
        pg8::Gemm g{MIX, WoutT, T, D, D}; pg8::StaticOrder S; S.init(T, D, G, bx);
        pg8::EpiResid E{x, X1, D};
        pg8::gemm_phase<pg8::EpiResid, pg8::StaticOrder, false, true>(lds, g, S, E);
        if (BOTH(4)) GRID_BAR();
    }

    if (IN(5)) {
        LAS float* lg = (LAS float*)(lds + wave * 4096);
        const float* nw = args.in[9];
        const int nit5 = (T / 16 + 2 * G - 1) / (2 * G);
        for (int it = 0; it < nit5; ++it) {
            const int tile = (2 * it + (wave >> 2)) * G + bx; const bool tvalid = tile < T / 16;
            const int t0 = (tvalid ? tile : 0) * 16, row = lane & 15, kq = lane >> 4, kpart = wave & 3;
            const float* xr = X1 + (size_t)(t0 + row) * D + 8 * kq;
            pg8::f32x4 acc[3] = {{0.f, 0.f, 0.f, 0.f}, {0.f, 0.f, 0.f, 0.f}, {0.f, 0.f, 0.f, 0.f}};
            float ss = 0.f;
#pragma unroll 2
            for (int s = 16 * kpart; s < 16 * kpart + 16; ++s) {
                const f32x4 a0 = *(const f32x4*)(xr + 32 * s), a1 = *(const f32x4*)(xr + 32 * s + 4);
                const f32x4 w0 = *(const f32x4*)(nw + 32 * s + 8 * kq), w1 = *(const f32x4*)(nw + 32 * s + 8 * kq + 4);
                ss += (a0[0] * a0[0] + a0[1] * a0[1]) + (a0[2] * a0[2] + a0[3] * a0[3]) + (a1[0] * a1[0] + a1[1] * a1[1]) + (a1[2] * a1[2] + a1[3] * a1[3]);
                const f32x4 u0 = a0 * w0, u1 = a1 * w1;
                unsigned hb[8]; float uf[8] = {u0[0], u0[1], u0[2], u0[3], u1[0], u1[1], u1[2], u1[3]};
                u32x4 ah, al;
#pragma unroll
                for (int j = 0; j < 8; ++j) hb[j] = f2bf(uf[j]);
                ah.x = hb[0] | (hb[1] << 16); ah.y = hb[2] | (hb[3] << 16); ah.z = hb[4] | (hb[5] << 16); ah.w = hb[6] | (hb[7] << 16);
                al.x = pk2(uf[0] - bf2f(hb[0]), uf[1] - bf2f(hb[1])); al.y = pk2(uf[2] - bf2f(hb[2]), uf[3] - bf2f(hb[3]));
                al.z = pk2(uf[4] - bf2f(hb[4]), uf[5] - bf2f(hb[5])); al.w = pk2(uf[6] - bf2f(hb[6]), uf[7] - bf2f(hb[7]));
                const bf16x8 afh = __builtin_bit_cast(bf16x8, ah), afl = __builtin_bit_cast(bf16x8, al);
#pragma unroll
                for (int ct = 0; ct < 3; ++ct) { const size_t wo = (size_t)(16 * ct + row) * D + 32 * s + 8 * kq;
                    const bf16x8 bh = *(const bf16x8*)(WRHI + wo), bl = *(const bf16x8*)(WRLO + wo);
                    acc[ct] = __builtin_amdgcn_mfma_f32_16x16x32_bf16(afh, bh, acc[ct], 0, 0, 0);
                    acc[ct] = __builtin_amdgcn_mfma_f32_16x16x32_bf16(afh, bl, acc[ct], 0, 0, 0);
                    acc[ct] = __builtin_amdgcn_mfma_f32_16x16x32_bf16(afl, bh, acc[ct], 0, 0, 0); }
            }
            ss += __shfl_xor(ss, 16); ss += __shfl_xor(ss, 32);
#pragma unroll
            for (int ct = 0; ct < 3; ++ct)
#pragma unroll
                for (int r = 0; r < 4; ++r) lg[(4 * kq + r) * 48 + 16 * ct + row] = acc[ct][r];
            if (kq == 0) lg[768 + row] = ss;
            __syncthreads();
            if (tvalid && kpart == 0 && lane < 16) {
                const LAS float* L0 = lg + lane * 48;
                const float rs = __builtin_amdgcn_rsqf((lg[768 + lane] + lg[1024 + 768 + lane] + lg[2048 + 768 + lane] + lg[3072 + 768 + lane]) * (1.f / D) + RMS_EPS);
#define LGT(c) ((L0[(c)] + L0[1024 + (c)]) + (L0[2048 + (c)] + L0[3072 + (c)]))
                float gmax = -__builtin_inff(); int gi = 0; float gl[4];
#pragma unroll
                for (int c = 0; c < 4; ++c) { gl[c] = LGT(c) * rs + args.in[11][c]; if (gl[c] > gmax) { gmax = gl[c]; gi = c; } }
                float gsum = 0.f;
#pragma unroll
                for (int c = 0; c < 4; ++c) gsum += __expf(gl[c] - gmax);
                const float gp = 1.f / gsum;
                float el[8], emax = -__builtin_inff();
#pragma unroll
                for (int j = 0; j < 8; ++j) { el[j] = LGT(4 + 8 * gi + j) * rs + args.in[13][8 * gi + j]; emax = fmaxf(emax, el[j]); }
#undef LGT
                float p0v = -1.f, p1v = -1.f; int i0 = 0, i1 = 0;
#pragma unroll
                for (int j = 0; j < 8; ++j) { const float p = __expf(el[j] - emax);
                    if (p > p0v) { p1v = p0v; i1 = i0; p0v = p; i0 = j; } else if (p > p1v) { p1v = p; i1 = j; } }
                const float inv = gp / (p0v + p1v);
                const int e0 = 8 * gi + i0, e1 = 8 * gi + i1;
                u32x4 info; info.x = (unsigned)e0; info.y = (unsigned)e1; info.z = __builtin_bit_cast(unsigned, p0v * inv); info.w = __builtin_bit_cast(unsigned, p1v * inv);
                TOKINFO[t0 + lane] = info; TOKRSTD[t0 + lane] = rs;
                atomicAdd(ctl + CW_ECNT + POFF + 64 * e0, 1u); atomicAdd(ctl + CW_ECNT + POFF + 64 * e1, 1u);
            }
            __syncthreads();
        }
        if (BOTH(5)) GRID_BAR();
    }

    LAS int* const tab = (LAS int*)(lds + MOE_TAB_OFF);
    if (IN(6) || IN(7) || IN(8)) {
        if (tid < 32) tab[120 + tid] = (int)__hip_atomic_load(ctl + CW_ECNT + 64 * tid, __ATOMIC_RELAXED, __HIP_MEMORY_SCOPE_AGENT);
        __syncthreads();
        if (tid == 0) { int ts = 0;
            for (int e = 0; e < 32; ++e) { const int c = tab[120 + e], nt = (c + 255) >> 8; tab[e] = ts; tab[40 + e] = ts; tab[80 + e] = ts * 256 + c; ts += nt; }
            tab[32] = ts; }
        __syncthreads();
    }

    if (IN(6)) {
        const float* nw = args.in[9];
        static_assert(T == 4 * 8 * 256, "P6 deal assumes 4 tokens per wave on 256 workgroups");
        for (int tb = gw; tb < T; tb += 4 * NGW) {
            int mp0 = 0, mp1 = 0; unsigned mw0 = 0u, mw1 = 0u; float mrs = 0.f;
            if (lane < 4 && tb + lane * NGW < T) { const int t = tb + lane * NGW; const u32x4 info = TOKINFO[t]; mrs = TOKRSTD[t];
                const int e0 = (int)info.x, e1 = (int)info.y; mw0 = info.z; mw1 = info.w;
                mp0 = (int)atomicAdd(ctl + CW_ECUR + POFF + 64 * e0, 1u) + tab[40 + e0] * 256; mp1 = (int)atomicAdd(ctl + CW_ECUR + POFF + 64 * e1, 1u) + tab[40 + e1] * 256; }
#pragma unroll
            for (int i = 0; i < 4; ++i) { const int t = tb + i * NGW; if (t >= T) break;
                const int p0 = __builtin_amdgcn_readlane(mp0, i), p1 = __builtin_amdgcn_readlane(mp1, i);
                const float rs = __builtin_bit_cast(float, __builtin_amdgcn_readlane(__builtin_bit_cast(int, mrs), i));
                const f32x4* xr = (const f32x4*)(X1 + (size_t)t * D) + lane; const f32x4* wr = (const f32x4*)nw + lane;
                u32x2* o0 = (u32x2*)(XP + (size_t)p0 * D) + lane; u32x2* o1 = (u32x2*)(XP + (size_t)p1 * D) + lane;
#pragma unroll
                for (int j = 0; j < 8; ++j) { const f32x4 v = xr[64 * j], ww = wr[64 * j]; u32x2 p; p.x = pk2(v[0] * rs * ww[0], v[1] * rs * ww[1]); p.y = pk2(v[2] * rs * ww[2], v[3] * rs * ww[3]);
                    o0[64 * j] = p; o1[64 * j] = p; }
                if (lane == i) { ROWINFO[2 * mp0] = 2 * t; ROWINFO[2 * mp0 + 1] = (int)mw0; ROWINFO[2 * mp1] = 2 * t + 1; ROWINFO[2 * mp1 + 1] = (int)mw1; }
            }
        }
        if (BOTH(6)) GRID_BAR();
    }

    if (IN(7)) {
        pg8::Gemm g{XP, WguT, XP_ROWS, NE * 1024, D}; pg8::MoeOrder S{tab, 4, tab[32] * 4, G, bx};
        pg8::EpiSwiGLU E{ACT};
        pg8::gemm_phase<pg8::EpiSwiGLU, pg8::MoeOrder, true, true>(lds, g, S, E);
        if (BOTH(7)) GRID_BAR();
    }

    if (IN(8)) {
        pg8::Gemm g{ACT, WdT, XP_ROWS, NE * 2048, DE}; pg8::MoeOrder S{tab, 8, tab[32] * 8, G, bx};
        pg8::EpiDown E{Y, ROWINFO, tab + 80};
        pg8::gemm_phase<pg8::EpiDown, pg8::MoeOrder, true, true>(lds, g, S, E);
        if (BOTH(8)) GRID_BAR();
    }

    if (IN(9)) {
        const float* nf = args.in[17];
        for (int t = gw; t < T; t += NGW) {
            const f32x4* xr = (const f32x4*)(X1 + (size_t)t * D) + lane;
            const u32x2* y0 = (const u32x2*)(Y + (size_t)(2 * t) * D) + lane; const u32x2* y1 = (const u32x2*)(Y + (size_t)(2 * t + 1) * D) + lane;
            f32x4 v[8]; float s = 0.f;
#pragma unroll
            for (int j = 0; j < 8; ++j) { f32x4 a = xr[64 * j]; const u32x2 p = y0[64 * j], q = y1[64 * j];
                a[0] += bf2f(p.x & 0xffffu) + bf2f(q.x & 0xffffu); a[1] += bf2f(p.x >> 16) + bf2f(q.x >> 16);
                a[2] += bf2f(p.y & 0xffffu) + bf2f(q.y & 0xffffu); a[3] += bf2f(p.y >> 16) + bf2f(q.y >> 16);
                v[j] = a; s += (a[0] * a[0] + a[1] * a[1]) + (a[2] * a[2] + a[3] * a[3]); }
            const float rstd = __builtin_amdgcn_rsqf(wave_sum(s) * (1.f / D) + RMS_EPS);
            f32x4* orow = (f32x4*)(args.out + (size_t)t * D) + lane; const f32x4* wr = (const f32x4*)nf + lane;
#pragma unroll
            for (int j = 0; j < 8; ++j) orow[64 * j] = v[j] * rstd * wr[64 * j];
        }
    }
#undef IN
#undef BOTH
#undef GRID_BAR
}

extern "C" void kernel_launch(void* const* d_in, const int* in_sizes, int n_in, void* d_out, int out_size, void* d_ws, size_t ws_size, hipStream_t stream) {
    static int grid = 0;
    if (grid == 0) {
        if (n_in != 18 || in_sizes[0] != T * D || out_size != T * D || ws_size < WS_END) { fprintf(stderr, "kernel_launch: unexpected shapes (n_in %d, in0 %d, out %d, ws %zu)\n", n_in, n_in > 0 ? in_sizes[0] : -1, out_size, ws_size); grid = -1; return; }
        int dev = 0, cus = 0, per_cu = 0;
        if (hipGetDevice(&dev) != hipSuccess || hipDeviceGetAttribute(&cus, hipDeviceAttributeMultiprocessorCount, dev) != hipSuccess) { grid = -1; return; }
        if (hipFuncSetAttribute((const void*)trunk_fwd, hipFuncAttributeMaxDynamicSharedMemorySize, LDS_BYTES) != hipSuccess) { fprintf(stderr, "kernel_launch: hipFuncSetAttribute failed\n"); grid = -1; return; }
        if (hipOccupancyMaxActiveBlocksPerMultiprocessor(&per_cu, (const void*)trunk_fwd, NWAVES * 64, LDS_BYTES) != hipSuccess || per_cu < 1)
            fprintf(stderr, "kernel_launch: note: occupancy query reports %d workgroups per CU\n", per_cu);
        (void)hipGetLastError();
        grid = cus;
    }
    if (grid < 0) return;
    if (hipMemsetAsync((char*)d_ws + WS_CTL, 0, CTL_ZERO_BYTES, stream) != hipSuccess) return;
    Args a{};
    for (int i = 0; i < 18; ++i) a.in[i] = (const float*)d_in[i];
    a.out = (float*)d_out; a.ws = (unsigned char*)d_ws;
    int plan[NPH + 2][2]; int nl = 0;
#if defined(PROBE_DUP)
    plan[nl][0] = 0; plan[nl][1] = PROBE_DUP + 1; ++nl; plan[nl][0] = PROBE_DUP; plan[nl][1] = PROBE_DUP + 1; ++nl;
    if (PROBE_DUP + 1 < NPH) { plan[nl][0] = PROBE_DUP + 1; plan[nl][1] = NPH; ++nl; }
#else
    if (N_LAUNCHES == 1) { plan[0][0] = 0; plan[0][1] = NPH; nl = 1; } else { for (int k = 0; k < NPH; ++k) { plan[k][0] = k; plan[k][1] = k + 1; } nl = NPH; }
#endif
    for (int li = 0; li < nl; ++li) {
        a.ph_lo = plan[li][0]; a.ph_hi = plan[li][1]; a.li = li;
        hipLaunchKernelGGL(trunk_fwd, dim3(grid), dim3(NWAVES * 64), LDS_BYTES, stream, a);
    }
}
```

```cpp
#include <hip/hip_runtime.h>
#include <cstdio>
#include <cstdint>

#ifndef MK_N_LAUNCHES
#define MK_N_LAUNCHES 1
#endif
constexpr int NPH = 10;
constexpr int N_LAUNCHES = MK_N_LAUNCHES;

constexpr int NWAVES = 8;
#ifndef N_MOE_P1
#define N_MOE_P1 0
#endif
#ifndef N_MOE_P0
#define N_MOE_P0 0
#endif
constexpr int BATCH = 2, SEQ = 4096, T = BATCH * SEQ, D = 2048, NIN = 6144;
constexpr int NE = 32, DE = 512, NPAIR = 2 * T;
constexpr int XP_ROWS = 24576;
constexpr float RMS_EPS = 1e-6f;
constexpr float LOG2E = 1.4426950408889634f;
constexpr float QSCALE = 0.08838834764831845f * 1.4426950408889634f;

constexpr size_t MiB = 1u << 20;
constexpr size_t WS_CTL = 0, CTL_ZERO_BYTES = 1 * MiB;
constexpr size_t WS_WIN = 1 * MiB;
constexpr size_t WS_WOUT = 25 * MiB;
constexpr size_t WS_H = 33 * MiB;
constexpr size_t WS_Y = 1 * MiB;
constexpr size_t WS_WGU = 65 * MiB;
constexpr size_t WS_WD = 193 * MiB;
constexpr size_t WS_PROJ = 257 * MiB;
constexpr size_t WS_XP = 257 * MiB;
constexpr size_t WS_MIX = 353 * MiB;
constexpr size_t WS_ACT = 353 * MiB;
constexpr size_t WS_X1 = 385 * MiB;
constexpr size_t WS_MISC = 449 * MiB;
constexpr size_t WS_KMEAN = WS_MISC;
constexpr size_t WS_TOKINFO = WS_MISC + 256 * 1024;
constexpr size_t WS_TOKRSTD = WS_MISC + 384 * 1024;
constexpr size_t WS_ROWINFO = WS_MISC + 512 * 1024;
constexpr size_t WS_WRHI = WS_MISC + 1024 * 1024;
constexpr size_t WS_WRLO = WS_MISC + 1280 * 1024;
constexpr size_t WS_END = 452 * MiB;
constexpr int CW_BAR = 4096;
constexpr int CW_ECNT = 16384;
constexpr int CW_ECUR = 16384 + 2048;
constexpr int CW_QHEAD = 16384 + 4096;

constexpr int RING_BYTES = 131072;
constexpr int ATT_SCR_OFF = 131072;
constexpr int MOE_TAB_OFF = 135168;
constexpr int MISC_OFF = 136192;
constexpr int QTAB_OFF = 136448;
constexpr int LDS_BYTES = 147456;

#define GAS __attribute__((address_space(1)))
#define LAS __attribute__((address_space(3)))
typedef unsigned short bf16;
typedef float f32x4 __attribute__((ext_vector_type(4)));
typedef float f32x16 __attribute__((ext_vector_type(16)));
typedef short bf16x8 __attribute__((ext_vector_type(8)));
typedef short s16x4 __attribute__((ext_vector_type(4)));
typedef unsigned u32x4 __attribute__((ext_vector_type(4)));
typedef unsigned u32x2 __attribute__((ext_vector_type(2)));

__device__ __forceinline__ unsigned f2bf(float f) { unsigned u = __builtin_bit_cast(unsigned, f); return (u + 0x7fffu + ((u >> 16) & 1u)) >> 16; }
__device__ __forceinline__ unsigned pk2(float lo, float hi) { return f2bf(lo) | (f2bf(hi) << 16); }
__device__ __forceinline__ float bf2f(unsigned b) { return __builtin_bit_cast(float, b << 16); }
__device__ __forceinline__ float wave_sum(float v) {
#pragma unroll
    for (int o = 1; o < 64; o <<= 1) v += __shfl_xor(v, o);
    return v;
}
namespace pg8 {
#define PG8_LAS __attribute__((address_space(3)))
typedef unsigned short bf16_t;
typedef short bf16x8 __attribute__((ext_vector_type(8)));
typedef float f32x4 __attribute__((ext_vector_type(4)));
typedef unsigned u32x4 __attribute__((ext_vector_type(4)));
constexpr int BM = 256, BK = 64, HALF = 128, HTB = HALF * BK * 2  , STAGE_BYTES = 8 * HTB, NXCD = 8, WGM = 8;

__host__ __device__ __forceinline__ int lds_byte(int r, int c) { const int st = (r >> 4) * 2 + (c >> 5), rr = r & 15, cc = c & 31, ob = rr * 64 + cc * 2; return st * 1024 + (ob ^ (((ob >> 9) & 1) << 5)); }
__host__ __device__ __forceinline__ void stage_rc(int b, int& R, int& C) { const int st = b / 1024, sb = b % 1024, swz = sb ^ (((sb >> 9) & 1) << 5); R = (st >> 1) * 16 + swz / 64; C = (st & 1) * 32 + (swz % 64) / 2; }
__host__ __device__ __forceinline__ int perm32(int rho) { const int n = rho >> 4, i = rho & 15; return 8 * (i >> 2) + 4 * n + (i & 3); }

struct Unit { int pm, pn; };
struct Gemm { const bf16_t* A; const bf16_t* Bt; int M, N, K; };

struct StaticOrder {
    int nM, nN, nwg, G, c;
    __host__ __device__ void init(int M, int N, int G_, int c_) { nM = M / BM; nN = N / BM; nwg = nM * nN; G = G_; c = c_; }
    __host__ __device__ bool next(int i, Unit& u) const {
        const long L = (long)i * G + c; if (L >= nwg) return false;
        int wgid = (int)L; { const int q = nwg / NXCD, r = nwg % NXCD, xcd = wgid % NXCD, off = wgid / NXCD; wgid = (xcd < r ? xcd * (q + 1) : r * (q + 1) + (xcd - r) * q) + off; }
        const int nig = WGM * nN, gid = wgid / nig, fm = gid * WGM, gsz = (nM - fm) < WGM ? (nM - fm) : WGM;
        u.pm = fm + ((wgid % nig) % gsz); u.pn = (wgid % nig) / gsz; return true;
    }
    __device__ __forceinline__ void a_ready(const Unit&) const {}
    __device__ __forceinline__ void done(const Unit&) const {}
};

__device__ __forceinline__ unsigned cvt_pk_bf16(float lo, float hi) { unsigned r; asm volatile("v_cvt_pk_bf16_f32 %0, %1, %2" : "=v"(r) : "v"(lo), "v"(hi)); return r; }
typedef float f32x2 __attribute__((ext_vector_type(2)));
struct EpiProj {
    static constexpr bool PERM = true, AFTER_DRAIN = false;
    bf16_t* O; int ldc; float qscale; float* kmp;
    __device__ __forceinline__ void operator()(const f32x4 (&acc)[2][2][4][2], const Unit& u, int wr, int wc, int fr, int fq) const {
        const int row0 = u.pm * BM + wr * 64 + fr, col0 = u.pn * BM + wc * 32 + 8 * fq;
        const float sc = (u.pn < 4 || (u.pn >= 12 && u.pn < 16)) ? qscale : 1.f;
#pragma unroll
        for (int ai = 0; ai < 2; ++ai)
#pragma unroll
            for (int m = 0; m < 4; ++m) { bf16_t* rowp = O + (size_t)(row0 + ai * HALF + m * 16) * ldc + col0;
#pragma unroll
                for (int bj = 0; bj < 2; ++bj) { const f32x4 v0 = acc[ai][bj][m][0] * sc, v1 = acc[ai][bj][m][1] * sc;
                    u32x4 w; w.x = cvt_pk_bf16(v0[0], v0[1]); w.y = cvt_pk_bf16(v0[2], v0[3]); w.z = cvt_pk_bf16(v1[0], v1[1]); w.w = cvt_pk_bf16(v1[2], v1[3]);
                    *(u32x4*)(rowp + bj * HALF) = w; } }
        if (u.pn >= 4 && u.pn < 8) {
            const int lane = fq * 16 + fr;
#pragma unroll
            for (int bj = 0; bj < 2; ++bj)
#pragma unroll
                for (int n = 0; n < 2; ++n) { f32x4 s = (acc[0][bj][0][n] + acc[0][bj][1][n]) + (acc[0][bj][2][n] + acc[0][bj][3][n]) + (acc[1][bj][0][n] + acc[1][bj][1][n]) + (acc[1][bj][2][n] + acc[1][bj][3][n]);
#pragma unroll
                    for (int i = 0; i < 4; ++i) { float v = s[i]; v += __shfl_xor(v, 1); v += __shfl_xor(v, 2); v += __shfl_xor(v, 4); v += __shfl_xor(v, 8); s[i] = v; }
                    if (fr == 0) { const int bh = (u.pm >> 4) * 8 + 2 * (u.pn - 4) + bj, blk = u.pm & 15;
                        *(f32x4*)(kmp + ((size_t)((bh * 16 + blk) * 2 + wr)) * 128 + wc * 32 + 8 * fq + 4 * n) = s; } }
            (void)lane;
        }
    }
};
struct EpiResid {
    static constexpr bool PERM = true, AFTER_DRAIN = false;
    const float* X; float* X1; int ldc;
    __device__ __forceinline__ void operator()(const f32x4 (&acc)[2][2][4][2], const Unit& u, int wr, int wc, int fr, int fq) const {
        const int row0 = u.pm * BM + wr * 64 + fr, col0 = u.pn * BM + wc * 32 + 8 * fq;
#pragma unroll
        for (int ai = 0; ai < 2; ++ai)
#pragma unroll
            for (int m = 0; m < 4; ++m) { const size_t off = (size_t)(row0 + ai * HALF + m * 16) * ldc + col0;
#pragma unroll
                for (int bj = 0; bj < 2; ++bj)
#pragma unroll
                    for (int n = 0; n < 2; ++n) { const f32x4 xv = *(const f32x4*)(X + off + bj * HALF + 4 * n); *(f32x4*)(X1 + off + bj * HALF + 4 * n) = xv + acc[ai][bj][m][n]; } }
    }
};
__device__ __forceinline__ float silu_mul(float g, float u) { return g * u * __builtin_amdgcn_rcpf(1.f + __builtin_amdgcn_exp2f(-1.4426950408889634f * g)); }
struct EpiSwiGLU {
    static constexpr bool PERM = true, AFTER_DRAIN = false;
    bf16_t* ACT; const unsigned* rec; const PG8_LAS int* tab;
    __device__ __forceinline__ void operator()(const f32x4 (&acc)[2][2][4][2], const Unit& u, int wr, int wc, int fr, int fq) const {
        const int e = u.pn >> 2, i0 = (u.pm - tab[40 + e]) * BM + wr * 64 + fr, cm1 = tab[120 + e] - 1;
        const int row0 = u.pm * BM + wr * 64 + fr, col0 = (u.pn & 3) * 128 + wc * 32 + 8 * fq;
#pragma unroll
        for (int ai = 0; ai < 2; ++ai)
#pragma unroll
            for (int m = 0; m < 4; ++m) { int idx = i0 + ai * HALF + m * 16; idx = idx < cm1 ? idx : cm1;
                const float rs = __builtin_bit_cast(float, rec[((size_t)e * 8192 + idx) * 4 + 2]);
                const f32x4 g0 = acc[ai][0][m][0] * rs, g1 = acc[ai][0][m][1] * rs, u0 = acc[ai][1][m][0] * rs, u1 = acc[ai][1][m][1] * rs;
                u32x4 w; w.x = cvt_pk_bf16(silu_mul(g0[0], u0[0]), silu_mul(g0[1], u0[1])); w.y = cvt_pk_bf16(silu_mul(g0[2], u0[2]), silu_mul(g0[3], u0[3]));
                w.z = cvt_pk_bf16(silu_mul(g1[0], u1[0]), silu_mul(g1[1], u1[1])); w.w = cvt_pk_bf16(silu_mul(g1[2], u1[2]), silu_mul(g1[3], u1[3]));
                *(u32x4*)(ACT + (size_t)(row0 + ai * HALF + m * 16) * 512 + col0) = w; }
    }
};
struct EpiDown {
    static constexpr bool PERM = true, AFTER_DRAIN = false;
    bf16_t* Y; const unsigned* rec; const PG8_LAS int* tab;
    __device__ __forceinline__ void operator()(const f32x4 (&acc)[2][2][4][2], const Unit& u, int wr, int wc, int fr, int fq) const {
        const int e = u.pn >> 3, i0 = (u.pm - tab[40 + e]) * BM + wr * 64 + fr, cnt = tab[120 + e];
        const int col0 = (u.pn & 7) * BM + wc * 32 + 8 * fq;
#pragma unroll
        for (int ai = 0; ai < 2; ++ai)
#pragma unroll
            for (int m = 0; m < 4; ++m) { const int idx = i0 + ai * HALF + m * 16;
                if (idx < cnt) { const unsigned* rc = rec + ((size_t)e * 8192 + idx) * 4; const int pair = (int)rc[0]; const float wgt = __builtin_bit_cast(float, rc[1]);
                    bf16_t* rowp = Y + (size_t)pair * 2048 + col0;
#pragma unroll
                    for (int bj = 0; bj < 2; ++bj) { const f32x4 v0 = acc[ai][bj][m][0] * wgt, v1 = acc[ai][bj][m][1] * wgt;
                        u32x4 w; w.x = cvt_pk_bf16(v0[0], v0[1]); w.y = cvt_pk_bf16(v0[2], v0[3]); w.z = cvt_pk_bf16(v1[0], v1[1]); w.w = cvt_pk_bf16(v1[2], v1[3]);
                        *(u32x4*)(rowp + bj * HALF) = w; } } }
    }
};
struct MoeOrder {
    const PG8_LAS int* tab; int npn, total, G, c; const unsigned* rec; unsigned rowbytes;
    __device__ __forceinline__ bool next(int i, Unit& u) const {
        const int L = i * G + c; if (L >= total) return false;
        const int tile = L / npn, pn = L - tile * npn; int e = 0;
#pragma unroll 4
        for (int j = 1; j < 32; ++j) e += (tab[j] <= tile) ? 1 : 0;
        u.pm = tab[40 + e] + (tile - tab[e]); u.pn = e * npn + pn; return true;
    }
    __device__ __forceinline__ unsigned arow(const Unit& u, int r) const {
        const int e = u.pn / npn; int idx = (u.pm - tab[40 + e]) * BM + r; const int cm1 = tab[120 + e] - 1; idx = idx < cm1 ? idx : cm1;
        return rec[((size_t)e * 8192 + idx) * 4 + 3] * rowbytes;
    }
    __device__ __forceinline__ void a_ready(const Unit&) const {}
    __device__ __forceinline__ void done(const Unit&) const {}
};

template <class Epi, class Sched, bool ALIGN_EPI = false, bool SP2 = false>
__device__ __forceinline__ void gemm_phase(PG8_LAS unsigned char* lds, const Gemm g, const Sched& S, const Epi& E) {
    const int tid = threadIdx.x, wid = __builtin_amdgcn_readfirstlane(tid >> 6), lane = tid & 63, wr = wid >> 2, wc = wid & 3, fr = lane & 15, fq = lane >> 4;
    const int K = g.K, nt = K / BK;
    unsigned voffA[2], voffB[2];
#pragma unroll
    for (int i = 0; i < 2; ++i) { int R, C; stage_rc(tid * 16 + i * 8192, R, C); const int Rb = Epi::PERM ? ((R & ~31) + perm32(R & 31)) : R;
        voffA[i] = (unsigned)(R * K + C) * 2u; voffB[i] = (unsigned)(Rb * K + C) * 2u; }
    const size_t kstep = (size_t)(BK * 2);
    const size_t hstep = (size_t)HALF * K * 2;
    const size_t tstep = 2 * hstep;
    const unsigned ldsw = (unsigned)wid * 1024u;
    const int aoff = lds_byte(wr * 64 + fr, fq * 8), boff = lds_byte(wc * 32 + fr, fq * 8);
#define PG8_SA(b, h) (((b) * 2 + (h)) * HTB)
#define PG8_SB(b, h) ((4 + (b) * 2 + (h)) * HTB)
#define PG8_STAGE(bufoff, gbase, voff) do { _Pragma("unroll") for (int _i = 0; _i < 2; ++_i) \
        __builtin_amdgcn_global_load_lds((const unsigned*)((const char*)(gbase) + (voff)[_i]), (PG8_LAS unsigned*)(lds + (bufoff) + ldsw + _i * 8192), 16, 0, 0); } while (0)
#define PG8_LDA(dst, b, h) do { _Pragma("unroll") for (int m = 0; m < 4; ++m) _Pragma("unroll") for (int k = 0; k < 2; ++k) dst[m][k] = *(const PG8_LAS bf16x8*)(lds + PG8_SA(b, h) + aoff + m * 2048 + k * 1024); } while (0)
#define PG8_LDB(dst, b, h) do { _Pragma("unroll") for (int n = 0; n < 2; ++n) _Pragma("unroll") for (int k = 0; k < 2; ++k) dst[n][k] = *(const PG8_LAS bf16x8*)(lds + PG8_SB(b, h) + boff + n * 2048 + k * 1024); } while (0)
#define PG8_MMA(ai, bj, At, Bt) do { __builtin_amdgcn_s_setprio(1); _Pragma("unroll") for (int m = 0; m < 4; ++m) _Pragma("unroll") for (int n = 0; n < 2; ++n) _Pragma("unroll") for (int k = 0; k < 2; ++k) \
        acc[ai][bj][m][n] = __builtin_amdgcn_mfma_f32_16x16x32_bf16(Bt[n][k], At[m][k], acc[ai][bj][m][n], 0, 0, 0); __builtin_amdgcn_s_setprio(0); } while (0)
#define PG8_WAIT_V(n) asm volatile("s_waitcnt vmcnt(" #n ")" ::: "memory")
#define PG8_WAIT_L(n) asm volatile("s_waitcnt lgkmcnt(" #n ")" ::: "memory")
#define PG8_BAR __builtin_amdgcn_s_barrier()
#define PG8_SCHED __builtin_amdgcn_sched_barrier(0)
    Unit cur, nxt; int ui = 0;
    if (!S.next(0, cur)) return;
    f32x4 acc[2][2][4][2];
#pragma unroll
    for (int a = 0; a < 2; ++a)
#pragma unroll
        for (int b = 0; b < 2; ++b)
#pragma unroll
            for (int m = 0; m < 4; ++m)
#pragma unroll
                for (int n = 0; n < 2; ++n) acc[a][b][m][n] = (f32x4){0.f, 0.f, 0.f, 0.f};
    bf16x8 At[4][2], B0[2][2], B1[2][2];
    const char* cA = (const char*)g.A + (size_t)cur.pm * tstep; const char* cB = (const char*)g.Bt + (size_t)cur.pn * tstep;
    S.a_ready(cur);
    if constexpr (SP2) {
        PG8_STAGE(PG8_SB(0, 0), cB, voffB); PG8_STAGE(PG8_SB(0, 1), cB + hstep, voffB); PG8_STAGE(PG8_SA(0, 0), cA, voffA); PG8_STAGE(PG8_SA(0, 1), cA + hstep, voffA);
        if (wr == 1) PG8_BAR;
        PG8_WAIT_V(2); PG8_BAR;
        PG8_STAGE(PG8_SB(1, 0), cB + kstep, voffB); PG8_STAGE(PG8_SA(1, 0), cA + kstep, voffA); PG8_STAGE(PG8_SB(1, 1), cB + hstep + kstep, voffB);
        PG8_WAIT_V(6); PG8_BAR;
    } else {
        PG8_STAGE(PG8_SB(0, 0), cB, voffB); PG8_STAGE(PG8_SA(0, 0), cA, voffA); PG8_STAGE(PG8_SB(0, 1), cB + hstep, voffB); PG8_STAGE(PG8_SA(0, 1), cA + hstep, voffA);
        if (wr == 1) PG8_BAR;
        PG8_WAIT_V(4); PG8_BAR;
        PG8_STAGE(PG8_SB(1, 0), cB + kstep, voffB); PG8_STAGE(PG8_SA(1, 0), cA + kstep, voffA); PG8_STAGE(PG8_SB(1, 1), cB + hstep + kstep, voffB);
        PG8_WAIT_V(6); PG8_BAR;
    }
    for (;;) {
        const bool has_next = S.next(ui + 1, nxt);
        const char* nA = has_next ? (const char*)g.A + (size_t)nxt.pm * tstep : cA; const char* nB = has_next ? (const char*)g.Bt + (size_t)nxt.pn * tstep : cB;
        for (int t = 0; t < nt; t += 2) {
            const bool last = (t == nt - 2);
            const char* a1 = cA + (size_t)(t + 1) * kstep;
            const char* a2 = last ? nA : cA + (size_t)(t + 2) * kstep; const char* b2 = last ? nB : cB + (size_t)(t + 2) * kstep;
            const char* a3 = a2 + kstep; const char* b3 = b2 + kstep;
            if (last && has_next) S.a_ready(nxt);
            if constexpr (SP2) {
            PG8_LDB(B0, 0, 0); PG8_LDB(B1, 0, 1); PG8_SCHED; PG8_LDA(At, 0, 0); PG8_STAGE(PG8_SA(1, 1), a1 + hstep, voffA);
            PG8_WAIT_V(8); PG8_WAIT_L(0); PG8_BAR; PG8_MMA(0, 0, At, B0); PG8_MMA(0, 1, At, B1); PG8_BAR; PG8_SCHED;
            PG8_LDA(At, 0, 1); PG8_STAGE(PG8_SB(0, 0), b2, voffB); PG8_STAGE(PG8_SB(0, 1), b2 + hstep, voffB); PG8_STAGE(PG8_SA(0, 0), a2, voffA);
            PG8_WAIT_V(8); PG8_WAIT_L(0); PG8_BAR; PG8_MMA(1, 0, At, B0); PG8_MMA(1, 1, At, B1); PG8_BAR; PG8_SCHED;
            PG8_LDB(B0, 1, 0); PG8_LDB(B1, 1, 1); PG8_SCHED; PG8_LDA(At, 1, 0); PG8_STAGE(PG8_SA(0, 1), a2 + hstep, voffA);
            PG8_WAIT_V(8); PG8_WAIT_L(0); PG8_BAR; PG8_MMA(0, 0, At, B0); PG8_MMA(0, 1, At, B1); PG8_BAR; PG8_SCHED;
            PG8_LDA(At, 1, 1); PG8_STAGE(PG8_SB(1, 0), b3, voffB); PG8_STAGE(PG8_SB(1, 1), b3 + hstep, voffB); PG8_STAGE(PG8_SA(1, 0), a3, voffA);
            PG8_WAIT_V(8); PG8_WAIT_L(0); PG8_BAR; PG8_MMA(1, 0, At, B0); PG8_MMA(1, 1, At, B1); PG8_BAR; PG8_SCHED;
            } else {
            PG8_LDB(B0, 0, 0); PG8_SCHED; PG8_LDA(At, 0, 0); PG8_STAGE(PG8_SA(1, 1), a1 + hstep, voffA);
            PG8_WAIT_L(8); PG8_BAR; PG8_WAIT_L(0); PG8_MMA(0, 0, At, B0); PG8_BAR; PG8_SCHED;
            PG8_LDB(B1, 0, 1); PG8_STAGE(PG8_SB(0, 0), b2, voffB);
            PG8_BAR; PG8_WAIT_L(0); PG8_MMA(0, 1, At, B1); PG8_BAR;
            PG8_LDA(At, 0, 1); PG8_STAGE(PG8_SA(0, 0), a2, voffA);
            PG8_BAR; PG8_WAIT_L(0); PG8_MMA(1, 0, At, B0); PG8_BAR; PG8_SCHED;
            PG8_STAGE(PG8_SB(0, 1), b2 + hstep, voffB);
            PG8_WAIT_V(6); PG8_BAR; PG8_MMA(1, 1, At, B1); PG8_BAR;
            PG8_LDB(B0, 1, 0); PG8_SCHED; PG8_LDA(At, 1, 0); PG8_STAGE(PG8_SA(0, 1), a2 + hstep, voffA);
            PG8_WAIT_L(8); PG8_BAR; PG8_WAIT_L(0); PG8_MMA(0, 0, At, B0); PG8_BAR; PG8_SCHED;
            PG8_LDB(B1, 1, 1); PG8_STAGE(PG8_SB(1, 0), b3, voffB);
            PG8_BAR; PG8_WAIT_L(0); PG8_MMA(0, 1, At, B1); PG8_BAR;
            PG8_LDA(At, 1, 1); PG8_STAGE(PG8_SA(1, 0), a3, voffA);
            PG8_BAR; PG8_WAIT_L(0); PG8_MMA(1, 0, At, B0); PG8_BAR; PG8_SCHED;
            PG8_STAGE(PG8_SB(1, 1), b3 + hstep, voffB);
            PG8_WAIT_V(6); PG8_BAR; PG8_MMA(1, 1, At, B1); PG8_BAR;
            }
        }
        if constexpr (ALIGN_EPI) { if (wr == 0) PG8_BAR; }
        if constexpr (!Epi::AFTER_DRAIN) { E(acc, cur, wr, wc, fr, fq); S.done(cur); }
        if (!has_next) break;
#pragma unroll
        for (int a = 0; a < 2; ++a)
#pragma unroll
            for (int b = 0; b < 2; ++b)
#pragma unroll
                for (int m = 0; m < 4; ++m)
#pragma unroll
                    for (int n = 0; n < 2; ++n) acc[a][b][m][n] = (f32x4){0.f, 0.f, 0.f, 0.f};
        cur = nxt; cA = nA; cB = nB; ++ui;
        if constexpr (ALIGN_EPI) { if (wr == 1) PG8_BAR; }
    }
    PG8_WAIT_V(0);
    if constexpr (!ALIGN_EPI) { if (wr == 0) PG8_BAR; }
    PG8_BAR;
    if constexpr (Epi::AFTER_DRAIN) { E.fused(acc, cur, wr, wc, fr, fq, lds, wid, lane); S.done(cur); }
#undef PG8_SA
#undef PG8_SB
#undef PG8_STAGE
#undef PG8_LDA
#undef PG8_LDB
#undef PG8_MMA
#undef PG8_WAIT_V
#undef PG8_WAIT_L
#undef PG8_BAR
#undef PG8_SCHED
}
template <class Epi, class Sched, bool ALIGN_EPI = false>
__device__ __forceinline__ void gemm_phase_g(PG8_LAS unsigned char* lds, const Gemm g, const Sched& S, const Epi& E) {
    const int tid = threadIdx.x, wid = __builtin_amdgcn_readfirstlane(tid >> 6), lane = tid & 63, wr = wid >> 2, wc = wid & 3, fr = lane & 15, fq = lane >> 4;
    const int K = g.K, nt = K / BK;
    unsigned voffB[2], colA[2]; int rowA[2];
#pragma unroll
    for (int i = 0; i < 2; ++i) { int R, C; stage_rc(tid * 16 + i * 8192, R, C); const int Rb = Epi::PERM ? ((R & ~31) + perm32(R & 31)) : R;
        rowA[i] = R; colA[i] = (unsigned)C * 2u; voffB[i] = (unsigned)(Rb * K + C) * 2u; }
    const size_t kstep = (size_t)(BK * 2);
    const size_t hstep = (size_t)HALF * K * 2;
    const size_t tstep = 2 * hstep;
    const unsigned ldsw = (unsigned)wid * 1024u;
    const int aoff = lds_byte(wr * 64 + fr, fq * 8), boff = lds_byte(wc * 32 + fr, fq * 8);
#define PG8_SA(b, h) (((b) * 2 + (h)) * HTB)
#define PG8_SB(b, h) ((4 + (b) * 2 + (h)) * HTB)
#define PG8_STAGE(bufoff, gbase, voff) do { _Pragma("unroll") for (int _i = 0; _i < 2; ++_i) \
        __builtin_amdgcn_global_load_lds((const unsigned*)((const char*)(gbase) + (voff)[_i]), (PG8_LAS unsigned*)(lds + (bufoff) + ldsw + _i * 8192), 16, 0, 0); } while (0)
#define PG8_STAGE_AG(bufoff, kbyte, arr) do { _Pragma("unroll") for (int _i = 0; _i < 2; ++_i) \
        __builtin_amdgcn_global_load_lds((const unsigned*)((const char*)g.A + (size_t)(kbyte) + (arr)[_i]), (PG8_LAS unsigned*)(lds + (bufoff) + ldsw + _i * 8192), 16, 0, 0); } while (0)
#define PG8_AOFF(dst, un) do { _Pragma("unroll") for (int _h = 0; _h < 2; ++_h) _Pragma("unroll") for (int _i = 0; _i < 2; ++_i) dst[_h][_i] = S.arow(un, _h * HALF + rowA[_i]) + colA[_i]; } while (0)
#define PG8_LDA(dst, b, h) do { _Pragma("unroll") for (int m = 0; m < 4; ++m) _Pragma("unroll") for (int k = 0; k < 2; ++k) dst[m][k] = *(const PG8_LAS bf16x8*)(lds + PG8_SA(b, h) + aoff + m * 2048 + k * 1024); } while (0)
#define PG8_LDB(dst, b, h) do { _Pragma("unroll") for (int n = 0; n < 2; ++n) _Pragma("unroll") for (int k = 0; k < 2; ++k) dst[n][k] = *(const PG8_LAS bf16x8*)(lds + PG8_SB(b, h) + boff + n * 2048 + k * 1024); } while (0)
#define PG8_MMA(ai, bj, At, Bt) do { __builtin_amdgcn_s_setprio(1); _Pragma("unroll") for (int m = 0; m < 4; ++m) _Pragma("unroll") for (int n = 0; n < 2; ++n) _Pragma("unroll") for (int k = 0; k < 2; ++k) \
        acc[ai][bj][m][n] = __builtin_amdgcn_mfma_f32_16x16x32_bf16(Bt[n][k], At[m][k], acc[ai][bj][m][n], 0, 0, 0); __builtin_amdgcn_s_setprio(0); } while (0)
#define PG8_WAIT_V(n) asm volatile("s_waitcnt vmcnt(" #n ")" ::: "memory")
#define PG8_WAIT_L(n) asm volatile("s_waitcnt lgkmcnt(" #n ")" ::: "memory")
#define PG8_BAR __builtin_amdgcn_s_barrier()
#define PG8_SCHED __builtin_amdgcn_sched_barrier(0)
    Unit cur, nxt; int ui = 0;
    if (!S.next(0, cur)) return;
    f32x4 acc[2][2][4][2];
#pragma unroll
    for (int a = 0; a < 2; ++a)
#pragma unroll
        for (int b = 0; b < 2; ++b)
#pragma unroll
            for (int m = 0; m < 4; ++m)
#pragma unroll
                for (int n = 0; n < 2; ++n) acc[a][b][m][n] = (f32x4){0.f, 0.f, 0.f, 0.f};
    bf16x8 At[4][2], B0[2][2], B1[2][2];
    unsigned ca[2][2], na[2][2]; PG8_AOFF(ca, cur);
    const char* cB = (const char*)g.Bt + (size_t)cur.pn * tstep;
    S.a_ready(cur);
    {
        PG8_STAGE(PG8_SB(0, 0), cB, voffB); PG8_STAGE(PG8_SB(0, 1), cB + hstep, voffB); PG8_STAGE_AG(PG8_SA(0, 0), 0, ca[0]); PG8_STAGE_AG(PG8_SA(0, 1), 0, ca[1]);
        if (wr == 1) PG8_BAR;
        PG8_WAIT_V(2); PG8_BAR;
        PG8_STAGE(PG8_SB(1, 0), cB + kstep, voffB); PG8_STAGE_AG(PG8_SA(1, 0), kstep, ca[0]); PG8_STAGE(PG8_SB(1, 1), cB + hstep + kstep, voffB);
        PG8_WAIT_V(6); PG8_BAR;
    }
    for (;;) {
        const bool has_next = S.next(ui + 1, nxt);
        if (has_next) { PG8_AOFF(na, nxt); } else { _Pragma("unroll") for (int _h = 0; _h < 2; ++_h) _Pragma("unroll") for (int _i = 0; _i < 2; ++_i) na[_h][_i] = ca[_h][_i]; }
        const char* nB = has_next ? (const char*)g.Bt + (size_t)nxt.pn * tstep : cB;
        for (int t = 0; t < nt; t += 2) {
            const bool last = (t == nt - 2);
            const size_t ka1 = (size_t)(t + 1) * kstep, ka2 = last ? 0 : (size_t)(t + 2) * kstep, ka3 = ka2 + kstep;
            unsigned s2[2][2];
            _Pragma("unroll") for (int _h = 0; _h < 2; ++_h) _Pragma("unroll") for (int _i = 0; _i < 2; ++_i) s2[_h][_i] = last ? na[_h][_i] : ca[_h][_i];
            const char* b2 = last ? nB : cB + (size_t)(t + 2) * kstep; const char* b3 = b2 + kstep;
            if (last && has_next) S.a_ready(nxt);
            {
            PG8_LDB(B0, 0, 0); PG8_LDB(B1, 0, 1); PG8_SCHED; PG8_LDA(At, 0, 0); PG8_STAGE_AG(PG8_SA(1, 1), ka1, ca[1]);
            PG8_WAIT_V(8); PG8_WAIT_L(0); PG8_BAR; PG8_MMA(0, 0, At, B0); PG8_MMA(0, 1, At, B1); PG8_BAR; PG8_SCHED;
            PG8_LDA(At, 0, 1); PG8_STAGE(PG8_SB(0, 0), b2, voffB); PG8_STAGE(PG8_SB(0, 1), b2 + hstep, voffB); PG8_STAGE_AG(PG8_SA(0, 0), ka2, s2[0]);
            PG8_WAIT_V(8); PG8_WAIT_L(0); PG8_BAR; PG8_MMA(1, 0, At, B0); PG8_MMA(1, 1, At, B1); PG8_BAR; PG8_SCHED;
            PG8_LDB(B0, 1, 0); PG8_LDB(B1, 1, 1); PG8_SCHED; PG8_LDA(At, 1, 0); PG8_STAGE_AG(PG8_SA(0, 1), ka2, s2[1]);
            PG8_WAIT_V(8); PG8_WAIT_L(0); PG8_BAR; PG8_MMA(0, 0, At, B0); PG8_MMA(0, 1, At, B1); PG8_BAR; PG8_SCHED;
            PG8_LDA(At, 1, 1); PG8_STAGE(PG8_SB(1, 0), b3, voffB); PG8_STAGE(PG8_SB(1, 1), b3 + hstep, voffB); PG8_STAGE_AG(PG8_SA(1, 0), ka3, s2[0]);
            PG8_WAIT_V(8); PG8_WAIT_L(0); PG8_BAR; PG8_MMA(1, 0, At, B0); PG8_MMA(1, 1, At, B1); PG8_BAR; PG8_SCHED;
            }
        }
        if constexpr (ALIGN_EPI) { if (wr == 0) PG8_BAR; }
        if constexpr (!Epi::AFTER_DRAIN) { E(acc, cur, wr, wc, fr, fq); S.done(cur); }
        if (!has_next) break;
#pragma unroll
        for (int a = 0; a < 2; ++a)
#pragma unroll
            for (int b = 0; b < 2; ++b)
#pragma unroll
                for (int m = 0; m < 4; ++m)
#pragma unroll
                    for (int n = 0; n < 2; ++n) acc[a][b][m][n] = (f32x4){0.f, 0.f, 0.f, 0.f};
        cur = nxt; cB = nB; ++ui;
        _Pragma("unroll") for (int _h = 0; _h < 2; ++_h) _Pragma("unroll") for (int _i = 0; _i < 2; ++_i) ca[_h][_i] = na[_h][_i];
        if constexpr (ALIGN_EPI) { if (wr == 1) PG8_BAR; }
    }
    PG8_WAIT_V(0);
    if constexpr (!ALIGN_EPI) { if (wr == 0) PG8_BAR; }
    PG8_BAR;
    if constexpr (Epi::AFTER_DRAIN) { E.fused(acc, cur, wr, wc, fr, fq, lds, wid, lane); S.done(cur); }
#undef PG8_SA
#undef PG8_SB
#undef PG8_STAGE
#undef PG8_STAGE_AG
#undef PG8_AOFF
#undef PG8_LDA
#undef PG8_LDB
#undef PG8_MMA
#undef PG8_WAIT_V
#undef PG8_WAIT_L
#undef PG8_BAR
#undef PG8_SCHED
}
}
#define XB_TMO      128
#define XB_XCNT(j)  (256  + 64 * (j))
#define XB_XSUB(j)  (1280 + 64 * (j))
#define XB_XGEN(j)  (2304 + 64 * (j))
#define XB_TOP      3328
#define XB_TOPGEN   3392
#define XCD_BAR_WORDS 3456
#define XB_SPIN_CAP (1u << 18)

__device__ __forceinline__ unsigned xb_ld(unsigned* p)              { return __hip_atomic_load(p, __ATOMIC_RELAXED, __HIP_MEMORY_SCOPE_AGENT); }
__device__ __forceinline__ unsigned xb_add(unsigned* p, unsigned v) { return __hip_atomic_fetch_add(p, v, __ATOMIC_RELAXED, __HIP_MEMORY_SCOPE_AGENT); }
__device__ __forceinline__ unsigned xb_xcc_id() { return (unsigned)__builtin_amdgcn_s_getreg((3 << 11) | 20) & 0xFu; }
#define XB_SPIN(cond, bar) do { unsigned _sp = 0; while (cond) { __builtin_amdgcn_s_sleep(1); \
    if ((++_sp & 255u) == 0u) { if (xb_ld(&(bar)[XB_TMO])) break; if (_sp > XB_SPIN_CAP) { atomicAdd(&(bar)[XB_TMO], 1u); break; } } } } while (0)

struct XcdBarrier {
    unsigned* bar; unsigned x;
    volatile LAS unsigned* st;
};

__device__ __forceinline__ XcdBarrier xcd_barrier_post(unsigned* bar, volatile LAS unsigned* st) {
    XcdBarrier b; b.bar = bar; b.x = xb_xcc_id(); b.st = st;
    if (threadIdx.x == 0) (void)xb_add(&bar[XB_XCNT(b.x)], 1u);
    return b;
}
__device__ __forceinline__ void xcd_barrier_complete(unsigned* bar, unsigned x, unsigned& nloc, unsigned& nx) {
    const unsigned G = gridDim.x * gridDim.y * gridDim.z;
    unsigned sum, cnt, mine, sp = 0u;
    for (;;) {
        sum = 0u; cnt = 0u; mine = 0u;
#pragma unroll
        for (unsigned j = 0; j < 16; ++j) { const unsigned c = xb_ld(&bar[XB_XCNT(j)]); sum += c; cnt += (c > 0u) ? 1u : 0u; mine = (j == x) ? c : mine; }
        if (sum == G) break;
        __builtin_amdgcn_s_sleep(1);
        if ((++sp & 255u) == 0u) { if (xb_ld(&bar[XB_TMO])) break; if (sp > XB_SPIN_CAP) { atomicAdd(&bar[XB_TMO], 1u); break; } }
    }
    nloc = mine > 0u ? mine : 1u; nx = cnt > 0u ? cnt : 1u;
}

__device__ __forceinline__ void xcd_barrier(const XcdBarrier& b) {
    asm volatile("s_waitcnt vmcnt(0)" ::: "memory");
    __syncthreads();
    if (threadIdx.x == 0) {
        unsigned* bar = b.bar;
        __builtin_amdgcn_s_waitcnt(0);
        unsigned nloc = b.st[0], nx = b.st[1];
        if (nloc == 0u) { xcd_barrier_complete(bar, b.x, nloc, nx); b.st[0] = nloc; b.st[1] = nx; }
        const unsigned old = xb_add(&bar[XB_XSUB(b.x)], 1u);
        const unsigned gen = old / nloc;
        if (old + 1u == (gen + 1u) * nloc) {
            __builtin_amdgcn_fence(__ATOMIC_RELEASE, "agent");
            asm volatile("s_waitcnt vmcnt(0)" ::: "memory");
            const unsigned og = xb_add(&bar[XB_TOP], 1u);
            const unsigned tg = og / nx;
            if (og + 1u == (tg + 1u) * nx) xb_add(&bar[XB_TOPGEN], 1u);
            else XB_SPIN(xb_ld(&bar[XB_TOPGEN]) == tg, bar);
            __builtin_amdgcn_fence(__ATOMIC_ACQUIRE, "agent");
            xb_add(&bar[XB_XGEN(b.x)], 1u);
            asm volatile("s_waitcnt vmcnt(0)" ::: "memory");
        } else {
            XB_SPIN(xb_ld(&bar[XB_XGEN(b.x)]) == gen, bar);
            __builtin_amdgcn_fence(__ATOMIC_ACQUIRE, "agent");
            asm volatile("s_waitcnt vmcnt(0)" ::: "memory");
        }
    }
    __syncthreads();
}

namespace att {
constexpr int PITCH = NIN;
constexpr int STAGE = 65536, SUB = 16384;
typedef short v4i16_t __attribute__((ext_vector_type(4)));
constexpr float THR2 = 11.5f;
constexpr float PSKIP = -140.f;
#define KSWZ(row, colB) ((row) * 256 + ((colB) ^ (((row) & 7) << 4)))
#define SBAR() __builtin_amdgcn_sched_barrier(0)
__device__ __forceinline__ int v_rd_base(int lane) { return ((lane & 3) << 3) | (((lane >> 2) & 3) << 6) | (((lane >> 4) & 1) << 5) | (((lane >> 5) & 1) << 8); }
constexpr int v_rd_off(int d0, int ks, int half) { return d0 * 512 + ks * 4096 + half * 2048; }
__device__ __forceinline__ int crow(int r, int hi) { return (r & 3) + 8 * (r >> 2) + 4 * hi; }
__device__ __forceinline__ unsigned cvtpk(float lo, float hi) { unsigned r; asm volatile("v_cvt_pk_bf16_f32 %0, %1, %2" : "=v"(r) : "v"(lo), "v"(hi)); return r; }

__device__ __forceinline__ void qkt(f32x16& p0, f32x16& p1, const LAS unsigned char* Ks, int r32, int hi, const bf16x8* qr) {
    const LAS unsigned char* kb[4];
#pragma unroll
    for (int dd = 0; dd < 4; ++dd) kb[dd] = Ks + KSWZ(r32, (dd * 16 + hi * 8) * 2);
#pragma unroll
    for (int d0 = 0; d0 < 8; ++d0) { const LAS unsigned char* a = kb[d0 & 3] + (d0 >> 2) * 128;
        const bf16x8 b0 = *(const LAS bf16x8*)a;
        const bf16x8 b1 = *(const LAS bf16x8*)(a + 32 * 256);
        p0 = __builtin_amdgcn_mfma_f32_32x32x16_bf16(b0, qr[d0], p0, 0, 0, 0);
        p1 = __builtin_amdgcn_mfma_f32_32x32x16_bf16(b1, qr[d0], p1, 0, 0, 0); }
}
__device__ __forceinline__ void pv_tile(f32x16* o, unsigned vb0, bf16x8 pa0, bf16x8 pa1, bf16x8 pa2, bf16x8 pa3) {
#define TRRD(dst, off) asm volatile("ds_read_b64_tr_b16 %0, %1 offset:%2" : "=&v"(dst) : "v"(vb0), "i"(off) : "memory")
#define PV_D0(d0) do { s16x4 l0, l1, l2, l3, h0, h1, h2, h3; constexpr int b_ = v_rd_off(d0, 0, 0); \
        TRRD(l0, b_); TRRD(h0, b_ + 2048); TRRD(l1, b_ + 4096); TRRD(h1, b_ + 6144); TRRD(l2, b_ + 8192); TRRD(h2, b_ + 10240); TRRD(l3, b_ + 12288); TRRD(h3, b_ + 14336); \
        asm volatile("s_waitcnt lgkmcnt(0)" ::: "memory"); SBAR(); \
        o[d0] = __builtin_amdgcn_mfma_f32_32x32x16_bf16(pa0, (bf16x8){l0[0], l0[1], l0[2], l0[3], h0[0], h0[1], h0[2], h0[3]}, o[d0], 0, 0, 0); \
        o[d0] = __builtin_amdgcn_mfma_f32_32x32x16_bf16(pa1, (bf16x8){l1[0], l1[1], l1[2], l1[3], h1[0], h1[1], h1[2], h1[3]}, o[d0], 0, 0, 0); \
        o[d0] = __builtin_amdgcn_mfma_f32_32x32x16_bf16(pa2, (bf16x8){l2[0], l2[1], l2[2], l2[3], h2[0], h2[1], h2[2], h2[3]}, o[d0], 0, 0, 0); \
        o[d0] = __builtin_amdgcn_mfma_f32_32x32x16_bf16(pa3, (bf16x8){l3[0], l3[1], l3[2], l3[3], h3[0], h3[1], h3[2], h3[3]}, o[d0], 0, 0, 0); } while (0)
    PV_D0(0); PV_D0(1); PV_D0(2); PV_D0(3);
#undef PV_D0
#undef TRRD
}
__device__ __forceinline__ void glds16(const bf16* g, LAS unsigned char* l) {
    __builtin_amdgcn_global_load_lds((const unsigned*)g, (LAS unsigned*)l, 16, 0, 0);
}

template <int DIFF, int HF>
__device__ __forceinline__ void half_step(f32x16* o, float& m_reg, float& l_reg, const bf16x8* qr, const LAS unsigned char* Kst, unsigned vb0, LAS float* al_l,
                                          int kbh, int q0, int r32, int hi, float slope2, bool selbit, int pmode = 0) {
    constexpr int NO = DIFF ? 8 : 4;
    if (kbh > q0 + 31) return;
    float binit = slope2 * (float)(kbh - (q0 + r32) + 4 * hi);
    if (!selbit) binit = -__builtin_inff();
    f32x16 p;
#pragma unroll
    for (int r = 0; r < 16; ++r) p[r] = fmaf(slope2, (float)((r & 3) + 8 * (r >> 2)), binit);
    if (!(pmode & 16)) {
        const LAS unsigned char* kb4[4];
#pragma unroll
        for (int dd = 0; dd < 4; ++dd) kb4[dd] = Kst + KSWZ(r32, (dd * 16 + hi * 8) * 2) + HF * 8192;
        if (DIFF) {
            bf16x8 kf[4];
#pragma unroll
            for (int d0 = 0; d0 < 4; ++d0) kf[d0] = *(const LAS bf16x8*)(kb4[d0]);
            SBAR();
#pragma unroll
            for (int d0 = 0; d0 < 4; ++d0) { p = __builtin_amdgcn_mfma_f32_32x32x16_bf16(kf[d0], qr[d0], p, 0, 0, 0); kf[d0] = *(const LAS bf16x8*)(kb4[d0] + 128); }
            SBAR();
#pragma unroll
            for (int d0 = 0; d0 < 4; ++d0) p = __builtin_amdgcn_mfma_f32_32x32x16_bf16(kf[d0], qr[4 + d0], p, 0, 0, 0);
        } else {
            bf16x8 kf[8];
#pragma unroll
            for (int d0 = 0; d0 < 8; ++d0) kf[d0] = *(const LAS bf16x8*)(kb4[d0 & 3] + (d0 >> 2) * 128);
            SBAR();
#pragma unroll
            for (int d0 = 0; d0 < 8; ++d0) p = __builtin_amdgcn_mfma_f32_32x32x16_bf16(kf[d0], qr[d0], p, 0, 0, 0);
        }
    }
    if (kbh + 31 > q0) {
        const int dq = q0 + r32 - kbh - 4 * hi; const float NEG = -__builtin_inff();
#pragma unroll
        for (int r = 0; r < 16; ++r) { const int c = (r & 3) + 8 * (r >> 2); if (c > dq) p[r] = NEG; }
    }
    float pmax = p[0];
#pragma unroll
    for (int r = 1; r < 16; ++r) pmax = fmaxf(pmax, p[r]);
    { auto rr = __builtin_amdgcn_permlane32_swap(__float_as_uint(pmax), __float_as_uint(pmax), false, false); pmax = fmaxf(__uint_as_float(rr[0]), __uint_as_float(rr[1])); }
    if (__all(pmax - m_reg < PSKIP)) return;
    float mn, alpha;
    if (__all(pmax - m_reg <= THR2)) { mn = m_reg; alpha = 1.f; }
    else { mn = fmaxf(m_reg, pmax); alpha = __builtin_amdgcn_exp2f(m_reg - mn); m_reg = mn; }
    float ps = 0.f;
    if (!(pmode & 8)) {
#pragma unroll
    for (int r = 0; r < 16; ++r) p[r] = __builtin_amdgcn_exp2f(p[r] - mn);
#pragma unroll
    for (int r = 0; r < 16; ++r) ps += p[r];
    }
    { auto rr = __builtin_amdgcn_permlane32_swap(__float_as_uint(ps), __float_as_uint(ps), false, false); ps = __uint_as_float(rr[0]) + __uint_as_float(rr[1]); }
    l_reg = l_reg * alpha + ps;
    bf16x8 pa0, pa1;
#define PK4(P, B_, OUT) do { unsigned a0 = cvtpk(P[B_ + 0], P[B_ + 1]), a1 = cvtpk(P[B_ + 2], P[B_ + 3]); \
        unsigned b0 = cvtpk(P[B_ + 4], P[B_ + 5]), b1 = cvtpk(P[B_ + 6], P[B_ + 7]); \
        auto r0 = __builtin_amdgcn_permlane32_swap(a0, b0, false, false); auto r1 = __builtin_amdgcn_permlane32_swap(a1, b1, false, false); \
        u32x4 w = {r0[0], r1[0], r0[1], r1[1]}; OUT = __builtin_bit_cast(bf16x8, w); } while (0)
    PK4(p, 0, pa0); PK4(p, 8, pa1);
#undef PK4
    if (__any(alpha < 1.f)) {
        if (hi == 0) al_l[r32] = alpha;
        asm volatile("s_waitcnt lgkmcnt(0)" ::: "memory");
#pragma unroll
        for (int r = 0; r < 16; ++r) { const float a = al_l[crow(r, hi)];
#pragma unroll
            for (int d = 0; d < NO; ++d) o[d][r] *= a; }
    }
    if (!(pmode & 4)) {
        const LAS unsigned char* vp = (const LAS unsigned char*)(uintptr_t)vb0;
#define VTR(off) __builtin_bit_cast(s16x4, __builtin_amdgcn_ds_read_tr16_b64_v4i16((LAS v4i16_t*)(vp + (off))))
#define GOFF(g) (((g) >> 2) * SUB + v_rd_off((g) & 3, 2 * HF, 0))
#define LOADG(V, g) do { V[0] = VTR(GOFF(g)); V[1] = VTR(GOFF(g) + 2048); V[2] = VTR(GOFF(g) + 4096); V[3] = VTR(GOFF(g) + 6144); } while (0)
#define MMAG(V, g) do { o[g] = __builtin_amdgcn_mfma_f32_32x32x16_bf16(pa0, (bf16x8){V[0][0], V[0][1], V[0][2], V[0][3], V[1][0], V[1][1], V[1][2], V[1][3]}, o[g], 0, 0, 0); \
                        o[g] = __builtin_amdgcn_mfma_f32_32x32x16_bf16(pa1, (bf16x8){V[2][0], V[2][1], V[2][2], V[2][3], V[3][0], V[3][1], V[3][2], V[3][3]}, o[g], 0, 0, 0); } while (0)
        s16x4 va[4], vc[4];
        LOADG(va, 0); LOADG(vc, 1); SBAR();
        MMAG(va, 0); LOADG(va, 2); SBAR();
        MMAG(vc, 1); LOADG(vc, 3); SBAR();
        if (DIFF) {
            MMAG(va, 2); LOADG(va, 4); SBAR();
            MMAG(vc, 3); LOADG(vc, 5); SBAR();
            MMAG(va, 4); LOADG(va, 6); SBAR();
            MMAG(vc, 5); LOADG(vc, 7); SBAR();
            MMAG(va, 6); SBAR();
            MMAG(vc, 7);
        } else {
            MMAG(va, 2); SBAR();
            MMAG(vc, 3);
        }
#undef MMAG
#undef LOADG
#undef GOFF
#undef VTR
    }
}

template <int DIFF>
__device__ __forceinline__ void attn_unit(LAS unsigned char* lds, const bf16* __restrict__ proj, bf16* __restrict__ mixed, const float* __restrict__ kmp,
                                          int b, int h, int idx, float lam, const float* __restrict__ subw, int pmode = 0) {
    constexpr int NO = DIFF ? 8 : 4;
    const int tid = threadIdx.x, lane = tid & 63, wid = __builtin_amdgcn_readfirstlane(tid >> 6), r32 = lane & 31, hi = lane >> 5;
    const int rg = wid & 3, comp = wid >> 2;
    const int q0 = DIFF ? (128 * idx + 32 * rg) : (256 * idx + 32 * wid);
    const size_t rowbase = (size_t)b * SEQ;
    const int qcol = DIFF ? (3072 + 256 * h + 128 * comp) : (128 * h);
    const int kcol = DIFF ? (4096 + 256 * h) : (1024 + 128 * h);
    const int vcol = DIFF ? (5120 + 256 * h) : (2048 + 128 * h);
    const float slope2 = (DIFF ? __builtin_amdgcn_exp2f(-2.f * (float)(h + 1)) : __builtin_amdgcn_exp2f(-(float)(h + 1))) * LOG2E;
    const int NT = DIFF ? 2 * (idx + 1) : 4 * (idx + 1);
    int koff, voff;
    { const int row = 4 * wid + (lane >> 4), ch = (lane & 15) ^ (row & 7); koff = row * PITCH + 8 * ch;
      const int sub = 2 * wid + (lane >> 5), kk = 8 * (sub >> 2) + ((lane & 31) >> 2), k = (kk & ~0xC) | ((kk & 4) << 1) | ((kk & 8) >> 1), c = 32 * (sub & 3) + 8 * (lane & 3);
      voff = k * PITCH + c; }
    LAS unsigned char* const dst0 = lds + wid * 1024;
#define ISSUE_TILE(st, kb_) do { const bf16* g_ = proj + (rowbase + (size_t)(kb_)) * PITCH; LAS unsigned char* d_ = dst0 + (st) * STAGE; \
        _Pragma("unroll") for (int i_ = 0; i_ < 2; ++i_) { \
            glds16(g_ + kcol + koff + i_ * 32 * PITCH, d_ + i_ * 8192); \
            if (DIFF) { glds16(g_ + kcol + 128 + koff + i_ * 32 * PITCH, d_ + SUB + i_ * 8192); \
                        glds16(g_ + vcol + voff + i_ * 32 * PITCH, d_ + 2 * SUB + i_ * 8192); \
                        glds16(g_ + vcol + 128 + voff + i_ * 32 * PITCH, d_ + 3 * SUB + i_ * 8192); } \
            else { glds16(g_ + vcol + voff + i_ * 32 * PITCH, d_ + SUB + i_ * 8192); } } } while (0)
#define TILE_KB(t_) (DIFF ? 64 * (NT - 1 - (t_)) : ((t_) < 4 ? 256 * idx + 64 * (3 - (t_)) : 256 * (idx - 1 - (((t_) - 4) >> 2)) + 64 * (3 - (((t_) - 4) & 3))))
    ISSUE_TILE(0, TILE_KB(0));
    if (!DIFF && idx > 0) {
        const int row = tid >> 4, ch = tid & 15; u32x4 w = {0u, 0u, 0u, 0u};
        if (row < 16) { const float* s0 = kmp + ((size_t)((b * 8 + h) * 16 + row) * 2) * 128 + 8 * ch;
            const f32x4 a0 = *(const f32x4*)s0, a1 = *(const f32x4*)(s0 + 4), b0 = *(const f32x4*)(s0 + 128), b1 = *(const f32x4*)(s0 + 132);
            const f32x4 m0 = (a0 + b0) * (1.f / 256.f), m1 = (a1 + b1) * (1.f / 256.f);
            w.x = cvtpk(m0[0], m0[1]); w.y = cvtpk(m0[2], m0[3]); w.z = cvtpk(m1[0], m1[1]); w.w = cvtpk(m1[2], m1[3]); }
        *(LAS u32x4*)(lds + STAGE + KSWZ(row, 16 * ch)) = w;
    }
    bf16x8 qr[8];
    { const bf16* qp = proj + (rowbase + q0 + r32) * PITCH + qcol + hi * 8;
#pragma unroll
      for (int d0 = 0; d0 < 8; ++d0) qr[d0] = *(const bf16x8*)(qp + d0 * 16); }
    LAS float* const al_l = (LAS float*)(lds + ATT_SCR_OFF + wid * 512);
    LAS float* const li_l = al_l + 32;
    unsigned sel = 0u;
    if (!DIFF && idx > 0) {
        asm volatile("s_waitcnt vmcnt(0)" ::: "memory"); __syncthreads();
        f32x16 g = {};
        { const LAS unsigned char* Ks = lds + STAGE;
#pragma unroll
          for (int d0 = 0; d0 < 8; ++d0) { const LAS unsigned char* a = Ks + KSWZ(r32, ((d0 & 3) * 16 + hi * 8) * 2) + (d0 >> 2) * 128;
              g = __builtin_amdgcn_mfma_f32_32x32x16_bf16(*(const LAS bf16x8*)a, qr[d0], g, 0, 0, 0); } }
        float gv[16]; int gn[16];
#pragma unroll
        for (int r = 0; r < 8; ++r) { const int nb = (r & 3) + 8 * (r >> 2);
            gv[r] = g[r]; gn[r] = nb + 4 * hi; gv[8 + r] = __shfl_xor(g[r], 32); gn[8 + r] = nb + 4 * (1 - hi); }
        const float NEG = -__builtin_inff();
        float m1 = NEG, m2 = NEG, m3 = NEG;
#pragma unroll
        for (int i = 0; i < 16; ++i) { float v = gn[i] < idx ? gv[i] : NEG;
            float t1 = fmaxf(m1, v); v = fminf(m1, v); m1 = t1; float t2 = fmaxf(m2, v); v = fminf(m2, v); m2 = t2; m3 = fmaxf(m3, v); }
#pragma unroll
        for (int i = 0; i < 16; ++i) if (gn[i] < idx && gv[i] >= m3) sel |= 1u << gn[i];
    }
    float m_reg = -1e30f, l_reg = 0.f;
    f32x16 o[NO];
#pragma unroll
    for (int d = 0; d < NO; ++d) o[d] = f32x16{};
    const unsigned ldsu = (unsigned)(uintptr_t)lds;
    const int ksub = DIFF ? comp : 0;
    for (int t = 0; t < NT; ++t) {
        asm volatile("s_waitcnt vmcnt(0)" ::: "memory"); __syncthreads();
        if (t + 1 < NT && !(pmode & 1)) ISSUE_TILE((t + 1) & 1, TILE_KB(t + 1));
        const int kb = TILE_KB(t);
        const bool past = !DIFF && t >= 4;
        const bool selbit = past ? (((sel >> (idx - 1 - ((t - 4) >> 2))) & 1u) != 0u) : true;
        const int stoff = (t & 1) * STAGE;
        const LAS unsigned char* Kst = lds + stoff + ksub * SUB;
        const unsigned vb0 = ldsu + stoff + (DIFF ? 2 : 1) * SUB + v_rd_base(lane);
        if (!(pmode & 2)) {
        half_step<DIFF, 1>(o, m_reg, l_reg, qr, Kst, vb0, al_l, kb + 32, q0, r32, hi, slope2, selbit, pmode);
        half_step<DIFF, 0>(o, m_reg, l_reg, qr, Kst, vb0, al_l, kb, q0, r32, hi, slope2, selbit, pmode);
        }
    }
    if (hi == 0) li_l[r32] = l_reg;
    asm volatile("s_waitcnt lgkmcnt(0)" ::: "memory");
    float rli[16];
#pragma unroll
    for (int r = 0; r < 16; ++r) rli[r] = __builtin_amdgcn_rcpf(li_l[crow(r, hi)]);
    if (!DIFF) {
        bf16* Ow = mixed + (rowbase + q0) * D + 128 * h;
#pragma unroll
        for (int r = 0; r < 16; ++r) { const int orow = crow(r, hi);
#pragma unroll
            for (int d0 = 0; d0 < 4; ++d0) { const float v = o[d0][r] * rli[r]; const float vn = __shfl_xor(v, 1);
                if ((r32 & 1) == 0) *(unsigned*)(Ow + (size_t)orow * D + d0 * 32 + r32) = cvtpk(v, vn); } }
        __syncthreads();
    } else {
        __syncthreads();
        LAS float* xb = (LAS float*)(lds + rg * 32768) + lane;
        if (comp == 1) {
#pragma unroll
            for (int d0 = 0; d0 < 8; ++d0)
#pragma unroll
                for (int r = 0; r < 16; ++r) xb[(d0 * 16 + r) * 64] = lam * o[d0][r] * rli[r];
        }
        __syncthreads();
        if (comp == 0) {
            float ssq[16];
#pragma unroll
            for (int r = 0; r < 16; ++r) ssq[r] = 0.f;
#pragma unroll
            for (int d0 = 0; d0 < 8; ++d0)
#pragma unroll
                for (int r = 0; r < 16; ++r) { const float dv = o[d0][r] * rli[r] - xb[(d0 * 16 + r) * 64]; o[d0][r] = dv; ssq[r] += dv * dv; }
#pragma unroll
            for (int r = 0; r < 16; ++r) { float s = ssq[r]; s += __shfl_xor(s, 1); s += __shfl_xor(s, 2); s += __shfl_xor(s, 4); s += __shfl_xor(s, 8); s += __shfl_xor(s, 16);
                ssq[r] = __builtin_amdgcn_rsqf(s * (1.f / 256.f) + RMS_EPS) * 0.8f; }
            bf16* Ow = mixed + (rowbase + q0) * D + 1024 + 256 * h;
#pragma unroll
            for (int d0 = 0; d0 < 8; ++d0) { const float wv = subw[d0 * 32 + r32];
#pragma unroll
                for (int r = 0; r < 16; ++r) { const float v = o[d0][r] * ssq[r] * wv; const float vn = __shfl_xor(v, 1);
                    if ((r32 & 1) == 0) *(unsigned*)(Ow + (size_t)crow(r, hi) * D + d0 * 32 + r32) = cvtpk(v, vn); } }
        }
        __syncthreads();
    }
#undef ISSUE_TILE
#undef TILE_KB
}

#undef KSWZ
#undef SBAR
}

__device__ __forceinline__ void tr_item(const float* __restrict__ W, int N, int K, int k0, int n0, bf16* __restrict__ dst, LAS unsigned* scr, int lane) {
    { const int kr = lane >> 4, nc = (lane & 15) * 4;
      f32x4 v[16];
#pragma unroll
      for (int i = 0; i < 16; ++i) v[i] = *(const f32x4*)(W + (size_t)(k0 + 4 * i + kr) * N + n0 + nc);
#pragma unroll
      for (int i = 0; i < 16; ++i) { const int k = 4 * i + kr; scr[k * 33 + (nc >> 1)] = pk2(v[i][0], v[i][1]); scr[k * 33 + (nc >> 1) + 1] = pk2(v[i][2], v[i][3]); } }
    asm volatile("s_waitcnt lgkmcnt(0)" ::: "memory");
    { const int np = lane >> 3, c = lane & 7;
#pragma unroll
      for (int j = 0; j < 4; ++j) { const int n2 = np + 8 * j; unsigned d[8];
#pragma unroll
          for (int i = 0; i < 8; ++i) d[i] = scr[(8 * c + i) * 33 + n2];
          u32x4 lo, hi;
          lo.x = (d[0] & 0xffffu) | (d[1] << 16); lo.y = (d[2] & 0xffffu) | (d[3] << 16); lo.z = (d[4] & 0xffffu) | (d[5] << 16); lo.w = (d[6] & 0xffffu) | (d[7] << 16);
          hi.x = (d[0] >> 16) | (d[1] & 0xffff0000u); hi.y = (d[2] >> 16) | (d[3] & 0xffff0000u); hi.z = (d[4] >> 16) | (d[5] & 0xffff0000u); hi.w = (d[6] >> 16) | (d[7] & 0xffff0000u);
          *(u32x4*)(dst + (size_t)(2 * n2) * K + k0 + 8 * c) = lo;
          *(u32x4*)(dst + (size_t)(2 * n2 + 1) * K + k0 + 8 * c) = hi; } }
    asm volatile("s_waitcnt lgkmcnt(0)" ::: "memory");
}
__device__ __forceinline__ void rms_row_to_bf16(const float* __restrict__ xrow, const float* __restrict__ w, bf16* __restrict__ orow, int lane) {
    const f32x4* xr = (const f32x4*)xrow + lane; const f32x4* wr = (const f32x4*)w + lane;
    f32x4 v[8]; float s = 0.f;
#pragma unroll
    for (int j = 0; j < 8; ++j) { v[j] = xr[64 * j]; s += (v[j][0] * v[j][0] + v[j][1] * v[j][1]) + (v[j][2] * v[j][2] + v[j][3] * v[j][3]); }
    const float rstd = __builtin_amdgcn_rsqf(wave_sum(s) * (1.f / D) + RMS_EPS);
    u32x2* o8 = (u32x2*)orow + lane;
#pragma unroll
    for (int j = 0; j < 8; ++j) { const f32x4 ww = wr[64 * j]; u32x2 p; p.x = pk2(v[j][0] * rstd * ww[0], v[j][1] * rstd * ww[1]); p.y = pk2(v[j][2] * rstd * ww[2], v[j][3] * rstd * ww[3]); o8[64 * j] = p; }
}


struct Args { const float* in[18]; float* out; unsigned char* ws; int ph_lo, ph_hi, li, pad; };
__global__ void __launch_bounds__(NWAVES * 64, 2) trunk_fwd(Args args) {
    extern __shared__ __attribute__((aligned(16))) unsigned char lds_raw[];
    LAS unsigned char* const lds = (LAS unsigned char*)lds_raw;
    volatile LAS unsigned* const MISC = (volatile LAS unsigned*)(lds + MISC_OFF);
    const int tid = threadIdx.x, lane = tid & 63, wave = __builtin_amdgcn_readfirstlane(tid >> 6);
    const int G = gridDim.x, bx = blockIdx.x;
    const int gw = bx * NWAVES + wave, NGW = G * NWAVES;
    unsigned char* const ws = args.ws;
    unsigned* const ctl = (unsigned*)(ws + WS_CTL);
    const float* const x = args.in[0];
    bf16* const WinT = (bf16*)(ws + WS_WIN); bf16* const WoutT = (bf16*)(ws + WS_WOUT); bf16* const Hb = (bf16*)(ws + WS_H);
    bf16* const WguT = (bf16*)(ws + WS_WGU); bf16* const WdT = (bf16*)(ws + WS_WD);
    bf16* const PROJ = (bf16*)(ws + WS_PROJ); bf16* const MIX = (bf16*)(ws + WS_MIX); bf16* const ACT = (bf16*)(ws + WS_ACT);
    float* const X1 = (float*)(ws + WS_X1); bf16* const Y = (bf16*)(ws + WS_Y);
    float* const KMP = (float*)(ws + WS_KMEAN); unsigned* const REC = (unsigned*)(ws + WS_XP);
    bf16* const WRHI = (bf16*)(ws + WS_WRHI); bf16* const WRLO = (bf16*)(ws + WS_WRLO);

    for (int u = tid; u < (LDS_BYTES - ATT_SCR_OFF) / 4; u += NWAVES * 64) ((LAS unsigned*)(lds + ATT_SCR_OFF))[u] = 0u;
    __syncthreads();
    const int lo = args.ph_lo, hi_ph = args.ph_hi;
    XcdBarrier bar; bar.bar = ctl + CW_BAR + args.li * XCD_BAR_WORDS; bar.x = 0; bar.st = nullptr;
    if (hi_ph - lo > 1) bar = xcd_barrier_post(ctl + CW_BAR + args.li * XCD_BAR_WORDS, MISC + 8);
#define GRID_BAR() xcd_barrier(bar)
#if defined(PROBE_DUP)
    const int POFF = args.li == 1 ? 8192 : 0;
#else
    constexpr int POFF = 0;
#endif
#ifndef PH_MASK
#define PH_MASK 0x3ff
#endif
#define IN(k) (((PH_MASK >> (k)) & 1) && lo <= (k) && (k) < hi_ph)
#define BOTH(k) (IN(k) && IN((k) + 1))

    constexpr int I_IN = 32 * 96, I_OUT = 32 * 32, I_G = 32 * 8 * 32, I_D = 8 * 32 * 32;
    constexpr int N_DENSE = I_IN + I_OUT, N_MOE = 2 * I_G + I_D;
#define DENSE_ITEM(r_) do { int r = (r_); \
        if (r < I_IN) { const int kb = r / 96, nb = r % 96; tr_item(args.in[2], NIN, D, 64 * kb, 64 * nb, WinT + (size_t)(64 * nb) * D, scr, lane); } \
        else { r -= I_IN; const int kb = r / 32, nb = r % 32; tr_item(args.in[8], D, D, 64 * kb, 64 * nb, WoutT + (size_t)(64 * nb) * D, scr, lane); } } while (0)
#define MOE_ITEM(r_) do { int r = (r_); \
        if (r < 2 * I_G) { const int up = r >= I_G ? 1 : 0; if (up) r -= I_G; const int e = r >> 8, q = r & 255, kb = q >> 3, nb = q & 7, n0 = 64 * nb; \
            const float* W = (up ? args.in[15] : args.in[14]) + (size_t)e * D * DE; \
            tr_item(W, DE, D, 64 * kb, n0, WguT + ((size_t)e * 1024 + (n0 >> 7) * 256 + (n0 & 127) + up * 128) * D, scr, lane); } \
        else { r -= 2 * I_G; const int e = r >> 8, q = r & 255, kb = q >> 5, nb = q & 31; \
            tr_item(args.in[16] + (size_t)e * DE * D, D, DE, 64 * kb, 64 * nb, WdT + ((size_t)e * 2048 + 64 * nb) * DE, scr, lane); } } while (0)
    const int n_moe_p0 = N_MOE_P0, n_moe_p1 = (G == 256) ? N_MOE_P1 : N_MOE_P0;
    const int GP1 = (n_moe_p1 > n_moe_p0) ? 192 : G;

    if (IN(0)) {
        LAS unsigned* scr = (LAS unsigned*)(lds + wave * 16384);
        for (int it = gw; it < N_DENSE; it += NGW) DENSE_ITEM(it);
        for (int it = gw; it < n_moe_p0; it += NGW) MOE_ITEM(it);
        for (int i = bx * 512 + tid; i < 48 * D; i += G * 512) { const int c = i / D, k = i % D;
            const float v = c < 4 ? args.in[10][k * 4 + c] : (c < 36 ? args.in[12][k * 32 + (c - 4)] : 0.f);
            const unsigned h = f2bf(v); WRHI[i] = (bf16)h; WRLO[i] = (bf16)f2bf(v - bf2f(h)); }
        for (int m = gw; m < T; m += NGW) rms_row_to_bf16(x + (size_t)m * D, args.in[1], Hb + (size_t)m * D, lane);
        if (BOTH(0)) GRID_BAR();
    }

    if (IN(1)) {
        if (bx < GP1) {
            pg8::Gemm g{Hb, WinT, T, NIN, D}; pg8::StaticOrder S; S.init(T, NIN, GP1, bx);
            pg8::EpiProj E{PROJ, NIN, QSCALE, KMP};
            pg8::gemm_phase<pg8::EpiProj, pg8::StaticOrder, true, true>(lds, g, S, E);
        } else {
            LAS unsigned* scr = (LAS unsigned*)(lds + wave * 16384);
            for (int it = n_moe_p0 + (bx - GP1) * NWAVES + wave; it < n_moe_p1; it += (G - GP1) * NWAVES) MOE_ITEM(it);
        }
        if (BOTH(1)) GRID_BAR();
    }


    if (IN(3)) {
        float lam;
        { const float a = args.in[3][lane] * args.in[4][lane] + args.in[3][lane + 64] * args.in[4][lane + 64];
          const float c = args.in[5][lane] * args.in[6][lane] + args.in[5][lane + 64] * args.in[6][lane + 64];
          lam = __expf(wave_sum(a)) - __expf(wave_sum(c)) + 0.2f; }
        LAS int* const ucost = (LAS int*)(lds + QTAB_OFF); LAS unsigned* const uperm = (LAS unsigned*)(lds + QTAB_OFF + 2048);
        { const int u = tid, ty = u >> 8, b = (u >> 7) & 1; int c; unsigned ent;
          if (ty) { const int h = (u >> 5) & 3, j = u & 31, nt = 2 * (j + 1); const int dh = h == 0 ? 444 : (h == 1 ? 1774 : 8192); int near = dh / 64 + 3; near = near < nt ? near : nt;
              c = near * 48 + (nt - near) * 18; ent = (1u << 16) | ((unsigned)b << 12) | ((unsigned)h << 8) | (unsigned)j; }
          else { const int h = (u >> 4) & 7, i = u & 15, nt = 4 * (i + 1); const int dh = h < 5 ? (222 << h) : 8192; int near = dh / 64 + 5; near = near < nt ? near : nt;
              c = near * 32 + (nt - near) * 17; ent = ((unsigned)b << 12) | ((unsigned)h << 8) | (unsigned)i; }
          ucost[u] = c; __syncthreads();
          int rank = 0; const int v0 = u & 256;
          for (int v = v0; v < v0 + 256; ++v) { const int cv = ucost[v]; rank += (cv > c || (cv == c && v < u)) ? 1 : 0; }
          uperm[v0 + rank] = ent; __syncthreads(); }
#if defined(PROBE_DUP) && defined(PROBE_MODE)
        const int pmode = args.li == 1 ? PROBE_MODE : 0; bf16* const mixo = args.li == 1 ? Hb : MIX;
#else
        constexpr int pmode = 0; bf16* const mixo = MIX;
#endif
#define QFETCH(word) do { __syncthreads(); if (tid == 0) MISC[16] = __hip_atomic_fetch_add(ctl + CW_QHEAD + 64 * args.li + (word), 1u, __ATOMIC_RELAXED, __HIP_MEMORY_SCOPE_AGENT); \
                          __syncthreads(); qi = __builtin_amdgcn_readfirstlane(MISC[16]); } while (0)
        unsigned qi;
        for (;;) { QFETCH(0); if (qi >= 256u) break;
            const unsigned e = __builtin_amdgcn_readfirstlane(uperm[256 + qi]);
            att::attn_unit<1>(lds, PROJ, mixo, KMP, (int)((e >> 12) & 15u), (int)((e >> 8) & 15u), (int)(e & 255u), lam, args.in[7], pmode); }
        for (;;) { QFETCH(1024); if (qi >= 256u) break;
            const unsigned e = __builtin_amdgcn_readfirstlane(uperm[qi]);
            att::attn_unit<0>(lds, PROJ, mixo, KMP, (int)((e >> 12) & 15u), (int)((e >> 8) & 15u), (int)(e & 255u), lam, args.in[7], pmode); }
#if defined(PROBE_DUP) && defined(PROBE_MODE)
        if (args.li != 1)
#endif
        { const unsigned ncu = (unsigned)((N_MOE - n_moe_p1 + NWAVES - 1) / NWAVES); LAS unsigned* scr = (LAS unsigned*)(lds + wave * 16384);
          for (;;) { QFETCH(2048); if (qi >= ncu) break;
              const int it = n_moe_p1 + (int)qi * NWAVES + wave; if (it < N_MOE) MOE_ITEM(it); } }
#undef QFETCH
        if (BOTH(3)) GRID_BAR();
    }

    if (IN(4)) {
        pg8::Gemm g{MIX, WoutT, T, D, D}; pg8::StaticOrder S; S.init(T, D, G, bx);
        pg8::EpiResid E{x, X1, D};
        pg8::gemm_phase<pg8::EpiResid, pg8::StaticOrder, false, true>(lds, g, S, E);
        if (BOTH(4)) GRID_BAR();
    }

    if (IN(5)) {
        LAS float* lg = (LAS float*)(lds + wave * 4096);
        const float* nw = args.in[9];
        const int nit5 = (T / 16 + 2 * G - 1) / (2 * G);
        for (int it = 0; it < nit5; ++it) {
            const int tile = (2 * it + (wave >> 2)) * G + bx; const bool tvalid = tile < T / 16;
            const int t0 = (tvalid ? tile : 0) * 16, row = lane & 15, kq = lane >> 4, kpart = wave & 3;
            const float* xr = X1 + (size_t)(t0 + row) * D + 8 * kq;
            pg8::f32x4 acc[3] = {{0.f, 0.f, 0.f, 0.f}, {0.f, 0.f, 0.f, 0.f}, {0.f, 0.f, 0.f, 0.f}};
            float ss = 0.f;
#pragma unroll 2
            for (int s = 16 * kpart; s < 16 * kpart + 16; ++s) {
                const f32x4 a0 = *(const f32x4*)(xr + 32 * s), a1 = *(const f32x4*)(xr + 32 * s + 4);
                const f32x4 w0 = *(const f32x4*)(nw + 32 * s + 8 * kq), w1 = *(const f32x4*)(nw + 32 * s + 8 * kq + 4);
                ss += (a0[0] * a0[0] + a0[1] * a0[1]) + (a0[2] * a0[2] + a0[3] * a0[3]) + (a1[0] * a1[0] + a1[1] * a1[1]) + (a1[2] * a1[2] + a1[3] * a1[3]);
                const f32x4 u0 = a0 * w0, u1 = a1 * w1;
                unsigned hb[8]; float uf[8] = {u0[0], u0[1], u0[2], u0[3], u1[0], u1[1], u1[2], u1[3]};
                u32x4 ah, al;
#pragma unroll
                for (int j = 0; j < 8; ++j) hb[j] = f2bf(uf[j]);
                ah.x = hb[0] | (hb[1] << 16); ah.y = hb[2] | (hb[3] << 16); ah.z = hb[4] | (hb[5] << 16); ah.w = hb[6] | (hb[7] << 16);
                al.x = pk2(uf[0] - bf2f(hb[0]), uf[1] - bf2f(hb[1])); al.y = pk2(uf[2] - bf2f(hb[2]), uf[3] - bf2f(hb[3]));
                al.z = pk2(uf[4] - bf2f(hb[4]), uf[5] - bf2f(hb[5])); al.w = pk2(uf[6] - bf2f(hb[6]), uf[7] - bf2f(hb[7]));
                const bf16x8 afh = __builtin_bit_cast(bf16x8, ah), afl = __builtin_bit_cast(bf16x8, al);
                if (tvalid) *(u32x4*)(Hb + (size_t)(t0 + row) * D + 32 * s + 8 * kq) = ah;
#pragma unroll
                for (int ct = 0; ct < 3; ++ct) { const size_t wo = (size_t)(16 * ct + row) * D + 32 * s + 8 * kq;
                    const bf16x8 bh = *(const bf16x8*)(WRHI + wo), bl = *(const bf16x8*)(WRLO + wo);
                    acc[ct] = __builtin_amdgcn_mfma_f32_16x16x32_bf16(afh, bh, acc[ct], 0, 0, 0);
                    acc[ct] = __builtin_amdgcn_mfma_f32_16x16x32_bf16(afh, bl, acc[ct], 0, 0, 0);
                    acc[ct] = __builtin_amdgcn_mfma_f32_16x16x32_bf16(afl, bh, acc[ct], 0, 0, 0); }
            }
            ss += __shfl_xor(ss, 16); ss += __shfl_xor(ss, 32);
#pragma unroll
            for (int ct = 0; ct < 3; ++ct)
#pragma unroll
                for (int r = 0; r < 4; ++r) lg[(4 * kq + r) * 48 + 16 * ct + row] = acc[ct][r];
            if (kq == 0) lg[768 + row] = ss;
            __syncthreads();
            if (tvalid && kpart == 0 && lane < 16) {
                const LAS float* L0 = lg + lane * 48;
                const float rs = __builtin_amdgcn_rsqf((lg[768 + lane] + lg[1024 + 768 + lane] + lg[2048 + 768 + lane] + lg[3072 + 768 + lane]) * (1.f / D) + RMS_EPS);
#define LGT(c) ((L0[(c)] + L0[1024 + (c)]) + (L0[2048 + (c)] + L0[3072 + (c)]))
                float gmax = -__builtin_inff(); int gi = 0; float gl[4];
#pragma unroll
                for (int c = 0; c < 4; ++c) { gl[c] = LGT(c) * rs + args.in[11][c]; if (gl[c] > gmax) { gmax = gl[c]; gi = c; } }
                float gsum = 0.f;
#pragma unroll
                for (int c = 0; c < 4; ++c) gsum += __expf(gl[c] - gmax);
                const float gp = 1.f / gsum;
                float el[8], emax = -__builtin_inff();
#pragma unroll
                for (int j = 0; j < 8; ++j) { el[j] = LGT(4 + 8 * gi + j) * rs + args.in[13][8 * gi + j]; emax = fmaxf(emax, el[j]); }
#undef LGT
                float p0v = -1.f, p1v = -1.f; int i0 = 0, i1 = 0;
#pragma unroll
                for (int j = 0; j < 8; ++j) { const float p = __expf(el[j] - emax);
                    if (p > p0v) { p1v = p0v; i1 = i0; p0v = p; i0 = j; } else if (p > p1v) { p1v = p; i1 = j; } }
                const float inv = gp / (p0v + p1v);
                const int e0 = 8 * gi + i0, e1 = 8 * gi + i1;
                const unsigned pos0 = atomicAdd(ctl + CW_ECNT + POFF + 64 * e0, 1u), pos1 = atomicAdd(ctl + CW_ECNT + POFF + 64 * e1, 1u);
                const unsigned t = (unsigned)(t0 + lane), rsb = __builtin_bit_cast(unsigned, rs);
                u32x4 r0 = {2u * t, __builtin_bit_cast(unsigned, p0v * inv), rsb, t}, r1 = {2u * t + 1u, __builtin_bit_cast(unsigned, p1v * inv), rsb, t};
                *(u32x4*)(REC + ((size_t)e0 * 8192 + pos0) * 4) = r0; *(u32x4*)(REC + ((size_t)e1 * 8192 + pos1) * 4) = r1;
            }
            __syncthreads();
        }
        if (BOTH(5)) GRID_BAR();
    }

    LAS int* const tab = (LAS int*)(lds + MOE_TAB_OFF);
    if (IN(7) || IN(8)) {
        if (tid < 32) tab[120 + tid] = (int)__hip_atomic_load(ctl + CW_ECNT + 64 * tid, __ATOMIC_RELAXED, __HIP_MEMORY_SCOPE_AGENT);
        __syncthreads();
        if (tid == 0) { int ts = 0;
            for (int e = 0; e < 32; ++e) { const int c = tab[120 + e], nt = (c + 255) >> 8; tab[e] = ts; tab[40 + e] = ts; tab[80 + e] = ts * 256 + c; ts += nt; }
            tab[32] = ts; }
        __syncthreads();
    }


    if (IN(7)) {
        pg8::Gemm g{Hb, WguT, T, NE * 1024, D}; pg8::MoeOrder S{tab, 4, tab[32] * 4, G, bx, REC, (unsigned)(D * 2)};
        pg8::EpiSwiGLU E{ACT, REC, tab};
        pg8::gemm_phase_g<pg8::EpiSwiGLU, pg8::MoeOrder, true>(lds, g, S, E);
        if (BOTH(7)) GRID_BAR();
    }

    if (IN(8)) {
        pg8::Gemm g{ACT, WdT, XP_ROWS, NE * 2048, DE}; pg8::MoeOrder S{tab, 8, tab[32] * 8, G, bx, REC, 0u};
        pg8::EpiDown E{Y, REC, tab};
        pg8::gemm_phase<pg8::EpiDown, pg8::MoeOrder, true, true>(lds, g, S, E);
        if (BOTH(8)) GRID_BAR();
    }

    if (IN(9)) {
        const float* nf = args.in[17];
        for (int t = gw; t < T; t += NGW) {
            const f32x4* xr = (const f32x4*)(X1 + (size_t)t * D) + lane;
            const u32x2* y0 = (const u32x2*)(Y + (size_t)(2 * t) * D) + lane; const u32x2* y1 = (const u32x2*)(Y + (size_t)(2 * t + 1) * D) + lane;
            f32x4 v[8]; float s = 0.f;
#pragma unroll
            for (int j = 0; j < 8; ++j) { f32x4 a = xr[64 * j]; const u32x2 p = y0[64 * j], q = y1[64 * j];
                a[0] += bf2f(p.x & 0xffffu) + bf2f(q.x & 0xffffu); a[1] += bf2f(p.x >> 16) + bf2f(q.x >> 16);
                a[2] += bf2f(p.y & 0xffffu) + bf2f(q.y & 0xffffu); a[3] += bf2f(p.y >> 16) + bf2f(q.y >> 16);
                v[j] = a; s += (a[0] * a[0] + a[1] * a[1]) + (a[2] * a[2] + a[3] * a[3]); }
            const float rstd = __builtin_amdgcn_rsqf(wave_sum(s) * (1.f / D) + RMS_EPS);
            f32x4* orow = (f32x4*)(args.out + (size_t)t * D) + lane; const f32x4* wr = (const f32x4*)nf + lane;
#pragma unroll
            for (int j = 0; j < 8; ++j) orow[64 * j] = v[j] * rstd * wr[64 * j];
        }
    }
#undef IN
#undef BOTH
#undef GRID_BAR
}

extern "C" void kernel_launch(void* const* d_in, const int* in_sizes, int n_in, void* d_out, int out_size, void* d_ws, size_t ws_size, hipStream_t stream) {
    static int grid = 0;
    if (grid == 0) {
        if (n_in != 18 || in_sizes[0] != T * D || out_size != T * D || ws_size < WS_END) { fprintf(stderr, "kernel_launch: unexpected shapes (n_in %d, in0 %d, out %d, ws %zu)\n", n_in, n_in > 0 ? in_sizes[0] : -1, out_size, ws_size); grid = -1; return; }
        int dev = 0, cus = 0, per_cu = 0;
        if (hipGetDevice(&dev) != hipSuccess || hipDeviceGetAttribute(&cus, hipDeviceAttributeMultiprocessorCount, dev) != hipSuccess) { grid = -1; return; }
        if (hipFuncSetAttribute((const void*)trunk_fwd, hipFuncAttributeMaxDynamicSharedMemorySize, LDS_BYTES) != hipSuccess) { fprintf(stderr, "kernel_launch: hipFuncSetAttribute failed\n"); grid = -1; return; }
        if (hipOccupancyMaxActiveBlocksPerMultiprocessor(&per_cu, (const void*)trunk_fwd, NWAVES * 64, LDS_BYTES) != hipSuccess || per_cu < 1)
            fprintf(stderr, "kernel_launch: note: occupancy query reports %d workgroups per CU\n", per_cu);
        (void)hipGetLastError();
        grid = cus;
    }
    if (grid < 0) return;
    if (hipMemsetAsync((char*)d_ws + WS_CTL, 0, CTL_ZERO_BYTES, stream) != hipSuccess) return;
    Args a{};
    for (int i = 0; i < 18; ++i) a.in[i] = (const float*)d_in[i];
    a.out = (float*)d_out; a.ws = (unsigned char*)d_ws;
    int plan[NPH + 2][2]; int nl = 0;
#if defined(PROBE_DUP)
    plan[nl][0] = 0; plan[nl][1] = PROBE_DUP + 1; ++nl; plan[nl][0] = PROBE_DUP; plan[nl][1] = PROBE_DUP + 1; ++nl;
    if (PROBE_DUP + 1 < NPH) { plan[nl][0] = PROBE_DUP + 1; plan[nl][1] = NPH; ++nl; }
#else
    if (N_LAUNCHES == 1) { plan[0][0] = 0; plan[0][1] = NPH; nl = 1; } else { for (int k = 0; k < NPH; ++k) { plan[k][0] = k; plan[k][1] = k + 1; } nl = NPH; }
#endif
    for (int li = 0; li < nl; ++li) {
        a.ph_lo = plan[li][0]; a.ph_hi = plan[li][1]; a.li = li;
        hipLaunchKernelGGL(trunk_fwd, dim3(grid), dim3(NWAVES * 64), LDS_BYTES, stream, a);
    }
}
```
